# Optimizing an MI355X kernel written in HIP

```python
import jax
import jax.numpy as jnp
from jax import lax
import numpy as np

D_MODEL = 1024
BATCH = 16
SEQ = 2048
DEPTH = 2

CTX_LEN = 256
GRID_W = 64
HEAD_DIM = 64

NA_HEADS = 6
NA_WIN_ROWS = 8
NA_WIN_COLS = 16

GLA_HEADS = 4
GLA_DK = 32
GLA_DV = 64
GLA_RANK = 16
GLA_GATE_NORM = 16.0
GLA_CHUNK = 64

GQA_Q_HEADS = 6
GQA_KV_HEADS = 2
GQA_REP = GQA_Q_HEADS // GQA_KV_HEADS
Q_BLOCK = 128
ROPE_THETA = 10000.0
ROPE_AXIS_PAIRS = HEAD_DIM // 4

FFN_HIDDEN = ((8 * D_MODEL + 3 * 256 - 1) // (3 * 256)) * 256

NA_W = NA_HEADS * HEAD_DIM
GLA_KW = GLA_HEADS * GLA_DK
GLA_VW = GLA_HEADS * GLA_DV
GQA_QW = GQA_Q_HEADS * HEAD_DIM
GQA_KVW = GQA_KV_HEADS * HEAD_DIM
MIX_W = NA_W + GLA_VW + GQA_QW
IN_WIDTHS = (NA_W, NA_W, NA_W, GLA_KW, GLA_KW, GLA_VW, GLA_VW, 2 * GLA_RANK, GQA_QW, GQA_KVW, GQA_KVW)
IN_COLS = sum(IN_WIDTHS)
IN_SPLITS = [int(s) for s in np.cumsum(IN_WIDTHS)[:-1]]

DEEPNORM_ALPHA = (2.0 * DEPTH) ** 0.25
DEEPNORM_BETA = (8.0 * DEPTH) ** -0.25
LN_EPS = 1e-5
RMS_EPS = 1e-6

kernel_name = 'hybrid_na_gla_gqa_dit_block'


def layer_norm(x, g, b):
    xf = x.astype(jnp.float32)
    mu = jnp.mean(xf, axis=-1, keepdims=True)
    var = jnp.mean(jnp.square(xf - mu), axis=-1, keepdims=True)
    return ((xf - mu) * lax.rsqrt(var + LN_EPS) * g + b).astype(x.dtype)


def rms_norm(x, w):
    xf = x.astype(jnp.float32)
    ms = jnp.mean(jnp.square(xf), axis=-1, keepdims=True)
    return (xf * lax.rsqrt(ms + RMS_EPS) * w).astype(x.dtype)


def modulate(x, shift, scale):
    return x * (1 + scale) + shift


def to_heads(t, n_heads):
    b, n, _ = t.shape
    return t.reshape(b, n, n_heads, -1).transpose(0, 2, 1, 3)


def merge_heads(t):
    b, h, n, d = t.shape
    return t.transpose(0, 2, 1, 3).reshape(b, n, h * d)


def flip_seq(t):
    return jnp.flip(t, axis=2)


def axial_rope_tables(n_tokens):
    t = jnp.arange(n_tokens)
    row = (t // GRID_W).astype(jnp.float32)
    col = (t % GRID_W).astype(jnp.float32)
    inv_freq = ROPE_THETA ** (-jnp.arange(ROPE_AXIS_PAIRS, dtype=jnp.float32) / ROPE_AXIS_PAIRS)
    ang_r = row[:, None] * inv_freq
    ang_c = col[:, None] * inv_freq
    ang = jnp.concatenate([ang_r, ang_r, ang_c, ang_c], axis=-1)
    return jnp.cos(ang), jnp.sin(ang)


def apply_axial_rope(x, cos, sin):
    xf = x.astype(jnp.float32)
    x1, x2, x3, x4 = jnp.split(xf, 4, axis=-1)
    rot = jnp.concatenate([-x2, x1, -x4, x3], axis=-1)
    return (xf * cos + rot * sin).astype(x.dtype)


def context_attention(q, k, v):
    s = jnp.einsum('bgrqd,bgkd->bgrqk', q, k, preferred_element_type=jnp.float32) * (q.shape[-1] ** -0.5)
    p = jax.nn.softmax(s, axis=-1).astype(v.dtype)
    return jnp.einsum('bgrqk,bgkd->bgrqd', p, v)


def neighborhood_attention(q, k, v, k_ctx, v_ctx, rpb):
    B, H, N, d = q.shape
    rows = N // GRID_W
    wr = min(NA_WIN_ROWS, rows)
    scale = d ** -0.5
    qg = q.reshape(B, H, rows, GRID_W, d)
    kg = k.reshape(B, H, rows, GRID_W, d)
    vg = v.reshape(B, H, rows, GRID_W, d)
    cols = jnp.arange(GRID_W)
    col_start = jnp.clip(cols - NA_WIN_COLS // 2, 0, GRID_W - NA_WIN_COLS)
    col_in = (cols[None, :] >= col_start[:, None]) & (cols[None, :] < col_start[:, None] + NA_WIN_COLS)
    dc_idx = jnp.clip(cols[None, :] - cols[:, None], -(NA_WIN_COLS - 1), NA_WIN_COLS - 1) + (NA_WIN_COLS - 1)

    def row_block(r):
        rs = jnp.clip(r - wr // 2, 0, rows - wr)
        q_r = lax.dynamic_index_in_dim(qg, r, axis=2, keepdims=False)
        k_s = lax.dynamic_slice_in_dim(kg, rs, wr, axis=2)
        v_s = lax.dynamic_slice_in_dim(vg, rs, wr, axis=2)
        dr_idx = rs + jnp.arange(wr) - r + (NA_WIN_ROWS - 1)
        bias = rpb[:, dr_idx[None, :, None], dc_idx[:, None, :]]
        s_lat = jnp.einsum('bhqd,bhrkd->bhqrk', q_r, k_s, preferred_element_type=jnp.float32) * scale + bias.astype(jnp.float32)
        s_lat = jnp.where(col_in[:, None, :], s_lat, -jnp.inf).reshape(B, H, GRID_W, wr * GRID_W)
        s_ctx = jnp.einsum('bhqd,bhcd->bhqc', q_r, k_ctx, preferred_element_type=jnp.float32) * scale
        p = jax.nn.softmax(jnp.concatenate([s_lat, s_ctx], axis=-1), axis=-1).astype(v.dtype)
        p_lat = p[..., : wr * GRID_W].reshape(B, H, GRID_W, wr, GRID_W)
        p_ctx = p[..., wr * GRID_W:]
        return jnp.einsum('bhqrk,bhrkd->bhqd', p_lat, v_s) + jnp.einsum('bhqc,bhcd->bhqd', p_ctx, v_ctx)

    o = lax.map(row_block, jnp.arange(rows))
    return o.transpose(1, 2, 0, 3, 4).reshape(B, H, N, d)


def gqa_latent_attention(q, k, v, k_ctx, v_ctx):
    B, G, R, N, d = q.shape
    nb = N // Q_BLOCK
    keys = jnp.concatenate([k, k_ctx], axis=2)
    vals = jnp.concatenate([v, v_ctx], axis=2)
    qb = q.reshape(B, G, R, nb, Q_BLOCK, d).transpose(3, 0, 1, 2, 4, 5)

    def block(q_blk):
        s = jnp.einsum('bgrqd,bgkd->bgrqk', q_blk, keys, preferred_element_type=jnp.float32) * (d ** -0.5)
        p = jax.nn.softmax(s, axis=-1).astype(vals.dtype)
        return jnp.einsum('bgrqk,bgkd->bgrqd', p, vals)

    o = lax.map(block, qb)
    return o.transpose(1, 2, 3, 0, 4, 5).reshape(B, G * R, N, d)


def gla_log_gates(lr, wa2, ba):
    B, N, _ = lr.shape
    z = jnp.einsum('bner,erk->ebnk', lr.reshape(B, N, 2, GLA_RANK), wa2) + ba[:, None, None, :]
    la = jax.nn.log_sigmoid(z.astype(jnp.float32)) / GLA_GATE_NORM
    la = la.reshape(2, B, N, GLA_HEADS, GLA_DK).transpose(0, 1, 3, 2, 4)
    return la[0], la[1]


def gla_chunked(q, k, v, log_a, s0):
    B, H, N, dk = q.shape
    dv = v.shape[-1]
    nc = N // GLA_CHUNK

    def to_chunks(t):
        return t.astype(jnp.float32).reshape(B, H, nc, GLA_CHUNK, t.shape[-1]).transpose(2, 0, 1, 3, 4)

    causal = jnp.tril(jnp.ones((GLA_CHUNK, GLA_CHUNK), dtype=bool))

    def step(S, xs):
        qi, ki, vi, gi = xs
        b = jnp.cumsum(gi, axis=-2)
        b_last = b[..., -1:, :]
        diff = b[..., :, None, :] - b[..., None, :, :]
        decay = jnp.exp(jnp.where(causal[:, :, None], diff, -jnp.inf))
        A = jnp.einsum('bhtd,bhsd,bhtsd->bhts', qi, ki, decay)
        o = jnp.einsum('bhts,bhsv->bhtv', A, vi) + jnp.einsum('bhtd,bhdv->bhtv', qi * jnp.exp(b), S)
        S = jnp.exp(b_last)[..., 0, :, None] * S + jnp.einsum('bhsd,bhsv->bhdv', ki * jnp.exp(b_last - b), vi)
        return S, o

    S, o = lax.scan(step, s0.astype(jnp.float32), (to_chunks(q), to_chunks(k), to_chunks(v), to_chunks(log_a)))
    return o.transpose(1, 2, 0, 3, 4).reshape(B, H, N, dv).astype(v.dtype), S


def gla_final_state(k, v, log_a):
    b = jnp.cumsum(log_a.astype(jnp.float32), axis=2)
    w = jnp.exp(b[:, :, -1:, :] - b)
    return jnp.einsum('bhsd,bhsv->bhdv', k.astype(jnp.float32) * w, v.astype(jnp.float32))


def gla_bidirectional(q, k, v, la_f, la_b, s_f, s_b):
    o_f, s_f_end = gla_chunked(q, k, v, la_f, s_f)
    o_b, s_b_end = gla_chunked(flip_seq(q), flip_seq(k), flip_seq(v), flip_seq(la_b), s_b)
    return o_f + flip_seq(o_b), s_f_end, s_b_end


def gla_output(o, norm_w, g):
    return merge_heads(rms_norm(o, norm_w)) * jax.nn.silu(g)


def token_mixers(u, uc, w_in, rpb, gla_wa2, gla_ba, gla_norm_w, q_norm_w, k_norm_w, rope_cos, rope_sin, ctx_out):
    B, N, _ = u.shape
    (na_q, na_k, na_v, gl_q, gl_k, gl_v, gl_g, gl_lr, ga_q, ga_k, ga_v) = jnp.split(u @ w_in, IN_SPLITS, axis=-1)
    (na_qc, na_kc, na_vc, gl_qc, gl_kc, gl_vc, gl_gc, gl_lrc, ga_qc, ga_kc, ga_vc) = jnp.split(uc @ w_in, IN_SPLITS, axis=-1)

    k_na_c = to_heads(na_kc, NA_HEADS)
    v_na_c = to_heads(na_vc, NA_HEADS)
    o_na = neighborhood_attention(to_heads(na_q, NA_HEADS), to_heads(na_k, NA_HEADS), to_heads(na_v, NA_HEADS), k_na_c, v_na_c, rpb)

    la_f, la_b = gla_log_gates(gl_lr, gla_wa2, gla_ba)
    la_fc, la_bc = gla_log_gates(gl_lrc, gla_wa2, gla_ba)
    k_gl_c = to_heads(gl_kc, GLA_HEADS)
    v_gl_c = to_heads(gl_vc, GLA_HEADS)
    if ctx_out:
        s0 = jnp.zeros((B, GLA_HEADS, GLA_DK, GLA_DV), jnp.float32)
        q_gl_c = to_heads(gl_qc, GLA_HEADS) * GLA_DK ** -0.5
        oc_gl, s_f, s_b = gla_bidirectional(q_gl_c, k_gl_c, v_gl_c, la_fc, la_bc, s0, s0)
    else:
        s_f = gla_final_state(k_gl_c, v_gl_c, la_fc)
        s_b = gla_final_state(flip_seq(k_gl_c), flip_seq(v_gl_c), flip_seq(la_bc))
    o_gl, _, _ = gla_bidirectional(to_heads(gl_q, GLA_HEADS) * GLA_DK ** -0.5, to_heads(gl_k, GLA_HEADS), to_heads(gl_v, GLA_HEADS), la_f, la_b, s_f, s_b)

    q_ga = apply_axial_rope(rms_norm(to_heads(ga_q, GQA_Q_HEADS), q_norm_w), rope_cos, rope_sin)
    k_ga = apply_axial_rope(rms_norm(to_heads(ga_k, GQA_KV_HEADS), k_norm_w), rope_cos, rope_sin)
    k_ga_c = rms_norm(to_heads(ga_kc, GQA_KV_HEADS), k_norm_w)
    v_ga_c = to_heads(ga_vc, GQA_KV_HEADS)
    o_ga = gqa_latent_attention(q_ga.reshape(B, GQA_KV_HEADS, GQA_REP, N, HEAD_DIM), k_ga, to_heads(ga_v, GQA_KV_HEADS), k_ga_c, v_ga_c)

    o = jnp.concatenate([merge_heads(o_na), gla_output(o_gl, gla_norm_w, gl_g), merge_heads(o_ga)], axis=-1)
    if not ctx_out:
        return o, None

    L = uc.shape[1]
    oc_na = context_attention(to_heads(na_qc, NA_HEADS)[:, :, None], k_na_c, v_na_c)[:, :, 0]
    q_ga_c = rms_norm(to_heads(ga_qc, GQA_Q_HEADS), q_norm_w).reshape(B, GQA_KV_HEADS, GQA_REP, L, HEAD_DIM)
    oc_ga = context_attention(q_ga_c, k_ga_c, v_ga_c).reshape(B, GQA_Q_HEADS, L, HEAD_DIM)
    oc = jnp.concatenate([merge_heads(oc_na), gla_output(oc_gl, gla_norm_w, gl_gc), merge_heads(oc_ga)], axis=-1)
    return o, oc


def swiglu(u, w_ffn_in, w_ffn_out):
    a, b = jnp.split(u @ w_ffn_in, 2, axis=-1)
    return (jax.nn.silu(a) * b) @ w_ffn_out


def setup_inputs(seed: int = 0) -> dict:
    key = jax.random.key(seed)
    ks = jax.random.split(key, 20)

    def nrm(k, shape, scale):
        return jax.random.normal(k, shape, jnp.float32) * scale

    L = DEPTH
    return {
        'x': nrm(ks[0], (BATCH, SEQ, D_MODEL), 1.0),
        'c': nrm(ks[1], (BATCH, D_MODEL), 1.0),
        'ctx': nrm(ks[2], (BATCH, CTX_LEN, D_MODEL), 1.0),
        'c_ctx': nrm(ks[3], (D_MODEL,), 1.0),
        'w_ada': nrm(ks[4], (L, D_MODEL, 6 * D_MODEL), 0.5 * D_MODEL ** -0.5),
        'b_ada': nrm(ks[5], (L, 6 * D_MODEL), 0.02),
        'w_in': nrm(ks[6], (L, D_MODEL, IN_COLS), D_MODEL ** -0.5),
        'na_rpb': nrm(ks[7], (L, NA_HEADS, 2 * NA_WIN_ROWS - 1, 2 * NA_WIN_COLS - 1), 0.1),
        'gla_wa2': nrm(ks[8], (L, 2, GLA_RANK, GLA_KW), GLA_RANK ** -0.5),
        'gla_ba': nrm(ks[9], (L, 2, GLA_KW), 0.02),
        'gla_norm_w': 1.0 + nrm(ks[10], (L, GLA_DV), 0.05),
        'gqa_qnorm_w': 1.0 + nrm(ks[11], (L, HEAD_DIM), 0.05),
        'gqa_knorm_w': 1.0 + nrm(ks[12], (L, HEAD_DIM), 0.05),
        'w_out': nrm(ks[13], (L, MIX_W, D_MODEL), DEEPNORM_BETA * MIX_W ** -0.5),
        'ln1_g': 1.0 + nrm(ks[14], (L, D_MODEL), 0.05),
        'ln1_b': nrm(ks[15], (L, D_MODEL), 0.02),
        'w_ffn_in': nrm(ks[16], (L, D_MODEL, 2 * FFN_HIDDEN), D_MODEL ** -0.5),
        'w_ffn_out': nrm(ks[17], (L, FFN_HIDDEN, D_MODEL), DEEPNORM_BETA * FFN_HIDDEN ** -0.5),
        'ln2_g': 1.0 + nrm(ks[18], (L, D_MODEL), 0.05),
        'ln2_b': nrm(ks[19], (L, D_MODEL), 0.02),
    }


def reference(x, c, ctx, c_ctx, w_ada, b_ada, w_in, na_rpb, gla_wa2, gla_ba, gla_norm_w, gqa_qnorm_w, gqa_knorm_w, w_out, ln1_g, ln1_b, w_ffn_in, w_ffn_out, ln2_g, ln2_b):
    rope_cos, rope_sin = axial_rope_tables(x.shape[1])
    silu_c = jax.nn.silu(c)
    silu_cc = jax.nn.silu(c_ctx)
    xc = ctx
    for l in range(DEPTH):
        ctx_out = l < DEPTH - 1
        mod = (silu_c @ w_ada[l] + b_ada[l])[:, None, :]
        mod_c = silu_cc @ w_ada[l] + b_ada[l]
        sh1, sc1, g1, sh2, sc2, g2 = jnp.split(mod, 6, axis=-1)
        sh1c, sc1c, g1c, sh2c, sc2c, g2c = jnp.split(mod_c, 6, axis=-1)

        o, oc = token_mixers(modulate(x, sh1, sc1), modulate(xc, sh1c, sc1c), w_in[l], na_rpb[l], gla_wa2[l], gla_ba[l], gla_norm_w[l], gqa_qnorm_w[l], gqa_knorm_w[l], rope_cos, rope_sin, ctx_out)
        x = layer_norm(DEEPNORM_ALPHA * x + g1 * (o @ w_out[l]), ln1_g[l], ln1_b[l])
        x = layer_norm(DEEPNORM_ALPHA * x + g2 * swiglu(modulate(x, sh2, sc2), w_ffn_in[l], w_ffn_out[l]), ln2_g[l], ln2_b[l])
        if ctx_out:
            xc = layer_norm(DEEPNORM_ALPHA * xc + g1c * (oc @ w_out[l]), ln1_g[l], ln1_b[l])
            xc = layer_norm(DEEPNORM_ALPHA * xc + g2c * swiglu(modulate(xc, sh2c, sc2c), w_ffn_in[l], w_ffn_out[l]), ln2_g[l], ln2_b[l])
    return x
```

```cpp
#include <hip/hip_runtime.h>
#include <hip/hip_cooperative_groups.h>
#include <cstdio>
#include <cstdint>
namespace cg = cooperative_groups;

#ifndef PM
#define PM 0x1ff
#endif
#ifndef ONE_LAUNCH
#define ONE_LAUNCH 1
#endif

typedef unsigned short bf16_t;
typedef short bf16x8 __attribute__((ext_vector_type(8)));
typedef short s16x4 __attribute__((ext_vector_type(4)));
typedef float f32x4 __attribute__((ext_vector_type(4)));
typedef float f32x2 __attribute__((ext_vector_type(2)));
typedef unsigned u32x4 __attribute__((ext_vector_type(4)));
typedef unsigned u32x2 __attribute__((ext_vector_type(2)));
#define DI __device__ __forceinline__

constexpr int NB = 16, NSEQ = 2048, LC = 256, DM = 1024;
constexpr int NLAT = NB * NSEQ;
constexpr int NCTX = NB * LC;
constexpr int NROWS = NLAT + NCTX;
constexpr int PC = 2592;
constexpr int NPAD_IN = 2688;
constexpr int FH = 2816;
constexpr int C_NAQ = 0, C_NAK = 384, C_NAV = 768, C_GLQ = 1152, C_GLK = 1280, C_GLV = 1408, C_GLG = 1664,
              C_GAQ = 1920, C_GAK = 2304, C_GAV = 2432, C_GLR = 2560;
constexpr float ALPHA = 1.41421356237f;
constexpr float LOG2E = 1.44269504089f;
constexpr float QSCALE = 0.125f * LOG2E;

constexpr size_t al256(size_t x) { return (x + 255) & ~(size_t)255; }
constexpr size_t OFF_WTIN = 0;
constexpr size_t OFF_WTOUT = OFF_WTIN + al256((size_t)2 * NPAD_IN * 1024 * 2);
constexpr size_t OFF_WTFI = OFF_WTOUT + al256((size_t)2 * 1024 * 1024 * 2);
constexpr size_t OFF_WTFO = OFF_WTFI + al256((size_t)2 * 5632 * 1024 * 2);
constexpr size_t OFF_MOD = OFF_WTFO + al256((size_t)2 * 1024 * FH * 2);
constexpr size_t OFF_TAB = OFF_MOD + al256((size_t)2 * 17 * 6144 * 4);
constexpr size_t OFF_ROPE = OFF_TAB + al256((size_t)2 * 4 * 17 * 1024 * 4);
constexpr size_t OFF_ST1 = OFF_ROPE + al256((size_t)2 * 64 * 16 * 4);
constexpr size_t OFF_ST2 = OFF_ST1 + al256((size_t)NROWS * 16 * 4);
constexpr size_t OFF_LS = OFF_ST2 + al256((size_t)NROWS * 16 * 4);
constexpr size_t OFF_BL = OFF_LS + al256((size_t)NB * 4 * 2 * 36 * 2048 * 4);
constexpr size_t OFF_CTXY2 = OFF_BL + al256((size_t)NB * 4 * 2 * 36 * 32 * 4);
constexpr size_t OFF_Y1 = OFF_CTXY2 + al256((size_t)NCTX * 1024 * 4);
constexpr size_t OFF_P = OFF_Y1 + al256((size_t)NROWS * 1024 * 4);
constexpr size_t WS_END = OFF_P + al256((size_t)NROWS * FH * 2);

constexpr int SMEM_BYTES = 72 * 1024;
constexpr int NPHASE = 15;

struct Params {
  const float *x, *c, *ctx, *c_ctx, *w_ada, *b_ada, *w_in, *na_rpb, *gla_wa2, *gla_ba, *gla_norm_w, *qnorm_w, *knorm_w,
      *w_out, *ln1_g, *ln1_b, *w_ffn_in, *w_ffn_out, *ln2_g, *ln2_b;
  float* out;
  char* ws;
  int ph_lo, ph_hi;
};

DI unsigned pack2(float lo, float hi) {
  unsigned r;
  asm("v_cvt_pk_bf16_f32 %0, %1, %2" : "=v"(r) : "v"(lo), "v"(hi));
  return r;
}
DI bf16_t f2bf(float f) { return (bf16_t)(pack2(f, 0.f) & 0xffffu); }
DI float bf2f(unsigned h) { return __uint_as_float(h << 16); }
DI float bflo(unsigned u) { return __uint_as_float(u << 16); }
DI float bfhi(unsigned u) { return __uint_as_float(u & 0xffff0000u); }
DI f32x4 mfma16(bf16x8 a, bf16x8 b, f32x4 c) { return __builtin_amdgcn_mfma_f32_16x16x32_bf16(a, b, c, 0, 0, 0); }
DI float siluf(float x) { return x / (1.f + __expf(-x)); }
DI int tidx() { int t = threadIdx.x; asm volatile("" : "+v"(t)); return t; }
DI float shx(float v, int m) { return __shfl_xor(v, m, 64); }

DI int dest_row(int kind, int n) {
  if (kind == 0) return n < 1920 ? n : (n < 1952 ? n + 640 : n - 32);
  if (kind == 2) { int q = n / FH, hd = n - q * FH; return (hd >> 6) * 128 + ((hd >> 5) & 1) * 64 + q * 32 + (hd & 31); }
  return n;
}

DI void wt_tile(const float* __restrict__ src, int K, int N, int kt, int nt, bf16_t* __restrict__ dst, int dstStride, int kind, char* smem) {
  float* tile = (float*)smem;
  const int tid = tidx(), k0 = kt * 64, n0 = nt * 64;
#pragma unroll 4
  for (int ii = 0; ii < 16; ++ii) {
    int i = (tid >> 6) + 4 * ii, j = tid & 63, n = n0 + j;
    tile[i * 65 + j] = (n < N) ? src[(size_t)(k0 + i) * N + n] : 0.f;
  }
  __syncthreads();
#pragma unroll 4
  for (int ii = 0; ii < 16; ++ii) {
    int jj = (tid >> 6) + 4 * ii, kk = tid & 63, n = n0 + jj;
    if (n < N) dst[(size_t)dest_row(kind, n) * dstStride + k0 + kk] = f2bf(tile[kk * 65 + jj]);
  }
}

DI void mod_item(const Params& p, int l, int cgi, char* smem) {
  float* sc = (float*)smem;
  float* red = sc + 17 * 256;
  const int tid = tidx(), col = tid & 31, kg = tid >> 5, n = cgi * 32 + col;
  float acc[17];
#pragma unroll
  for (int r = 0; r < 17; ++r) acc[r] = 0.f;
  const float* w = p.w_ada + (size_t)l * 1024 * 6144 + n;
  for (int kc = 0; kc < 4; ++kc) {
    __syncthreads();
#pragma unroll
    for (int r = 0; r < 17; ++r) {
      float v = (r < 16) ? p.c[r * 1024 + kc * 256 + tid] : p.c_ctx[kc * 256 + tid];
      sc[r * 256 + tid] = siluf(v);
    }
    __syncthreads();
#pragma unroll 4
    for (int kk = 0; kk < 32; ++kk) {
      int kl = kg * 32 + kk;
      float wv = w[(size_t)(kc * 256 + kl) * 6144];
#pragma unroll
      for (int r = 0; r < 17; ++r) acc[r] += sc[r * 256 + kl] * wv;
    }
  }
#pragma unroll
  for (int r = 0; r < 17; ++r) red[(kg * 17 + r) * 32 + col] = acc[r];
  __syncthreads();
  float* MOD = (float*)(p.ws + OFF_MOD);
  for (int o = tid; o < 17 * 32; o += 256) {
    int r = o >> 5, cc = o & 31;
    float s = p.b_ada[l * 6144 + cgi * 32 + cc];
#pragma unroll
    for (int g = 0; g < 8; ++g) s += red[(g * 17 + r) * 32 + cc];
    MOD[((size_t)l * 17 + r) * 6144 + cgi * 32 + cc] = s;
  }
}

DI void phase_prepA(const Params& p, char* smem) {
  const int tid = tidx();
  for (int it = blockIdx.x; it < 6435; it += gridDim.x) {
    __syncthreads();
    if (it < 6048) {
      int l = it / 3024, r = it % 3024;
      if (r < 656) wt_tile(p.w_in + (size_t)l * 1024 * 2592, 1024, 2592, r / 41, r % 41, (bf16_t*)(p.ws + OFF_WTIN) + (size_t)l * NPAD_IN * 1024, 1024, 0, smem);
      else if (r < 912) { r -= 656; wt_tile(p.w_out + (size_t)l * 1024 * 1024, 1024, 1024, r / 16, r % 16, (bf16_t*)(p.ws + OFF_WTOUT) + (size_t)l * 1024 * 1024, 1024, 1, smem); }
      else if (r < 2320) { r -= 912; wt_tile(p.w_ffn_in + (size_t)l * 1024 * 5632, 1024, 5632, r / 88, r % 88, (bf16_t*)(p.ws + OFF_WTFI) + (size_t)l * 5632 * 1024, 1024, 2, smem); }
      else { r -= 2320; wt_tile(p.w_ffn_out + (size_t)l * FH * 1024, FH, 1024, r / 16, r % 16, (bf16_t*)(p.ws + OFF_WTFO) + (size_t)l * 1024 * FH, FH, 1, smem); }
    } else if (it < 6050) {
      int l = it - 6048;
      u32x4* d = (u32x4*)((bf16_t*)(p.ws + OFF_WTIN) + ((size_t)l * NPAD_IN + 2592) * 1024);
      for (int i = tid; i < 96 * 1024 / 8; i += 256) d[i] = (u32x4){0u, 0u, 0u, 0u};
    } else if (it < 6434) {
      int r = it - 6050;
      mod_item(p, r / 192, r % 192, smem);
    } else {
      float* rc = (float*)(p.ws + OFF_ROPE);
      for (int i = tid; i < 1024; i += 256) {
        int pos = i >> 4, f = i & 15;
        float invf = powf(10000.f, -(float)f / 16.f);
        float ang = (float)pos * invf;
        rc[i] = cosf(ang);
        rc[1024 + i] = sinf(ang);
      }
    }
  }
}

DI void phase_prepB(const Params& p) {
  const float* MOD = (const float*)(p.ws + OFF_MOD);
  float* TAB = (float*)(p.ws + OFF_TAB);
  for (int i = blockIdx.x * 256 + tidx(); i < 2 * 17 * 1024; i += gridDim.x * 256) {
    int k = i & 1023, b = (i >> 10) % 17, l = i / (17 * 1024);
    const float* m = MOD + ((size_t)l * 17 + b) * 6144;
    float sh1 = m[k], sc1 = m[1024 + k], sh2 = m[3072 + k], sc2 = m[4096 + k];
    float g0 = (l == 0) ? 1.f : p.ln2_g[k], b0 = (l == 0) ? 0.f : p.ln2_b[k];
    float* t = TAB + (size_t)l * 4 * 17 * 1024 + b * 1024 + k;
    t[0 * 17 * 1024] = g0 * (1.f + sc1);
    t[1 * 17 * 1024] = b0 * (1.f + sc1) + sh1;
    t[2 * 17 * 1024] = p.ln1_g[l * 1024 + k] * (1.f + sc2);
    t[3 * 17 * 1024] = p.ln1_b[l * 1024 + k] * (1.f + sc2) + sh2;
  }
}

DI void row_stats(const float* st, float& mu, float& rs) {
  const f32x4* s4 = (const f32x4*)st;
  f32x4 a = s4[0], b = s4[1], c = s4[2], d = s4[3];
  float S = a.x + a.z + b.x + b.z + c.x + c.z + d.x + d.z;
  float SS = a.y + a.w + b.y + b.w + c.y + c.w + d.y + d.w;
  mu = S * (1.f / 1024.f);
  float var = fmaxf(SS * (1.f / 1024.f) - mu * mu, 0.f);
  rs = rsqrtf(var + 1e-5f);
}

template <int MODE>
DI void gemm_tile(const Params& p, int l, int tm, int tn, char* smem) {
  constexpr bool AF32 = (MODE == 0 || MODE == 2);
  constexpr int K = (MODE == 3) ? FH : 1024;
  constexpr int NK = K / 64;
  bf16_t* As = (bf16_t*)smem;
  bf16_t* Bs = As + 128 * 72;
  float* red = (float*)(Bs + 128 * 72);
  const int tid = tidx(), lane = tid & 63, wid = tid >> 6, wr = wid >> 1, wc = wid & 1, fr = lane & 15, fq = lane >> 4;
  const int row0 = tm * 128;
  const bool lat = row0 < NLAT;
  const int bidx = lat ? row0 / NSEQ : 16;
  float* Y1 = (float*)(p.ws + OFF_Y1);
  float* CTXY2 = (float*)(p.ws + OFF_CTXY2);
  const float* ST1 = (const float*)(p.ws + OFF_ST1);
  const float* ST2 = (const float*)(p.ws + OFF_ST2);
  bf16_t* P = (bf16_t*)(p.ws + OFF_P);
  const float* MOD = (const float*)(p.ws + OFF_MOD) + ((size_t)l * 17 + bidx) * 6144;
  const float* TAB = (const float*)(p.ws + OFF_TAB) + (size_t)l * 4 * 17 * 1024 + bidx * 1024;

  const float* asrc = nullptr;
  const bf16_t* absrc = nullptr;
  int astride = 0;
  const float* t1 = nullptr; const float* t2 = nullptr;
  float mu[8], rsd[8];
  if (MODE == 0) {
    if (l == 0) asrc = lat ? p.x + (size_t)row0 * 1024 : p.ctx + (size_t)(row0 - NLAT) * 1024;
    else asrc = lat ? p.out + (size_t)row0 * 1024 : CTXY2 + (size_t)(row0 - NLAT) * 1024;
    t1 = TAB; t2 = TAB + 17 * 1024;
#pragma unroll
    for (int i = 0; i < 8; ++i) {
      if (l == 0) { mu[i] = 0.f; rsd[i] = 1.f; }
      else row_stats(ST2 + (size_t)(row0 + (tid >> 4) + 16 * i) * 16, mu[i], rsd[i]);
    }
  } else if (MODE == 2) {
    asrc = Y1 + (size_t)row0 * 1024;
    t1 = TAB + 2 * 17 * 1024; t2 = TAB + 3 * 17 * 1024;
#pragma unroll
    for (int i = 0; i < 8; ++i) row_stats(ST1 + (size_t)(row0 + (tid >> 4) + 16 * i) * 16, mu[i], rsd[i]);
  } else if (MODE == 1) {
    absrc = P + (size_t)row0 * PC; astride = PC;
  } else {
    absrc = P + (size_t)row0 * FH; astride = FH;
  }
  const bf16_t* wt;
  if (MODE == 0) wt = (const bf16_t*)(p.ws + OFF_WTIN) + (size_t)l * NPAD_IN * 1024;
  else if (MODE == 1) wt = (const bf16_t*)(p.ws + OFF_WTOUT) + (size_t)l * 1024 * 1024;
  else if (MODE == 2) wt = (const bf16_t*)(p.ws + OFF_WTFI) + (size_t)l * 5632 * 1024;
  else wt = (const bf16_t*)(p.ws + OFF_WTFO) + (size_t)l * 1024 * FH;
  const bf16_t* bsrc = wt + (size_t)(tn * 128 + (tid >> 3)) * K + (tid & 7) * 8;

  f32x4 ra[8]; u32x4 rab[4]; u32x4 rb[4]; f32x4 rp1, rp2;
  auto gload = [&](int kt) __attribute__((always_inline)) {
    if (AF32) {
      const float* ap = asrc + (size_t)(tid >> 4) * 1024 + kt * 64 + (tid & 15) * 4;
#pragma unroll
      for (int i = 0; i < 8; ++i) ra[i] = *(const f32x4*)(ap + (size_t)i * 16 * 1024);
      rp1 = *(const f32x4*)(t1 + kt * 64 + (tid & 15) * 4);
      rp2 = *(const f32x4*)(t2 + kt * 64 + (tid & 15) * 4);
    } else {
      int kk = kt * 64;
      if (MODE == 1 && kk >= 384) kk += 1280;
      const bf16_t* ap = absrc + (size_t)(tid >> 3) * astride + kk + (tid & 7) * 8;
#pragma unroll
      for (int i = 0; i < 4; ++i) rab[i] = *(const u32x4*)(ap + (size_t)i * 32 * astride);
    }
#pragma unroll
    for (int i = 0; i < 4; ++i) rb[i] = *(const u32x4*)(bsrc + (size_t)i * 32 * K + kt * 64);
  };
  auto lstore = [&]() __attribute__((always_inline)) {
    if (AF32) {
#pragma unroll
      for (int i = 0; i < 8; ++i) {
        float a = rsd[i], m = mu[i];
        float v0 = (ra[i].x - m) * a * rp1.x + rp2.x;
        float v1 = (ra[i].y - m) * a * rp1.y + rp2.y;
        float v2 = (ra[i].z - m) * a * rp1.z + rp2.z;
        float v3 = (ra[i].w - m) * a * rp1.w + rp2.w;
        u32x2 u; u.x = pack2(v0, v1); u.y = pack2(v2, v3);
        *(u32x2*)(As + ((tid >> 4) + 16 * i) * 72 + (tid & 15) * 4) = u;
      }
    } else {
#pragma unroll
      for (int i = 0; i < 4; ++i) *(u32x4*)(As + ((tid >> 3) + 32 * i) * 72 + (tid & 7) * 8) = rab[i];
    }
#pragma unroll
    for (int i = 0; i < 4; ++i) *(u32x4*)(Bs + ((tid >> 3) + 32 * i) * 72 + (tid & 7) * 8) = rb[i];
  };

  f32x4 acc[4][4];
#pragma unroll
  for (int m = 0; m < 4; ++m)
#pragma unroll
    for (int n = 0; n < 4; ++n) acc[m][n] = (f32x4){0.f, 0.f, 0.f, 0.f};

  gload(0);
  for (int kt = 0; kt < NK; ++kt) {
    __syncthreads();
    lstore();
    __syncthreads();
    if (kt + 1 < NK) gload(kt + 1);
#pragma unroll
    for (int ks = 0; ks < 2; ++ks) {
      bf16x8 af[4], bf[4];
#pragma unroll
      for (int m = 0; m < 4; ++m) af[m] = *(const bf16x8*)(As + (wr * 64 + m * 16 + fr) * 72 + ks * 32 + fq * 8);
#pragma unroll
      for (int n = 0; n < 4; ++n) bf[n] = *(const bf16x8*)(Bs + (wc * 64 + n * 16 + fr) * 72 + ks * 32 + fq * 8);
#pragma unroll
      for (int m = 0; m < 4; ++m)
#pragma unroll
        for (int n = 0; n < 4; ++n) acc[m][n] = mfma16(bf[n], af[m], acc[m][n]);
    }
  }
  if (MODE == 0) {
    const int hs = tn * 2 + wc;
    if (hs > 40) return;
    const bool isq = (hs >= 30 && hs < 36), isk = (hs == 36 || hs == 37);
    if (isq || isk) {
      const float* nw = (isq ? p.qnorm_w : p.knorm_w) + l * 64;
      const float* rc = (const float*)(p.ws + OFF_ROPE);
      float w_[4][4];
#pragma unroll
      for (int n = 0; n < 4; ++n)
#pragma unroll
        for (int j = 0; j < 4; ++j) w_[n][j] = nw[n * 16 + fq * 4 + j];
#pragma unroll
      for (int m = 0; m < 4; ++m) {
        float ss = 0.f;
#pragma unroll
        for (int n = 0; n < 4; ++n)
#pragma unroll
          for (int j = 0; j < 4; ++j) ss += acc[m][n][j] * acc[m][n][j];
        ss += shx(ss, 16); ss += shx(ss, 32);
        float inv = rsqrtf(ss * (1.f / 64.f) + 1e-6f);
#pragma unroll
        for (int n = 0; n < 4; ++n)
#pragma unroll
          for (int j = 0; j < 4; ++j) acc[m][n][j] *= inv * w_[n][j];
        if (lat) {
          int t = (row0 + wr * 64 + m * 16 + fr) & (NSEQ - 1);
          int gr = t >> 6, gc = t & 63;
#pragma unroll
          for (int j = 0; j < 4; ++j) {
            float cr = rc[gr * 16 + fq * 4 + j], sr = rc[1024 + gr * 16 + fq * 4 + j];
            float cc = rc[gc * 16 + fq * 4 + j], sn = rc[1024 + gc * 16 + fq * 4 + j];
            float x1 = acc[m][0][j], x2 = acc[m][1][j], x3 = acc[m][2][j], x4 = acc[m][3][j];
            acc[m][0][j] = x1 * cr - x2 * sr; acc[m][1][j] = x2 * cr + x1 * sr;
            acc[m][2][j] = x3 * cc - x4 * sn; acc[m][3][j] = x4 * cc + x3 * sn;
          }
        }
      }
    }
    float scl = 1.f;
    if (hs < 6 || isq) scl = QSCALE;
    else if (hs == 18 || hs == 19) scl = 0.17677669529663687f;
    const int nmax = (hs == 40) ? 2 : 4;
#pragma unroll
    for (int m = 0; m < 4; ++m) {
      bf16_t* pr = P + (size_t)(row0 + wr * 64 + m * 16 + fr) * PC + hs * 64 + fq * 4;
#pragma unroll
      for (int n = 0; n < 4; ++n) {
        if (n < nmax) {
          u32x2 u; u.x = pack2(acc[m][n][0] * scl, acc[m][n][1] * scl); u.y = pack2(acc[m][n][2] * scl, acc[m][n][3] * scl);
          *(u32x2*)(pr + n * 16) = u;
        }
      }
    }
  } else if (MODE == 2) {
    bf16_t* H = P;
#pragma unroll
    for (int m = 0; m < 4; ++m) {
      bf16_t* hr = H + (size_t)(row0 + wr * 64 + m * 16 + fr) * FH + tn * 64 + wc * 32 + fq * 4;
#pragma unroll
      for (int n = 0; n < 2; ++n) {
        float h0 = siluf(acc[m][n][0]) * acc[m][n + 2][0], h1 = siluf(acc[m][n][1]) * acc[m][n + 2][1];
        float h2 = siluf(acc[m][n][2]) * acc[m][n + 2][2], h3 = siluf(acc[m][n][3]) * acc[m][n + 2][3];
        u32x2 u; u.x = pack2(h0, h1); u.y = pack2(h2, h3);
        *(u32x2*)(hr + n * 16) = u;
      }
    }
  } else {
    const float* gate = MOD + (MODE == 1 ? 2048 : 5120) + tn * 128 + wc * 64 + fq * 4;
    const float* lng = nullptr; const float* lnb = nullptr; const float* xs; const float* st = nullptr;
    float* dst; float* stout;
    bool doln;
    if (MODE == 1) {
      doln = (l == 1);
      if (l == 0) xs = lat ? p.x + (size_t)row0 * 1024 : p.ctx + (size_t)(row0 - NLAT) * 1024;
      else { xs = p.out + (size_t)row0 * 1024; st = ST2 + (size_t)row0 * 16; lng = p.ln2_g; lnb = p.ln2_b; }
      dst = Y1 + (size_t)row0 * 1024;
      stout = (float*)(p.ws + OFF_ST1) + (size_t)row0 * 16;
    } else {
      doln = true;
      xs = Y1 + (size_t)row0 * 1024; st = ST1 + (size_t)row0 * 16; lng = p.ln1_g + l * 1024; lnb = p.ln1_b + l * 1024;
      dst = lat ? p.out + (size_t)row0 * 1024 : CTXY2 + (size_t)(row0 - NLAT) * 1024;
      stout = (float*)(p.ws + OFF_ST2) + (size_t)row0 * 16;
    }
    const int cb = tn * 128 + wc * 64 + fq * 4;
    f32x4 gv[4], lg[4], lb[4];
#pragma unroll
    for (int n = 0; n < 4; ++n) {
      gv[n] = *(const f32x4*)(gate + n * 16);
      if (doln) { lg[n] = *(const f32x4*)(lng + cb + n * 16); lb[n] = *(const f32x4*)(lnb + cb + n * 16); }
    }
#pragma unroll
    for (int m = 0; m < 4; ++m) {
      const int rl = wr * 64 + m * 16 + fr;
      float rmu = 0.f, rrs = 1.f;
      if (doln) row_stats(st + (size_t)rl * 16, rmu, rrs);
      float s = 0.f, ss = 0.f;
#pragma unroll
      for (int n = 0; n < 4; ++n) {
        f32x4 xv = *(const f32x4*)(xs + (size_t)rl * 1024 + cb + n * 16);
        if (doln) {
          xv.x = (xv.x - rmu) * rrs * lg[n].x + lb[n].x; xv.y = (xv.y - rmu) * rrs * lg[n].y + lb[n].y;
          xv.z = (xv.z - rmu) * rrs * lg[n].z + lb[n].z; xv.w = (xv.w - rmu) * rrs * lg[n].w + lb[n].w;
        }
        f32x4 o;
        o.x = ALPHA * xv.x + gv[n].x * acc[m][n][0]; o.y = ALPHA * xv.y + gv[n].y * acc[m][n][1];
        o.z = ALPHA * xv.z + gv[n].z * acc[m][n][2]; o.w = ALPHA * xv.w + gv[n].w * acc[m][n][3];
        *(f32x4*)(dst + (size_t)rl * 1024 + cb + n * 16) = o;
        s += o.x + o.y + o.z + o.w;
        ss += o.x * o.x + o.y * o.y + o.z * o.z + o.w * o.w;
      }
      s += shx(s, 16); s += shx(s, 32);
      ss += shx(ss, 16); ss += shx(ss, 32);
      if (fq == 0) { red[((wr * 2 + wc) * 64 + m * 16 + fr) * 2] = s; red[((wr * 2 + wc) * 64 + m * 16 + fr) * 2 + 1] = ss; }
    }
    __syncthreads();
    if (tid < 128) {
      int r = tid, w_ = r >> 6, rr = r & 63;
      float s = red[((w_ * 2 + 0) * 64 + rr) * 2] + red[((w_ * 2 + 1) * 64 + rr) * 2];
      float ss = red[((w_ * 2 + 0) * 64 + rr) * 2 + 1] + red[((w_ * 2 + 1) * 64 + rr) * 2 + 1];
      *(f32x2*)(stout + (size_t)r * 16 + tn * 2) = (f32x2){s, ss};
    }
  }
}

template <int MODE>
DI void phase_gemm(const Params& p, int l, char* smem) {
  const int NT = (MODE == 0) ? 21 : (MODE == 2 ? 44 : 8);
  const int MT = (l == 0 || MODE == 0) ? 288 : 256;
  for (int t = blockIdx.x; t < MT * NT; t += gridDim.x) gemm_tile<MODE>(p, l, t / NT, t % NT, smem);
}

DI void attn_item(const Params& p, int qrow0, int qcol, int kcol, int vcol, int lat_row0, int nb_lat, int ctx_row0, int nb_ctx,
                  bool na, int dr0, const float* rpb_h, char* smem) {
  bf16_t* Ks = (bf16_t*)smem;
  bf16_t* Vt = Ks + 64 * 72;
  float* rpbs = (float*)(Vt + 64 * 68);
  const int tid = tidx(), lane = tid & 63, w = tid >> 6, fr = lane & 15, fq = lane >> 4;
  bf16_t* P = (bf16_t*)(p.ws + OFF_P);
  __syncthreads();
  if (na) for (int i = tid; i < 465; i += 256) rpbs[i] = rpb_h[i] * LOG2E;
  bf16x8 qf[2];
  {
    const bf16_t* qp = P + (size_t)(qrow0 + w * 16 + fr) * PC + qcol + fq * 8;
    qf[0] = *(const bf16x8*)qp; qf[1] = *(const bf16x8*)(qp + 32);
  }
  f32x4 o[4];
#pragma unroll
  for (int i = 0; i < 4; ++i) o[i] = (f32x4){0.f, 0.f, 0.f, 0.f};
  float mrun = -1e30f, lrun = 0.f;
  const int nb = nb_lat + nb_ctx;
  u32x4 rk[2], rv[2];
  auto gload = [&](int kb) __attribute__((always_inline)) {
    int rb = kb < nb_lat ? lat_row0 + kb * 64 : ctx_row0 + (kb - nb_lat) * 64;
#pragma unroll
    for (int i = 0; i < 2; ++i) {
      int c = tid + i * 256;
      const bf16_t* rp = P + (size_t)(rb + (c >> 3)) * PC + (c & 7) * 8;
      rk[i] = *(const u32x4*)(rp + kcol);
      rv[i] = *(const u32x4*)(rp + vcol);
    }
  };
  gload(0);
  const int qj = w * 16 + fr;
  const int cs = min(max(qj - 8, 0), 48);
  for (int kb = 0; kb < nb; ++kb) {
    __syncthreads();
#pragma unroll
    for (int i = 0; i < 2; ++i) {
      int c = tid + i * 256, key = c >> 3, dc = c & 7;
      *(u32x4*)(Ks + key * 72 + dc * 8) = rk[i];
      unsigned vv[4] = {rv[i].x, rv[i].y, rv[i].z, rv[i].w};
#pragma unroll
      for (int e = 0; e < 4; ++e) {
        Vt[(dc * 8 + 2 * e) * 68 + key] = (bf16_t)(vv[e] & 0xffffu);
        Vt[(dc * 8 + 2 * e + 1) * 68 + key] = (bf16_t)(vv[e] >> 16);
      }
    }
    __syncthreads();
    if (kb + 1 < nb) gload(kb + 1);
    f32x4 s[4];
#pragma unroll
    for (int mt = 0; mt < 4; ++mt) {
      s[mt] = (f32x4){0.f, 0.f, 0.f, 0.f};
#pragma unroll
      for (int ks = 0; ks < 2; ++ks) {
        bf16x8 kf = *(const bf16x8*)(Ks + (mt * 16 + fr) * 72 + ks * 32 + fq * 8);
        s[mt] = mfma16(kf, qf[ks], s[mt]);
      }
    }
    if (na && kb < nb_lat) {
#pragma unroll
      for (int mt = 0; mt < 4; ++mt)
#pragma unroll
        for (int j = 0; j < 4; ++j) {
          int kc = mt * 16 + fq * 4 + j;
          bool valid = (kc >= cs) && (kc < cs + 16);
          int bi = min(max(kc - qj, -15), 15);
          s[mt][j] = valid ? s[mt][j] + rpbs[(dr0 + kb) * 31 + bi + 15] : -1e30f;
        }
    }
    float mx = -1e30f;
#pragma unroll
    for (int mt = 0; mt < 4; ++mt)
#pragma unroll
      for (int j = 0; j < 4; ++j) mx = fmaxf(mx, s[mt][j]);
    mx = fmaxf(mx, shx(mx, 16)); mx = fmaxf(mx, shx(mx, 32));
    float mnew = fmaxf(mrun, mx);
    float alpha = exp2f(mrun - mnew);
    mrun = mnew;
    float ps = 0.f;
#pragma unroll
    for (int mt = 0; mt < 4; ++mt)
#pragma unroll
      for (int j = 0; j < 4; ++j) { float e = exp2f(s[mt][j] - mnew); s[mt][j] = e; ps += e; }
    lrun = lrun * alpha + ps;
#pragma unroll
    for (int i = 0; i < 4; ++i) { o[i][0] *= alpha; o[i][1] *= alpha; o[i][2] *= alpha; o[i][3] *= alpha; }
#pragma unroll
    for (int kp = 0; kp < 2; ++kp) {
      unsigned pk[4];
      pk[0] = pack2(s[2 * kp][0], s[2 * kp][1]); pk[1] = pack2(s[2 * kp][2], s[2 * kp][3]);
      pk[2] = pack2(s[2 * kp + 1][0], s[2 * kp + 1][1]); pk[3] = pack2(s[2 * kp + 1][2], s[2 * kp + 1][3]);
      bf16x8 pf = __builtin_bit_cast(bf16x8, pk);
#pragma unroll
      for (int dt = 0; dt < 4; ++dt) {
        const bf16_t* vp = Vt + (dt * 16 + fr) * 68 + kp * 32 + fq * 4;
        s16x4 lo = *(const s16x4*)vp, hi = *(const s16x4*)(vp + 16);
        bf16x8 vf = __builtin_shufflevector(lo, hi, 0, 1, 2, 3, 4, 5, 6, 7);
        o[dt] = mfma16(vf, pf, o[dt]);
      }
    }
  }
  lrun += shx(lrun, 16); lrun += shx(lrun, 32);
  float inv = 1.f / lrun;
  bf16_t* op = P + (size_t)(qrow0 + w * 16 + fr) * PC + qcol + fq * 4;
#pragma unroll
  for (int dt = 0; dt < 4; ++dt) {
    u32x2 u; u.x = pack2(o[dt][0] * inv, o[dt][1] * inv); u.y = pack2(o[dt][2] * inv, o[dt][3] * inv);
    *(u32x2*)(op + dt * 16) = u;
  }
}

DI float logsig(float z) { return fminf(z, 0.f) - log1pf(expf(-fabsf(z))); }
DI int chunk_row0(int b, int cidx) { return cidx < 4 ? NLAT + b * LC + cidx * 64 : b * NSEQ + (cidx - 4) * 64; }
DI int chain_pos(int cidx, int dir) { return dir == 0 ? cidx : (cidx < 4 ? 3 - cidx : 39 - cidx); }

DI void gla_gates(const Params& p, int l, int h, int dir, int row0, float* bs, float* lrs, float* was, float* segt) {
  const int tid = tidx();
  const bf16_t* P = (const bf16_t*)(p.ws + OFF_P);
  {
    int s = tid >> 2, r4 = (tid & 3) * 4;
    u32x2 u = *(const u32x2*)(P + (size_t)(row0 + s) * PC + C_GLR + dir * 16 + r4);
    lrs[s * 17 + r4] = bflo(u.x); lrs[s * 17 + r4 + 1] = bfhi(u.x); lrs[s * 17 + r4 + 2] = bflo(u.y); lrs[s * 17 + r4 + 3] = bfhi(u.y);
    for (int i = tid; i < 512; i += 256) was[i] = p.gla_wa2[(((size_t)l * 2 + dir) * 16 + (i >> 5)) * 128 + h * 32 + (i & 31)];
  }
  __syncthreads();
  const int d = tid & 31, sg = tid >> 5;
  const float ba = p.gla_ba[(l * 2 + dir) * 128 + h * 32 + d];
  float la[8];
#pragma unroll
  for (int i = 0; i < 8; ++i) {
    int s = sg * 8 + i;
    float z = ba;
#pragma unroll
    for (int r = 0; r < 16; ++r) z += lrs[s * 17 + r] * was[r * 32 + d];
    la[i] = logsig(z) * (1.f / 16.f);
  }
  if (dir == 0) {
#pragma unroll
    for (int i = 1; i < 8; ++i) la[i] += la[i - 1];
    segt[sg * 32 + d] = la[7];
  } else {
#pragma unroll
    for (int i = 6; i >= 0; --i) la[i] += la[i + 1];
    segt[sg * 32 + d] = la[0];
  }
  __syncthreads();
  float pre = 0.f;
#pragma unroll
  for (int g = 0; g < 8; ++g) {
    float v = segt[g * 32 + d];
    if (dir == 0 ? (g < sg) : (g > sg)) pre += v;
  }
#pragma unroll
  for (int i = 0; i < 8; ++i) bs[(sg * 8 + i) * 33 + d] = la[i] + pre;
  __syncthreads();
}

DI void gla_passA(const Params& p, int l, int item, char* smem) {
  float* bs = (float*)smem;
  float* kw = bs + 64 * 33;
  float* vs = kw + 64 * 32;
  float* lrs = vs + 64 * 64;
  float* was = lrs + 64 * 17;
  float* segt = was + 512;
  const int tid = tidx();
  int dir = item & 1, cidx = (item >> 1) % 36, bh = item / 72, h = bh & 3, b = bh >> 2;
  const int row0 = chunk_row0(b, cidx);
  const bf16_t* P = (const bf16_t*)(p.ws + OFF_P);
  __syncthreads();
  gla_gates(p, l, h, dir, row0, bs, lrs, was, segt);
  {
    int s = tid >> 2, d8 = (tid & 3) * 8;
    u32x4 u = *(const u32x4*)(P + (size_t)(row0 + s) * PC + C_GLK + h * 32 + d8);
    unsigned uu[4] = {u.x, u.y, u.z, u.w};
    const int slast = dir == 0 ? 63 : 0;
#pragma unroll
    for (int e = 0; e < 4; ++e) {
      int d0 = d8 + 2 * e;
      kw[s * 32 + d0] = bflo(uu[e]) * __expf(bs[slast * 33 + d0] - bs[s * 33 + d0]);
      kw[s * 32 + d0 + 1] = bfhi(uu[e]) * __expf(bs[slast * 33 + d0 + 1] - bs[s * 33 + d0 + 1]);
    }
    int v16 = (tid & 3) * 16;
#pragma unroll
    for (int q = 0; q < 2; ++q) {
      u32x4 w = *(const u32x4*)(P + (size_t)(row0 + s) * PC + C_GLV + h * 64 + v16 + q * 8);
      unsigned ww[4] = {w.x, w.y, w.z, w.w};
#pragma unroll
      for (int e = 0; e < 4; ++e) { vs[s * 64 + v16 + q * 8 + 2 * e] = bflo(ww[e]); vs[s * 64 + v16 + q * 8 + 2 * e + 1] = bfhi(ww[e]); }
    }
  }
  __syncthreads();
  const int v = tid & 63, dg = (tid >> 6) * 8;
  float acc[8];
#pragma unroll
  for (int i = 0; i < 8; ++i) acc[i] = 0.f;
  for (int s = 0; s < 64; ++s) {
    float vv = vs[s * 64 + v];
    f32x4 k0 = *(const f32x4*)(kw + s * 32 + dg), k1 = *(const f32x4*)(kw + s * 32 + dg + 4);
    acc[0] += k0.x * vv; acc[1] += k0.y * vv; acc[2] += k0.z * vv; acc[3] += k0.w * vv;
    acc[4] += k1.x * vv; acc[5] += k1.y * vv; acc[6] += k1.z * vv; acc[7] += k1.w * vv;
  }
  const int pos = chain_pos(cidx, dir);
  float* LS = (float*)(p.ws + OFF_LS) + ((size_t)((b * 4 + h) * 2 + dir) * 36 + pos) * 2048;
#pragma unroll
  for (int i = 0; i < 8; ++i) LS[(dg + i) * 64 + v] = acc[i];
  if (tid < 32) {
    float* BL = (float*)(p.ws + OFF_BL) + ((size_t)((b * 4 + h) * 2 + dir) * 36 + pos) * 32;
    BL[tid] = bs[(dir == 0 ? 63 : 0) * 33 + tid];
  }
}

DI void gla_passB(const Params& p, int l, int b, int h, int cidx, char* smem) {
  float* bs = (float*)smem;
  float* qe = bs + 64 * 33;
  float* ke = qe + 64 * 36;
  float* vs = ke + 64 * 36;
  float* S0s = vs + 64 * 64;
  float* Am = S0s + 32 * 64;
  float* lrs = Am;
  float* was = lrs + 64 * 17;
  float* segt = was + 512;
  const int tid = tidx();
  const int row0 = chunk_row0(b, cidx);
  bf16_t* P = (bf16_t*)(p.ws + OFF_P);
  const int ty = tid >> 4, tx = tid & 15;
  float o[4][4];
#pragma unroll
  for (int i = 0; i < 4; ++i)
#pragma unroll
    for (int j = 0; j < 4; ++j) o[i][j] = 0.f;
  __syncthreads();
  {
    int s = tid >> 2, v16 = (tid & 3) * 16;
#pragma unroll
    for (int q = 0; q < 2; ++q) {
      u32x4 w = *(const u32x4*)(P + (size_t)(row0 + s) * PC + C_GLV + h * 64 + v16 + q * 8);
      unsigned ww[4] = {w.x, w.y, w.z, w.w};
#pragma unroll
      for (int e = 0; e < 4; ++e) { vs[s * 64 + v16 + q * 8 + 2 * e] = bflo(ww[e]); vs[s * 64 + v16 + q * 8 + 2 * e + 1] = bfhi(ww[e]); }
    }
  }
  for (int dir = 0; dir < 2; ++dir) {
    gla_gates(p, l, h, dir, row0, bs, lrs, was, segt);
    {
      int s = tid >> 2, d8 = (tid & 3) * 8;
      u32x4 uq = *(const u32x4*)(P + (size_t)(row0 + s) * PC + C_GLQ + h * 32 + d8);
      u32x4 uk = *(const u32x4*)(P + (size_t)(row0 + s) * PC + C_GLK + h * 32 + d8);
      unsigned q_[4] = {uq.x, uq.y, uq.z, uq.w}, k_[4] = {uk.x, uk.y, uk.z, uk.w};
#pragma unroll
      for (int e = 0; e < 4; ++e) {
        int d0 = d8 + 2 * e;
        float b0 = bs[s * 33 + d0], b1 = bs[s * 33 + d0 + 1];
        qe[s * 36 + d0] = bflo(q_[e]) * __expf(b0); qe[s * 36 + d0 + 1] = bfhi(q_[e]) * __expf(b1);
        ke[s * 36 + d0] = bflo(k_[e]) * __expf(-b0); ke[s * 36 + d0 + 1] = bfhi(k_[e]) * __expf(-b1);
      }
      const int pos = chain_pos(cidx, dir);
      const float* LS = (const float*)(p.ws + OFF_LS) + (size_t)((b * 4 + h) * 2 + dir) * 36 * 2048;
      const float* BL = (const float*)(p.ws + OFF_BL) + (size_t)((b * 4 + h) * 2 + dir) * 36 * 32;
      const int v = tid & 63, dg = (tid >> 6) * 8;
      float S[8];
#pragma unroll
      for (int i = 0; i < 8; ++i) S[i] = 0.f;
      for (int pp = 0; pp < pos; ++pp) {
#pragma unroll
        for (int i = 0; i < 8; ++i) S[i] = __expf(BL[pp * 32 + dg + i]) * S[i] + LS[(size_t)pp * 2048 + (dg + i) * 64 + v];
      }
#pragma unroll
      for (int i = 0; i < 8; ++i) S0s[(dg + i) * 64 + v] = S[i];
    }
    __syncthreads();
    {
      float a[4][4];
#pragma unroll
      for (int i = 0; i < 4; ++i)
#pragma unroll
        for (int j = 0; j < 4; ++j) a[i][j] = 0.f;
#pragma unroll 2
      for (int d = 0; d < 32; d += 4) {
        f32x4 qv[4], kv[4];
#pragma unroll
        for (int i = 0; i < 4; ++i) { qv[i] = *(const f32x4*)(qe + (ty * 4 + i) * 36 + d); kv[i] = *(const f32x4*)(ke + (tx * 4 + i) * 36 + d); }
#pragma unroll
        for (int i = 0; i < 4; ++i)
#pragma unroll
          for (int j = 0; j < 4; ++j) a[i][j] += qv[i].x * kv[j].x + qv[i].y * kv[j].y + qv[i].z * kv[j].z + qv[i].w * kv[j].w;
      }
#pragma unroll
      for (int i = 0; i < 4; ++i) {
        int t = ty * 4 + i;
        f32x4 r;
        float* rr = (float*)&r;
#pragma unroll
        for (int j = 0; j < 4; ++j) { int s = tx * 4 + j; bool keep = dir == 0 ? (s <= t) : (s >= t); rr[j] = keep ? a[i][j] : 0.f; }
        *(f32x4*)(Am + t * 68 + tx * 4) = r;
      }
    }
    __syncthreads();
    {
#pragma unroll 2
      for (int s = 0; s < 64; s += 4) {
        f32x4 av[4], vv[4];
#pragma unroll
        for (int i = 0; i < 4; ++i) { av[i] = *(const f32x4*)(Am + (ty * 4 + i) * 68 + s); vv[i] = *(const f32x4*)(vs + (s + i) * 64 + tx * 4); }
#pragma unroll
        for (int i = 0; i < 4; ++i) {
          o[i][0] += av[i].x * vv[0].x + av[i].y * vv[1].x + av[i].z * vv[2].x + av[i].w * vv[3].x;
          o[i][1] += av[i].x * vv[0].y + av[i].y * vv[1].y + av[i].z * vv[2].y + av[i].w * vv[3].y;
          o[i][2] += av[i].x * vv[0].z + av[i].y * vv[1].z + av[i].z * vv[2].z + av[i].w * vv[3].z;
          o[i][3] += av[i].x * vv[0].w + av[i].y * vv[1].w + av[i].z * vv[2].w + av[i].w * vv[3].w;
        }
      }
#pragma unroll 2
      for (int d = 0; d < 32; d += 4) {
        f32x4 av[4], vv[4];
#pragma unroll
        for (int i = 0; i < 4; ++i) { av[i] = *(const f32x4*)(qe + (ty * 4 + i) * 36 + d); vv[i] = *(const f32x4*)(S0s + (d + i) * 64 + tx * 4); }
#pragma unroll
        for (int i = 0; i < 4; ++i) {
          o[i][0] += av[i].x * vv[0].x + av[i].y * vv[1].x + av[i].z * vv[2].x + av[i].w * vv[3].x;
          o[i][1] += av[i].x * vv[0].y + av[i].y * vv[1].y + av[i].z * vv[2].y + av[i].w * vv[3].y;
          o[i][2] += av[i].x * vv[0].z + av[i].y * vv[1].z + av[i].z * vv[2].z + av[i].w * vv[3].z;
          o[i][3] += av[i].x * vv[0].w + av[i].y * vv[1].w + av[i].z * vv[2].w + av[i].w * vv[3].w;
        }
      }
    }
    __syncthreads();
  }
  const f32x4 nw = *(const f32x4*)(p.gla_norm_w + l * 64 + tx * 4);
#pragma unroll
  for (int i = 0; i < 4; ++i) {
    float ss = o[i][0] * o[i][0] + o[i][1] * o[i][1] + o[i][2] * o[i][2] + o[i][3] * o[i][3];
    ss += shx(ss, 1); ss += shx(ss, 2); ss += shx(ss, 4); ss += shx(ss, 8);
    float inv = rsqrtf(ss * (1.f / 64.f) + 1e-6f);
    bf16_t* gp = P + (size_t)(row0 + ty * 4 + i) * PC + C_GLG + h * 64 + tx * 4;
    u32x2 g = *(const u32x2*)gp;
    u32x2 u;
    u.x = pack2(o[i][0] * inv * nw.x * siluf(bflo(g.x)), o[i][1] * inv * nw.y * siluf(bfhi(g.x)));
    u.y = pack2(o[i][2] * inv * nw.z * siluf(bflo(g.y)), o[i][3] * inv * nw.w * siluf(bfhi(g.y)));
    *(u32x2*)gp = u;
  }
}

DI void phase_mixA(const Params& p, int l, char* smem) {
  const int NGQA = NB * 6 * 32, NGLA = NB * 4 * 36 * 2;
  for (int it = blockIdx.x; it < NGQA + NGLA; it += gridDim.x) {
    if (it < NGQA) {
      int b = it / 192, rem = it % 192, h = rem >> 5, qt = rem & 31, g = h / 3;
      attn_item(p, b * NSEQ + qt * 64, C_GAQ + h * 64, C_GAK + g * 64, C_GAV + g * 64, b * NSEQ, 32, NLAT + b * LC, 4, false, 0, nullptr, smem);
    } else gla_passA(p, l, it - NGQA, smem);
  }
}
DI void phase_mixB(const Params& p, int l, char* smem) {
  const int cpl = (l == 0) ? 36 : 32;
  const int NGLB = NB * 4 * cpl, NNA = NB * 6 * 32, NCA = (l == 0) ? NB * 12 * 4 : 0;
  for (int it = blockIdx.x; it < NGLB + NNA + NCA; it += gridDim.x) {
    if (it < NGLB) {
      int cc = it % cpl, bh = it / cpl;
      gla_passB(p, l, bh >> 2, bh & 3, cc + (36 - cpl), smem);
    } else if (it < NGLB + NNA) {
      int i = it - NGLB, b = i / 192, rem = i % 192, h = rem >> 5, r = rem & 31;
      int rs = min(max(r - 4, 0), 24);
      attn_item(p, b * NSEQ + r * 64, C_NAQ + h * 64, C_NAK + h * 64, C_NAV + h * 64, b * NSEQ + rs * 64, 8, NLAT + b * LC, 4, true, rs - r + 7,
                p.na_rpb + ((size_t)l * 6 + h) * 465, smem);
    } else {
      int i = it - NGLB - NNA, b = i / 48, rem = i % 48, hh = rem >> 2, qt = rem & 3;
      int qcol, kcol, vcol;
      if (hh < 6) { qcol = C_NAQ + hh * 64; kcol = C_NAK + hh * 64; vcol = C_NAV + hh * 64; }
      else { int h = hh - 6, g = h / 3; qcol = C_GAQ + h * 64; kcol = C_GAK + g * 64; vcol = C_GAV + g * 64; }
      attn_item(p, NLAT + b * LC + qt * 64, qcol, kcol, vcol, 0, 0, NLAT + b * LC, 4, false, 0, nullptr, smem);
    }
  }
}

DI void phase_final(const Params& p) {
  const int lane = tidx() & 63, w = tidx() >> 6;
  const float* g = p.ln2_g + 1024; const float* bb = p.ln2_b + 1024;
  for (int r = blockIdx.x * 4 + w; r < NLAT; r += gridDim.x * 4) {
    float* row = p.out + (size_t)r * 1024;
    f32x4 v[4];
    float s = 0.f;
#pragma unroll
    for (int i = 0; i < 4; ++i) { v[i] = *(const f32x4*)(row + i * 256 + lane * 4); s += v[i].x + v[i].y + v[i].z + v[i].w; }
#pragma unroll
    for (int m = 1; m < 64; m <<= 1) s += shx(s, m);
    float mu = s * (1.f / 1024.f), ss = 0.f;
#pragma unroll
    for (int i = 0; i < 4; ++i) { float a = v[i].x - mu, b = v[i].y - mu, c = v[i].z - mu, d = v[i].w - mu; ss += a * a + b * b + c * c + d * d; }
#pragma unroll
    for (int m = 1; m < 64; m <<= 1) ss += shx(ss, m);
    float rs = rsqrtf(ss * (1.f / 1024.f) + 1e-5f);
#pragma unroll
    for (int i = 0; i < 4; ++i) {
      f32x4 gg = *(const f32x4*)(g + i * 256 + lane * 4), be = *(const f32x4*)(bb + i * 256 + lane * 4), o;
      o.x = (v[i].x - mu) * rs * gg.x + be.x; o.y = (v[i].y - mu) * rs * gg.y + be.y;
      o.z = (v[i].z - mu) * rs * gg.z + be.z; o.w = (v[i].w - mu) * rs * gg.w + be.w;
      *(f32x4*)(row + i * 256 + lane * 4) = o;
    }
  }
}

__global__ void __launch_bounds__(256, 2) mega(Params p) {
  extern __shared__ __attribute__((aligned(16))) char smem[];
  cg::grid_group grid = cg::this_grid();
  for (int ph = p.ph_lo; ph < p.ph_hi; ++ph) {
    if (ph > p.ph_lo) grid.sync();
    if (ph == 0) { if (PM & 1) phase_prepA(p, smem); }
    else if (ph == 1) { if (PM & 2) phase_prepB(p); }
    else if (ph == 14) { if (PM & 4) phase_final(p); }
    else {
      int l = (ph - 2) / 6, s = (ph - 2) % 6;
      if (s == 0) { if (PM & 8) phase_gemm<0>(p, l, smem); }
      else if (s == 1) { if (PM & 16) phase_mixA(p, l, smem); }
      else if (s == 2) { if (PM & 32) phase_mixB(p, l, smem); }
      else if (s == 3) { if (PM & 64) phase_gemm<1>(p, l, smem); }
      else if (s == 4) { if (PM & 128) phase_gemm<2>(p, l, smem); }
      else { if (PM & 256) phase_gemm<3>(p, l, smem); }
    }
  }
}

extern "C" void kernel_launch(void* const* d_in, const int* in_sizes, int n_in, void* d_out, int out_size, void* d_ws, size_t ws_size,
                              hipStream_t stream) {
  static int grid = 0;
  if (grid == 0) {
    if (n_in != 20 || out_size != NLAT * 1024 || ws_size < WS_END) {
      fprintf(stderr, "kernel_launch: unexpected shapes (n_in %d out %d ws %zu need %zu)\n", n_in, out_size, ws_size, (size_t)WS_END);
      grid = -1; return;
    }
    int dev = 0, cus = 0, per = 0;
    hipGetDevice(&dev);
    hipDeviceGetAttribute(&cus, hipDeviceAttributeMultiprocessorCount, dev);
    hipFuncSetAttribute((const void*)mega, hipFuncAttributeMaxDynamicSharedMemorySize, SMEM_BYTES);
    hipOccupancyMaxActiveBlocksPerMultiprocessor(&per, (const void*)mega, 256, SMEM_BYTES);
    if (per < 1) per = 1;
    if (per > 2) per = 2;
    grid = cus * per;
  }
  if (grid < 0) return;
  Params p{};
  const float** pp = (const float**)&p;
  for (int i = 0; i < 20; ++i) pp[i] = (const float*)d_in[i];
  p.out = (float*)d_out; p.ws = (char*)d_ws;
#if ONE_LAUNCH
  p.ph_lo = 0; p.ph_hi = NPHASE;
  void* args[] = {&p};
  hipError_t e = hipLaunchCooperativeKernel((const void*)mega, dim3(grid), dim3(256), args, SMEM_BYTES, stream);
  if (e != hipSuccess) fprintf(stderr, "cooperative launch failed: %s (grid %d)\n", hipGetErrorString(e), grid);
#else
  for (int ph = 0; ph < NPHASE; ++ph) {
    p.ph_lo = ph; p.ph_hi = ph + 1;
    hipLaunchKernelGGL(mega, dim3(grid), dim3(256), SMEM_BYTES, stream, p);
  }
#endif
}
```

```cpp
#include <hip/hip_runtime.h>
#include <hip/hip_cooperative_groups.h>
#include <cstdio>
#include <cstdint>
namespace cg = cooperative_groups;

#ifndef PM
#define PM 0x1ff
#endif
#ifndef DUP
#define DUP 0
#endif
#ifndef ONE_LAUNCH
#define ONE_LAUNCH 1
#endif

typedef unsigned short bf16_t;
typedef short bf16x8 __attribute__((ext_vector_type(8)));
typedef short s16x4 __attribute__((ext_vector_type(4)));
typedef float f32x4 __attribute__((ext_vector_type(4)));
typedef float f32x2 __attribute__((ext_vector_type(2)));
typedef unsigned u32x4 __attribute__((ext_vector_type(4)));
typedef unsigned u32x2 __attribute__((ext_vector_type(2)));
#define DI __device__ __forceinline__

constexpr int NB = 16, NSEQ = 2048, LC = 256, DM = 1024;
constexpr int NLAT = NB * NSEQ;
constexpr int NCTX = NB * LC;
constexpr int NROWS = NLAT + NCTX;
constexpr int PC = 2592;
constexpr int NPAD_IN = 2688;
constexpr int FH = 2816;
constexpr int C_NAQ = 0, C_NAK = 384, C_NAV = 768, C_GLQ = 1152, C_GLK = 1280, C_GLV = 1408, C_GLG = 1664,
              C_GAQ = 1920, C_GAK = 2304, C_GAV = 2432, C_GLR = 2560;
constexpr float ALPHA = 1.41421356237f;
constexpr float LOG2E = 1.44269504089f;
constexpr float QSCALE = 0.125f * LOG2E;

constexpr size_t al256(size_t x) { return (x + 255) & ~(size_t)255; }
constexpr size_t OFF_WTIN = 0;
constexpr size_t OFF_WTOUT = OFF_WTIN + al256((size_t)2 * NPAD_IN * 1024 * 2);
constexpr size_t OFF_WTFI = OFF_WTOUT + al256((size_t)2 * 1024 * 1024 * 2);
constexpr size_t OFF_WTFO = OFF_WTFI + al256((size_t)2 * 5632 * 1024 * 2);
constexpr size_t OFF_MOD = OFF_WTFO + al256((size_t)2 * 1024 * FH * 2);
constexpr size_t OFF_TAB = OFF_MOD + al256((size_t)2 * 17 * 6144 * 4);
constexpr size_t OFF_ROPE = OFF_TAB + al256((size_t)2 * 4 * 17 * 1024 * 4);
constexpr size_t OFF_ST1 = OFF_ROPE + al256((size_t)2 * 64 * 16 * 4);
constexpr size_t OFF_ST2 = OFF_ST1 + al256((size_t)NROWS * 16 * 4);
constexpr size_t OFF_LS = OFF_ST2 + al256((size_t)NROWS * 16 * 4);
constexpr size_t OFF_BL = OFF_LS + al256((size_t)NB * 4 * 2 * 36 * 2048 * 4);
constexpr size_t OFF_CTXY2 = OFF_BL + al256((size_t)NB * 4 * 2 * 36 * 32 * 4);
constexpr size_t OFF_UF = OFF_LS;
constexpr size_t OFF_Y1 = OFF_UF + al256((size_t)NROWS * 1024 * 2);
constexpr size_t OFF_P = OFF_Y1 + al256((size_t)NROWS * 1024 * 4);
constexpr size_t OFF_BAR = OFF_P + al256((size_t)NROWS * FH * 2);
constexpr size_t BAR_BYTES = 16384;
constexpr size_t WS_END = OFF_BAR + BAR_BYTES;

constexpr int SMEM_BYTES = 72 * 1024;
constexpr int NPHASE = 18;

struct Params {
  const float *x, *c, *ctx, *c_ctx, *w_ada, *b_ada, *w_in, *na_rpb, *gla_wa2, *gla_ba, *gla_norm_w, *qnorm_w, *knorm_w,
      *w_out, *ln1_g, *ln1_b, *w_ffn_in, *w_ffn_out, *ln2_g, *ln2_b;
  float* out;
  char* ws;
  int ph_lo, ph_hi;
};

DI unsigned pack2(float lo, float hi) {
  unsigned r;
  asm("v_cvt_pk_bf16_f32 %0, %1, %2" : "=v"(r) : "v"(lo), "v"(hi));
  return r;
}
DI bf16_t f2bf(float f) { return (bf16_t)(pack2(f, 0.f) & 0xffffu); }
DI float bf2f(unsigned h) { return __uint_as_float(h << 16); }
DI float bflo(unsigned u) { return __uint_as_float(u << 16); }
DI float bfhi(unsigned u) { return __uint_as_float(u & 0xffff0000u); }
DI f32x4 mfma16(bf16x8 a, bf16x8 b, f32x4 c) { return __builtin_amdgcn_mfma_f32_16x16x32_bf16(a, b, c, 0, 0, 0); }
DI float siluf(float x) { return x / (1.f + __expf(-x)); }
DI int tidx() { int t = threadIdx.x; asm volatile("" : "+v"(t)); return t; }
DI float shx(float v, int m) { return __shfl_xor(v, m, 64); }

DI int dest_row(int kind, int n) {
  if (kind == 0) return n < 1920 ? n : (n < 1952 ? n + 640 : n - 32);
  if (kind == 2) { int q = n / FH, hd = n - q * FH; return (hd >> 6) * 128 + ((hd >> 5) & 1) * 64 + q * 32 + (hd & 31); }
  return n;
}

DI void wt_tile(const float* __restrict__ src, int K, int N, int kt, int nt, bf16_t* __restrict__ dst, int dstStride, int kind, char* smem) {
  float* tile = (float*)smem;
  const int tid = tidx(), k0 = kt * 64, n0 = nt * 64;
#pragma unroll 4
  for (int ii = 0; ii < 16; ++ii) {
    int i = (tid >> 6) + 4 * ii, j = tid & 63, n = n0 + j;
    tile[i * 65 + j] = (n < N) ? src[(size_t)(k0 + i) * N + n] : 0.f;
  }
  __syncthreads();
#pragma unroll 4
  for (int ii = 0; ii < 16; ++ii) {
    int jj = (tid >> 6) + 4 * ii, kk = tid & 63, n = n0 + jj;
    if (n < N) dst[(size_t)dest_row(kind, n) * dstStride + k0 + kk] = f2bf(tile[kk * 65 + jj]);
  }
}

DI void mod_item(const Params& p, int l, int cgi, char* smem) {
  float* sc = (float*)smem;
  float* red = sc + 17 * 256;
  const int tid = tidx(), col = tid & 31, kg = tid >> 5, n = cgi * 32 + col;
  float acc[17];
#pragma unroll
  for (int r = 0; r < 17; ++r) acc[r] = 0.f;
  const float* w = p.w_ada + (size_t)l * 1024 * 6144 + n;
  for (int kc = 0; kc < 4; ++kc) {
    __syncthreads();
#pragma unroll
    for (int r = 0; r < 17; ++r) {
      float v = (r < 16) ? p.c[r * 1024 + kc * 256 + tid] : p.c_ctx[kc * 256 + tid];
      sc[r * 256 + tid] = siluf(v);
    }
    __syncthreads();
#pragma unroll 4
    for (int kk = 0; kk < 32; ++kk) {
      int kl = kg * 32 + kk;
      float wv = w[(size_t)(kc * 256 + kl) * 6144];
#pragma unroll
      for (int r = 0; r < 17; ++r) acc[r] += sc[r * 256 + kl] * wv;
    }
  }
#pragma unroll
  for (int r = 0; r < 17; ++r) red[(kg * 17 + r) * 32 + col] = acc[r];
  __syncthreads();
  float* MOD = (float*)(p.ws + OFF_MOD);
  for (int o = tid; o < 17 * 32; o += 256) {
    int r = o >> 5, cc = o & 31;
    float s = p.b_ada[l * 6144 + cgi * 32 + cc];
#pragma unroll
    for (int g = 0; g < 8; ++g) s += red[(g * 17 + r) * 32 + cc];
    MOD[((size_t)l * 17 + r) * 6144 + cgi * 32 + cc] = s;
  }
}

DI void phase_prepA(const Params& p, char* smem) {
  const int tid = tidx();
  for (int it = blockIdx.x; it < 6435; it += gridDim.x) {
    __syncthreads();
    if (it < 6048) {
      int l = it / 3024, r = it % 3024;
      if (r < 656) wt_tile(p.w_in + (size_t)l * 1024 * 2592, 1024, 2592, r / 41, r % 41, (bf16_t*)(p.ws + OFF_WTIN) + (size_t)l * NPAD_IN * 1024, 1024, 0, smem);
      else if (r < 912) { r -= 656; wt_tile(p.w_out + (size_t)l * 1024 * 1024, 1024, 1024, r / 16, r % 16, (bf16_t*)(p.ws + OFF_WTOUT) + (size_t)l * 1024 * 1024, 1024, 1, smem); }
      else if (r < 2320) { r -= 912; wt_tile(p.w_ffn_in + (size_t)l * 1024 * 5632, 1024, 5632, r / 88, r % 88, (bf16_t*)(p.ws + OFF_WTFI) + (size_t)l * 5632 * 1024, 1024, 2, smem); }
      else { r -= 2320; wt_tile(p.w_ffn_out + (size_t)l * FH * 1024, FH, 1024, r / 16, r % 16, (bf16_t*)(p.ws + OFF_WTFO) + (size_t)l * 1024 * FH, FH, 1, smem); }
    } else if (it < 6050) {
      int l = it - 6048;
      u32x4* d = (u32x4*)((bf16_t*)(p.ws + OFF_WTIN) + ((size_t)l * NPAD_IN + 2592) * 1024);
      for (int i = tid; i < 96 * 1024 / 8; i += 256) d[i] = (u32x4){0u, 0u, 0u, 0u};
    } else if (it < 6434) {
      int r = it - 6050;
      mod_item(p, r / 192, r % 192, smem);
    } else {
      float* rc = (float*)(p.ws + OFF_ROPE);
      for (int i = tid; i < 1024; i += 256) {
        int pos = i >> 4, f = i & 15;
        float invf = powf(10000.f, -(float)f / 16.f);
        float ang = (float)pos * invf;
        rc[i] = cosf(ang);
        rc[1024 + i] = sinf(ang);
      }
    }
  }
}

DI void phase_prepB(const Params& p) {
  const float* MOD = (const float*)(p.ws + OFF_MOD);
  float* TAB = (float*)(p.ws + OFF_TAB);
  for (int i = blockIdx.x * 256 + tidx(); i < 2 * 17 * 1024; i += gridDim.x * 256) {
    int k = i & 1023, b = (i >> 10) % 17, l = i / (17 * 1024);
    const float* m = MOD + ((size_t)l * 17 + b) * 6144;
    float sh1 = m[k], sc1 = m[1024 + k], sh2 = m[3072 + k], sc2 = m[4096 + k];
    float g0 = (l == 0) ? 1.f : p.ln2_g[k], b0 = (l == 0) ? 0.f : p.ln2_b[k];
    float* t = TAB + (size_t)l * 4 * 17 * 1024 + b * 1024 + k;
    t[0 * 17 * 1024] = g0 * (1.f + sc1);
    t[1 * 17 * 1024] = b0 * (1.f + sc1) + sh1;
    t[2 * 17 * 1024] = p.ln1_g[l * 1024 + k] * (1.f + sc2);
    t[3 * 17 * 1024] = p.ln1_b[l * 1024 + k] * (1.f + sc2) + sh2;
  }
}

DI void row_stats(const float* st, float& mu, float& rs) {
  const f32x4* s4 = (const f32x4*)st;
  f32x4 a = s4[0], b = s4[1], c = s4[2], d = s4[3];
  float S = a.x + a.z + b.x + b.z + c.x + c.z + d.x + d.z;
  float SS = a.y + a.w + b.y + b.w + c.y + c.w + d.y + d.w;
  mu = S * (1.f / 1024.f);
  float var = fmaxf(SS * (1.f / 1024.f) - mu * mu, 0.f);
  rs = rsqrtf(var + 1e-5f);
}

template <int MODE>
DI void gemm_tile(const Params& p, int l, int tm, int tn, char* smem) {
  constexpr int K = (MODE == 3) ? FH : 1024;
  constexpr int NK = K / 32;
  bf16_t* As = (bf16_t*)smem;
  bf16_t* Bs = As + 2 * 256 * 40;
  float* red = (float*)(Bs + 2 * 128 * 40);
  const int tid = tidx(), lane = tid & 63, wid = tid >> 6, wr = wid >> 1, wc = wid & 1, fr = lane & 15, fq = lane >> 4;
  const int row0 = tm * 256;
  const bool lat = row0 < NLAT;
  const int bidx = lat ? row0 / NSEQ : 16;
  float* Y1 = (float*)(p.ws + OFF_Y1);
  float* CTXY2 = (float*)(p.ws + OFF_CTXY2);
  const float* ST1 = (const float*)(p.ws + OFF_ST1);
  const float* ST2 = (const float*)(p.ws + OFF_ST2);
  bf16_t* P = (bf16_t*)(p.ws + OFF_P);
  const float* MOD = (const float*)(p.ws + OFF_MOD) + ((size_t)l * 17 + bidx) * 6144;

  const bf16_t* absrc; int astride;
  if (MODE == 0) { absrc = (const bf16_t*)(p.ws + OFF_Y1) + (size_t)row0 * 1024; astride = 1024; }
  else if (MODE == 1) { absrc = P + (size_t)row0 * PC; astride = PC; }
  else if (MODE == 2) { absrc = (const bf16_t*)(p.ws + OFF_UF) + (size_t)row0 * 1024; astride = 1024; }
  else { absrc = P + (size_t)row0 * FH; astride = FH; }
  const bf16_t* wt;
  if (MODE == 0) wt = (const bf16_t*)(p.ws + OFF_WTIN) + (size_t)l * NPAD_IN * 1024;
  else if (MODE == 1) wt = (const bf16_t*)(p.ws + OFF_WTOUT) + (size_t)l * 1024 * 1024;
  else if (MODE == 2) wt = (const bf16_t*)(p.ws + OFF_WTFI) + (size_t)l * 5632 * 1024;
  else wt = (const bf16_t*)(p.ws + OFF_WTFO) + (size_t)l * 1024 * FH;
  const bf16_t* asrc_t = absrc + (size_t)(tid >> 2) * astride + (tid & 3) * 8;
  const bf16_t* bsrc_t = wt + (size_t)(tn * 128 + (tid >> 2)) * K + (tid & 3) * 8;
  const int lds_t = (tid >> 2) * 40 + (tid & 3) * 8;

  u32x4 ra[4], rb[2];
  auto gload = [&](int kt) __attribute__((always_inline)) {
    int kk = kt * 32;
    if (MODE == 1 && kk >= 384) kk += 1280;
#pragma unroll
    for (int i = 0; i < 4; ++i) ra[i] = *(const u32x4*)(asrc_t + (size_t)i * 64 * astride + kk);
#pragma unroll
    for (int i = 0; i < 2; ++i) rb[i] = *(const u32x4*)(bsrc_t + (size_t)i * 64 * K + kt * 32);
  };
  auto lstore = [&](int buf) __attribute__((always_inline)) {
#pragma unroll
    for (int i = 0; i < 4; ++i) *(u32x4*)(As + buf * 256 * 40 + i * 64 * 40 + lds_t) = ra[i];
#pragma unroll
    for (int i = 0; i < 2; ++i) *(u32x4*)(Bs + buf * 128 * 40 + i * 64 * 40 + lds_t) = rb[i];
  };

  f32x4 acc[8][4];
#pragma unroll
  for (int m = 0; m < 8; ++m)
#pragma unroll
    for (int n = 0; n < 4; ++n) acc[m][n] = (f32x4){0.f, 0.f, 0.f, 0.f};

  __syncthreads();
  gload(0);
  lstore(0);
  __syncthreads();
  for (int kt = 0; kt < NK; ++kt) {
    const int buf = kt & 1;
    if (kt + 1 < NK) gload(kt + 1);
    {
      bf16x8 af[8], bf[4];
      const bf16_t* ab = As + buf * 256 * 40 + (wr * 128 + fr) * 40 + fq * 8;
      const bf16_t* bb = Bs + buf * 128 * 40 + (wc * 64 + fr) * 40 + fq * 8;
#pragma unroll
      for (int n = 0; n < 4; ++n) bf[n] = *(const bf16x8*)(bb + n * 16 * 40);
#pragma unroll
      for (int m = 0; m < 8; ++m) af[m] = *(const bf16x8*)(ab + m * 16 * 40);
#pragma unroll
      for (int m = 0; m < 8; ++m)
#pragma unroll
        for (int n = 0; n < 4; ++n) acc[m][n] = mfma16(bf[n], af[m], acc[m][n]);
    }
    if (kt + 1 < NK) lstore(buf ^ 1);
    __syncthreads();
  }
  if (MODE == 0) {
    const int hs = tn * 2 + wc;
    if (hs > 40) return;
    const bool isq = (hs >= 30 && hs < 36), isk = (hs == 36 || hs == 37);
    if (isq || isk) {
      const float* nw = (isq ? p.qnorm_w : p.knorm_w) + l * 64;
      const float* rc = (const float*)(p.ws + OFF_ROPE);
      float w_[4][4];
#pragma unroll
      for (int n = 0; n < 4; ++n)
#pragma unroll
        for (int j = 0; j < 4; ++j) w_[n][j] = nw[n * 16 + fq * 4 + j];
#pragma unroll
      for (int m = 0; m < 8; ++m) {
        float ss = 0.f;
#pragma unroll
        for (int n = 0; n < 4; ++n)
#pragma unroll
          for (int j = 0; j < 4; ++j) ss += acc[m][n][j] * acc[m][n][j];
        ss += shx(ss, 16); ss += shx(ss, 32);
        float inv = rsqrtf(ss * (1.f / 64.f) + 1e-6f);
#pragma unroll
        for (int n = 0; n < 4; ++n)
#pragma unroll
          for (int j = 0; j < 4; ++j) acc[m][n][j] *= inv * w_[n][j];
        if (lat) {
          int t = (row0 + wr * 128 + m * 16 + fr) & (NSEQ - 1);
          int gr = t >> 6, gc = t & 63;
#pragma unroll
          for (int j = 0; j < 4; ++j) {
            float cr = rc[gr * 16 + fq * 4 + j], sr = rc[1024 + gr * 16 + fq * 4 + j];
            float cc = rc[gc * 16 + fq * 4 + j], sn = rc[1024 + gc * 16 + fq * 4 + j];
            float x1 = acc[m][0][j], x2 = acc[m][1][j], x3 = acc[m][2][j], x4 = acc[m][3][j];
            acc[m][0][j] = x1 * cr - x2 * sr; acc[m][1][j] = x2 * cr + x1 * sr;
            acc[m][2][j] = x3 * cc - x4 * sn; acc[m][3][j] = x4 * cc + x3 * sn;
          }
        }
      }
    }
    float scl = 1.f;
    if (hs < 6 || isq) scl = QSCALE;
    else if (hs == 18 || hs == 19) scl = 0.17677669529663687f;
    const int nmax = (hs == 40) ? 2 : 4;
#pragma unroll
    for (int m = 0; m < 8; ++m) {
      bf16_t* pr = P + (size_t)(row0 + wr * 128 + m * 16 + fr) * PC + hs * 64 + fq * 4;
#pragma unroll
      for (int n = 0; n < 4; ++n) {
        if (n < nmax) {
          u32x2 u; u.x = pack2(acc[m][n][0] * scl, acc[m][n][1] * scl); u.y = pack2(acc[m][n][2] * scl, acc[m][n][3] * scl);
          *(u32x2*)(pr + n * 16) = u;
        }
      }
    }
  } else if (MODE == 2) {
    bf16_t* H = P;
#pragma unroll
    for (int m = 0; m < 8; ++m) {
      bf16_t* hr = H + (size_t)(row0 + wr * 128 + m * 16 + fr) * FH + tn * 64 + wc * 32 + fq * 4;
#pragma unroll
      for (int n = 0; n < 2; ++n) {
        float h0 = siluf(acc[m][n][0]) * acc[m][n + 2][0], h1 = siluf(acc[m][n][1]) * acc[m][n + 2][1];
        float h2 = siluf(acc[m][n][2]) * acc[m][n + 2][2], h3 = siluf(acc[m][n][3]) * acc[m][n + 2][3];
        u32x2 u; u.x = pack2(h0, h1); u.y = pack2(h2, h3);
        *(u32x2*)(hr + n * 16) = u;
      }
    }
  } else {
    const float* gate = MOD + (MODE == 1 ? 2048 : 5120) + tn * 128 + wc * 64 + fq * 4;
    const float* lng = nullptr; const float* lnb = nullptr; const float* xs; const float* st = nullptr;
    float* dst; float* stout;
    bool doln;
    if (MODE == 1) {
      doln = (l == 1);
      if (l == 0) xs = lat ? p.x + (size_t)row0 * 1024 : p.ctx + (size_t)(row0 - NLAT) * 1024;
      else { xs = p.out + (size_t)row0 * 1024; st = ST2 + (size_t)row0 * 16; lng = p.ln2_g; lnb = p.ln2_b; }
      dst = Y1 + (size_t)row0 * 1024;
      stout = (float*)(p.ws + OFF_ST1) + (size_t)row0 * 16;
    } else {
      doln = true;
      xs = Y1 + (size_t)row0 * 1024; st = ST1 + (size_t)row0 * 16; lng = p.ln1_g + l * 1024; lnb = p.ln1_b + l * 1024;
      dst = lat ? p.out + (size_t)row0 * 1024 : CTXY2 + (size_t)(row0 - NLAT) * 1024;
      stout = (float*)(p.ws + OFF_ST2) + (size_t)row0 * 16;
    }
    const int cb = tn * 128 + wc * 64 + fq * 4;
    float* rst = red + 1024;
    if (doln) { float m_, r_; row_stats(st + (size_t)tid * 16, m_, r_); rst[tid * 2] = m_; rst[tid * 2 + 1] = r_; }
    __syncthreads();
#pragma unroll
    for (int m = 0; m < 8; ++m) {
      const int rl = wr * 128 + m * 16 + fr;
      float rmu = 0.f, rrs = 1.f;
      if (doln) { rmu = rst[rl * 2]; rrs = rst[rl * 2 + 1]; }
      float s_ = 0.f, ss = 0.f;
      const float* xr = xs + (size_t)rl * 1024 + cb;
      float* dr = dst + (size_t)rl * 1024 + cb;
#pragma unroll
      for (int n = 0; n < 4; ++n) {
        const f32x4 gv = *(const f32x4*)(gate + n * 16);
        f32x4 xv = *(const f32x4*)(xr + n * 16);
        if (doln) {
          const f32x4 lg = *(const f32x4*)(lng + cb + n * 16), lb = *(const f32x4*)(lnb + cb + n * 16);
          xv.x = (xv.x - rmu) * rrs * lg.x + lb.x; xv.y = (xv.y - rmu) * rrs * lg.y + lb.y;
          xv.z = (xv.z - rmu) * rrs * lg.z + lb.z; xv.w = (xv.w - rmu) * rrs * lg.w + lb.w;
        }
        f32x4 o;
        o.x = ALPHA * xv.x + gv.x * acc[m][n][0]; o.y = ALPHA * xv.y + gv.y * acc[m][n][1];
        o.z = ALPHA * xv.z + gv.z * acc[m][n][2]; o.w = ALPHA * xv.w + gv.w * acc[m][n][3];
        *(f32x4*)(dr + n * 16) = o;
        s_ += o.x + o.y + o.z + o.w;
        ss += o.x * o.x + o.y * o.y + o.z * o.z + o.w * o.w;
      }
      s_ += shx(s_, 16); s_ += shx(s_, 32);
      ss += shx(ss, 16); ss += shx(ss, 32);
      if (fq == 0) { red[((wr * 2 + wc) * 128 + m * 16 + fr) * 2] = s_; red[((wr * 2 + wc) * 128 + m * 16 + fr) * 2 + 1] = ss; }
      if (m & 1) __builtin_amdgcn_sched_barrier(0);
    }
    __syncthreads();
    {
      int r = tid, w_ = r >> 7, rr = r & 127;
      float s = red[((w_ * 2 + 0) * 128 + rr) * 2] + red[((w_ * 2 + 1) * 128 + rr) * 2];
      float ss = red[((w_ * 2 + 0) * 128 + rr) * 2 + 1] + red[((w_ * 2 + 1) * 128 + rr) * 2 + 1];
      *(f32x2*)(stout + (size_t)r * 16 + tn * 2) = (f32x2){s, ss};
    }
  }
}

template <int MODE>
DI void phase_gemm(const Params& p, int l, char* smem) {
  const int NT = (MODE == 0) ? 21 : (MODE == 2 ? 44 : 8);
  const int MT = (l == 0 || MODE == 0) ? 144 : 128;
  const int vb = (blockIdx.x & 7) * (gridDim.x >> 3) + (blockIdx.x >> 3);
  for (int t = vb; t < MT * NT; t += gridDim.x) gemm_tile<MODE>(p, l, t / NT, t % NT, smem);
}

typedef __attribute__((address_space(3))) s16x4 lds_s16x4;
template <int NH>
DI void attn_item(const Params& p, int qrow0, int qcol, int kcol, int vcol, int lat_row0, int nb_lat, int ctx_row0, int nb_ctx,
                  bool na, int dr0, const float* rpb_h, char* smem, bool dry = false) {
  bf16_t* KV = (bf16_t*)smem;
  float* rpbs = (float*)(KV + 4 * 64 * 72);
  const int tid = tidx(), lane = tid & 63, w = tid >> 6, fr = lane & 15, fq = lane >> 4;
  bf16_t* P = (bf16_t*)(p.ws + OFF_P);
  __syncthreads();
  if (na) for (int i = tid; i < 465; i += 256) rpbs[i] = rpb_h[i] * LOG2E;
  bf16x8 qf[NH][2];
  f32x4 o[NH][4];
  float mrun[NH], lrun[NH];
#pragma unroll
  for (int hh = 0; hh < NH; ++hh) {
    const bf16_t* qp = P + (size_t)(qrow0 + w * 16 + fr) * PC + qcol + hh * 64 + fq * 8;
    qf[hh][0] = *(const bf16x8*)qp; qf[hh][1] = *(const bf16x8*)(qp + 32);
#pragma unroll
    for (int i = 0; i < 4; ++i) o[hh][i] = (f32x4){0.f, 0.f, 0.f, 0.f};
    mrun[hh] = -1e30f; lrun[hh] = 0.f;
  }
  const int nb = nb_lat + nb_ctx;
  u32x4 rk[2], rv[2];
  const int lkey = tid >> 3, ldc = (tid & 7) * 8;
  auto gload = [&](int kb) __attribute__((always_inline)) {
    int rb = kb < nb_lat ? lat_row0 + kb * 64 : ctx_row0 + (kb - nb_lat) * 64;
#pragma unroll
    for (int i = 0; i < 2; ++i) {
      const bf16_t* rp = P + (size_t)(rb + lkey + i * 32) * PC + ldc;
      rk[i] = *(const u32x4*)(rp + kcol);
      rv[i] = *(const u32x4*)(rp + vcol);
    }
  };
  auto lstore = [&](int buf) __attribute__((always_inline)) {
#pragma unroll
    for (int i = 0; i < 2; ++i) {
      bf16_t* d = KV + buf * 2 * 64 * 72 + (lkey + i * 32) * 72 + ldc;
      *(u32x4*)d = rk[i];
      *(u32x4*)(d + 64 * 72) = rv[i];
    }
  };
  const int qj = w * 16 + fr;
  const int cs = min(max(qj - 8, 0), 48);
  gload(0);
  lstore(0);
  __syncthreads();
  for (int kb = 0; kb < nb; ++kb) {
    const bf16_t* Kb = KV + (kb & 1) * 2 * 64 * 72;
    const bf16_t* Vb = Kb + 64 * 72;
    if (kb + 1 < nb) gload(kb + 1);
    const bool msk = na && kb < nb_lat;
    int mt_lo = 0, mt_hi = 3;
    if (msk) { mt_lo = (w >= 2) ? w - 1 : 0; mt_hi = (w <= 1) ? w + 1 : 3; }
    bf16x8 kf[4][2];
#pragma unroll
    for (int mt = 0; mt < 4; ++mt)
      if (mt >= mt_lo && mt <= mt_hi) {
        kf[mt][0] = *(const bf16x8*)(Kb + (mt * 16 + fr) * 72 + fq * 8);
        kf[mt][1] = *(const bf16x8*)(Kb + (mt * 16 + fr) * 72 + 32 + fq * 8);
      }
    bf16x8 pf[NH][2];
#pragma unroll
    for (int hh = 0; hh < NH; ++hh) {
      f32x4 s[4];
#pragma unroll
      for (int mt = 0; mt < 4; ++mt) {
        if (mt >= mt_lo && mt <= mt_hi) {
          s[mt] = mfma16(kf[mt][0], qf[hh][0], (f32x4){0.f, 0.f, 0.f, 0.f});
          s[mt] = mfma16(kf[mt][1], qf[hh][1], s[mt]);
          if (msk) {
#pragma unroll
            for (int j = 0; j < 4; ++j) {
              int kc = mt * 16 + fq * 4 + j;
              bool valid = (kc >= cs) && (kc < cs + 16);
              int bi = min(max(kc - qj, -15), 15);
              s[mt][j] = valid ? s[mt][j] + rpbs[(dr0 + kb) * 31 + bi + 15] : -1e30f;
            }
          }
        } else s[mt] = (f32x4){-1e30f, -1e30f, -1e30f, -1e30f};
      }
      float mx = fmaxf(fmaxf(fmaxf(s[0][0], s[0][1]), fmaxf(s[0][2], s[0][3])), fmaxf(fmaxf(s[1][0], s[1][1]), fmaxf(s[1][2], s[1][3])));
      mx = fmaxf(mx, fmaxf(fmaxf(fmaxf(s[2][0], s[2][1]), fmaxf(s[2][2], s[2][3])), fmaxf(fmaxf(s[3][0], s[3][1]), fmaxf(s[3][2], s[3][3]))));
      mx = fmaxf(mx, shx(mx, 16)); mx = fmaxf(mx, shx(mx, 32));
      const float mnew = fmaxf(mrun[hh], mx);
      if (__builtin_amdgcn_ballot_w64(mnew > mrun[hh]) != 0) {
        const float alpha = __builtin_amdgcn_exp2f(mrun[hh] - mnew);
        mrun[hh] = mnew;
        lrun[hh] *= alpha;
#pragma unroll
        for (int i = 0; i < 4; ++i) { o[hh][i][0] *= alpha; o[hh][i][1] *= alpha; o[hh][i][2] *= alpha; o[hh][i][3] *= alpha; }
      }
      float ps = 0.f;
#pragma unroll
      for (int mt = 0; mt < 4; ++mt)
#pragma unroll
        for (int j = 0; j < 4; ++j) { float e = __builtin_amdgcn_exp2f(s[mt][j] - mnew); s[mt][j] = e; ps += e; }
      lrun[hh] += ps;
#pragma unroll
      for (int kp = 0; kp < 2; ++kp) {
        u32x4 pk;
        pk.x = pack2(s[2 * kp][0], s[2 * kp][1]); pk.y = pack2(s[2 * kp][2], s[2 * kp][3]);
        pk.z = pack2(s[2 * kp + 1][0], s[2 * kp + 1][1]); pk.w = pack2(s[2 * kp + 1][2], s[2 * kp + 1][3]);
        pf[hh][kp] = __builtin_bit_cast(bf16x8, pk);
      }
    }
#pragma unroll
    for (int kp = 0; kp < 2; ++kp) {
      if ((kp == 0 && mt_lo <= 1) || (kp == 1 && mt_hi >= 2)) {
#pragma unroll
        for (int dt = 0; dt < 4; ++dt) {
          const bf16_t* vp = Vb + (kp * 32 + fq * 4 + (fr >> 2)) * 72 + dt * 16 + (fr & 3) * 4;
          s16x4 lo = __builtin_amdgcn_ds_read_tr16_b64_v4i16((lds_s16x4*)vp);
          s16x4 hi = __builtin_amdgcn_ds_read_tr16_b64_v4i16((lds_s16x4*)(vp + 16 * 72));
          bf16x8 vf = __builtin_shufflevector(lo, hi, 0, 1, 2, 3, 4, 5, 6, 7);
#pragma unroll
          for (int hh = 0; hh < NH; ++hh) o[hh][dt] = mfma16(vf, pf[hh][kp], o[hh][dt]);
        }
      }
    }
    if (kb + 1 < nb) lstore((kb + 1) & 1);
    __syncthreads();
  }
#pragma unroll
  for (int hh = 0; hh < NH; ++hh) {
    float lt = lrun[hh];
    lt += shx(lt, 16); lt += shx(lt, 32);
    const float inv = 1.f / lt;
    bf16_t* op = dry ? (bf16_t*)(p.ws + OFF_Y1) + (size_t)((qrow0 + w * 16 + fr) & 16383) * PC + qcol + hh * 64 + fq * 4
                     : P + (size_t)(qrow0 + w * 16 + fr) * PC + qcol + hh * 64 + fq * 4;
#pragma unroll
    for (int dt = 0; dt < 4; ++dt) {
      u32x2 u; u.x = pack2(o[hh][dt][0] * inv, o[hh][dt][1] * inv); u.y = pack2(o[hh][dt][2] * inv, o[hh][dt][3] * inv);
      *(u32x2*)(op + dt * 16) = u;
    }
  }
}

DI float logsig(float z) { return fminf(z, 0.f) - log1pf(expf(-fabsf(z))); }
DI int chunk_row0(int b, int cidx) { return cidx < 4 ? NLAT + b * LC + cidx * 64 : b * NSEQ + (cidx - 4) * 64; }
DI int chain_pos(int cidx, int dir) { return dir == 0 ? cidx : (cidx < 4 ? 3 - cidx : 39 - cidx); }

DI void gla_gates(const Params& p, int l, int h, int dir, int row0, float* bs, float* lrs, float* was, float* segt) {
  const int tid = tidx();
  const bf16_t* P = (const bf16_t*)(p.ws + OFF_P);
  {
    int s = tid >> 2, r4 = (tid & 3) * 4;
    u32x2 u = *(const u32x2*)(P + (size_t)(row0 + s) * PC + C_GLR + dir * 16 + r4);
    lrs[s * 17 + r4] = bflo(u.x); lrs[s * 17 + r4 + 1] = bfhi(u.x); lrs[s * 17 + r4 + 2] = bflo(u.y); lrs[s * 17 + r4 + 3] = bfhi(u.y);
    for (int i = tid; i < 512; i += 256) was[i] = p.gla_wa2[(((size_t)l * 2 + dir) * 16 + (i >> 5)) * 128 + h * 32 + (i & 31)];
  }
  __syncthreads();
  const int d = tid & 31, sg = tid >> 5;
  const float ba = p.gla_ba[(l * 2 + dir) * 128 + h * 32 + d];
  float la[8];
#pragma unroll
  for (int i = 0; i < 8; ++i) {
    int s = sg * 8 + i;
    float z = ba;
#pragma unroll
    for (int r = 0; r < 16; ++r) z += lrs[s * 17 + r] * was[r * 32 + d];
    la[i] = logsig(z) * (1.f / 16.f);
  }
  if (dir == 0) {
#pragma unroll
    for (int i = 1; i < 8; ++i) la[i] += la[i - 1];
    segt[sg * 32 + d] = la[7];
  } else {
#pragma unroll
    for (int i = 6; i >= 0; --i) la[i] += la[i + 1];
    segt[sg * 32 + d] = la[0];
  }
  __syncthreads();
  float pre = 0.f;
#pragma unroll
  for (int g = 0; g < 8; ++g) {
    float v = segt[g * 32 + d];
    if (dir == 0 ? (g < sg) : (g > sg)) pre += v;
  }
#pragma unroll
  for (int i = 0; i < 8; ++i) bs[(sg * 8 + i) * 33 + d] = la[i] + pre;
  __syncthreads();
}

DI void gla_passA(const Params& p, int l, int item, char* smem) {
  float* bs = (float*)smem;
  float* kw = bs + 64 * 33;
  float* vs = kw + 64 * 32;
  float* lrs = vs + 64 * 64;
  float* was = lrs + 64 * 17;
  float* segt = was + 512;
  const int tid = tidx();
  int dir = item & 1, cidx = (item >> 1) % 36, bh = item / 72, h = bh & 3, b = bh >> 2;
  const int row0 = chunk_row0(b, cidx);
  const bf16_t* P = (const bf16_t*)(p.ws + OFF_P);
  __syncthreads();
  gla_gates(p, l, h, dir, row0, bs, lrs, was, segt);
  {
    int s = tid >> 2, d8 = (tid & 3) * 8;
    u32x4 u = *(const u32x4*)(P + (size_t)(row0 + s) * PC + C_GLK + h * 32 + d8);
    unsigned uu[4] = {u.x, u.y, u.z, u.w};
    const int slast = dir == 0 ? 63 : 0;
#pragma unroll
    for (int e = 0; e < 4; ++e) {
      int d0 = d8 + 2 * e;
      kw[s * 32 + d0] = bflo(uu[e]) * __expf(bs[slast * 33 + d0] - bs[s * 33 + d0]);
      kw[s * 32 + d0 + 1] = bfhi(uu[e]) * __expf(bs[slast * 33 + d0 + 1] - bs[s * 33 + d0 + 1]);
    }
    int v16 = (tid & 3) * 16;
#pragma unroll
    for (int q = 0; q < 2; ++q) {
      u32x4 w = *(const u32x4*)(P + (size_t)(row0 + s) * PC + C_GLV + h * 64 + v16 + q * 8);
      unsigned ww[4] = {w.x, w.y, w.z, w.w};
#pragma unroll
      for (int e = 0; e < 4; ++e) { vs[s * 64 + v16 + q * 8 + 2 * e] = bflo(ww[e]); vs[s * 64 + v16 + q * 8 + 2 * e + 1] = bfhi(ww[e]); }
    }
  }
  __syncthreads();
  const int v = tid & 63, dg = (tid >> 6) * 8;
  float acc[8];
#pragma unroll
  for (int i = 0; i < 8; ++i) acc[i] = 0.f;
  for (int s = 0; s < 64; ++s) {
    float vv = vs[s * 64 + v];
    f32x4 k0 = *(const f32x4*)(kw + s * 32 + dg), k1 = *(const f32x4*)(kw + s * 32 + dg + 4);
    acc[0] += k0.x * vv; acc[1] += k0.y * vv; acc[2] += k0.z * vv; acc[3] += k0.w * vv;
    acc[4] += k1.x * vv; acc[5] += k1.y * vv; acc[6] += k1.z * vv; acc[7] += k1.w * vv;
  }
  const int pos = chain_pos(cidx, dir);
  float* LS = (float*)(p.ws + OFF_LS) + ((size_t)((b * 4 + h) * 2 + dir) * 36 + pos) * 2048;
#pragma unroll
  for (int i = 0; i < 8; ++i) LS[(dg + i) * 64 + v] = acc[i];
  if (tid < 32) {
    float* BL = (float*)(p.ws + OFF_BL) + ((size_t)((b * 4 + h) * 2 + dir) * 36 + pos) * 32;
    BL[tid] = bs[(dir == 0 ? 63 : 0) * 33 + tid];
  }
}

DI void gla_passB(const Params& p, int l, int b, int h, int cidx, char* smem, bool dry = false) {
  float* bs = (float*)smem;
  float* qe = bs + 64 * 33;
  float* ke = qe + 64 * 36;
  float* vs = ke + 64 * 36;
  float* S0s = vs + 64 * 64;
  float* Am = S0s + 32 * 64;
  float* lrs = Am;
  float* was = lrs + 64 * 17;
  float* segt = was + 512;
  const int tid = tidx();
  const int row0 = chunk_row0(b, cidx);
  bf16_t* P = (bf16_t*)(p.ws + OFF_P);
  const int ty = tid >> 4, tx = tid & 15;
  float o[4][4];
#pragma unroll
  for (int i = 0; i < 4; ++i)
#pragma unroll
    for (int j = 0; j < 4; ++j) o[i][j] = 0.f;
  __syncthreads();
  {
    int s = tid >> 2, v16 = (tid & 3) * 16;
#pragma unroll
    for (int q = 0; q < 2; ++q) {
      u32x4 w = *(const u32x4*)(P + (size_t)(row0 + s) * PC + C_GLV + h * 64 + v16 + q * 8);
      unsigned ww[4] = {w.x, w.y, w.z, w.w};
#pragma unroll
      for (int e = 0; e < 4; ++e) { vs[s * 64 + v16 + q * 8 + 2 * e] = bflo(ww[e]); vs[s * 64 + v16 + q * 8 + 2 * e + 1] = bfhi(ww[e]); }
    }
  }
  for (int dir = 0; dir < 2; ++dir) {
    gla_gates(p, l, h, dir, row0, bs, lrs, was, segt);
    {
      int s = tid >> 2, d8 = (tid & 3) * 8;
      u32x4 uq = *(const u32x4*)(P + (size_t)(row0 + s) * PC + C_GLQ + h * 32 + d8);
      u32x4 uk = *(const u32x4*)(P + (size_t)(row0 + s) * PC + C_GLK + h * 32 + d8);
      unsigned q_[4] = {uq.x, uq.y, uq.z, uq.w}, k_[4] = {uk.x, uk.y, uk.z, uk.w};
#pragma unroll
      for (int e = 0; e < 4; ++e) {
        int d0 = d8 + 2 * e;
        float b0 = bs[s * 33 + d0], b1 = bs[s * 33 + d0 + 1];
        qe[s * 36 + d0] = bflo(q_[e]) * __expf(b0); qe[s * 36 + d0 + 1] = bfhi(q_[e]) * __expf(b1);
        ke[s * 36 + d0] = bflo(k_[e]) * __expf(-b0); ke[s * 36 + d0 + 1] = bfhi(k_[e]) * __expf(-b1);
      }
      const int pos = chain_pos(cidx, dir);
      const float* LS = (const float*)(p.ws + OFF_LS) + (size_t)((b * 4 + h) * 2 + dir) * 36 * 2048;
      const float* BL = (const float*)(p.ws + OFF_BL) + (size_t)((b * 4 + h) * 2 + dir) * 36 * 32;
      const int v = tid & 63, dg = (tid >> 6) * 8;
      float S[8];
#pragma unroll
      for (int i = 0; i < 8; ++i) S[i] = 0.f;
      for (int pp = 0; pp < pos; ++pp) {
#pragma unroll
        for (int i = 0; i < 8; ++i) S[i] = __expf(BL[pp * 32 + dg + i]) * S[i] + LS[(size_t)pp * 2048 + (dg + i) * 64 + v];
      }
#pragma unroll
      for (int i = 0; i < 8; ++i) S0s[(dg + i) * 64 + v] = S[i];
    }
    __syncthreads();
    {
      float a[4][4];
#pragma unroll
      for (int i = 0; i < 4; ++i)
#pragma unroll
        for (int j = 0; j < 4; ++j) a[i][j] = 0.f;
#pragma unroll 2
      for (int d = 0; d < 32; d += 4) {
        f32x4 qv[4], kv[4];
#pragma unroll
        for (int i = 0; i < 4; ++i) { qv[i] = *(const f32x4*)(qe + (ty * 4 + i) * 36 + d); kv[i] = *(const f32x4*)(ke + (tx * 4 + i) * 36 + d); }
#pragma unroll
        for (int i = 0; i < 4; ++i)
#pragma unroll
          for (int j = 0; j < 4; ++j) a[i][j] += qv[i].x * kv[j].x + qv[i].y * kv[j].y + qv[i].z * kv[j].z + qv[i].w * kv[j].w;
      }
#pragma unroll
      for (int i = 0; i < 4; ++i) {
        int t = ty * 4 + i;
        f32x4 r;
        float* rr = (float*)&r;
#pragma unroll
        for (int j = 0; j < 4; ++j) { int s = tx * 4 + j; bool keep = dir == 0 ? (s <= t) : (s >= t); rr[j] = keep ? a[i][j] : 0.f; }
        *(f32x4*)(Am + t * 68 + tx * 4) = r;
      }
    }
    __syncthreads();
    {
#pragma unroll 2
      for (int s = 0; s < 64; s += 4) {
        f32x4 av[4], vv[4];
#pragma unroll
        for (int i = 0; i < 4; ++i) { av[i] = *(const f32x4*)(Am + (ty * 4 + i) * 68 + s); vv[i] = *(const f32x4*)(vs + (s + i) * 64 + tx * 4); }
#pragma unroll
        for (int i = 0; i < 4; ++i) {
          o[i][0] += av[i].x * vv[0].x + av[i].y * vv[1].x + av[i].z * vv[2].x + av[i].w * vv[3].x;
          o[i][1] += av[i].x * vv[0].y + av[i].y * vv[1].y + av[i].z * vv[2].y + av[i].w * vv[3].y;
          o[i][2] += av[i].x * vv[0].z + av[i].y * vv[1].z + av[i].z * vv[2].z + av[i].w * vv[3].z;
          o[i][3] += av[i].x * vv[0].w + av[i].y * vv[1].w + av[i].z * vv[2].w + av[i].w * vv[3].w;
        }
      }
#pragma unroll 2
      for (int d = 0; d < 32; d += 4) {
        f32x4 av[4], vv[4];
#pragma unroll
        for (int i = 0; i < 4; ++i) { av[i] = *(const f32x4*)(qe + (ty * 4 + i) * 36 + d); vv[i] = *(const f32x4*)(S0s + (d + i) * 64 + tx * 4); }
#pragma unroll
        for (int i = 0; i < 4; ++i) {
          o[i][0] += av[i].x * vv[0].x + av[i].y * vv[1].x + av[i].z * vv[2].x + av[i].w * vv[3].x;
          o[i][1] += av[i].x * vv[0].y + av[i].y * vv[1].y + av[i].z * vv[2].y + av[i].w * vv[3].y;
          o[i][2] += av[i].x * vv[0].z + av[i].y * vv[1].z + av[i].z * vv[2].z + av[i].w * vv[3].z;
          o[i][3] += av[i].x * vv[0].w + av[i].y * vv[1].w + av[i].z * vv[2].w + av[i].w * vv[3].w;
        }
      }
    }
    __syncthreads();
  }
  const f32x4 nw = *(const f32x4*)(p.gla_norm_w + l * 64 + tx * 4);
#pragma unroll
  for (int i = 0; i < 4; ++i) {
    float ss = o[i][0] * o[i][0] + o[i][1] * o[i][1] + o[i][2] * o[i][2] + o[i][3] * o[i][3];
    ss += shx(ss, 1); ss += shx(ss, 2); ss += shx(ss, 4); ss += shx(ss, 8);
    float inv = rsqrtf(ss * (1.f / 64.f) + 1e-6f);
    bf16_t* gp = P + (size_t)(row0 + ty * 4 + i) * PC + C_GLG + h * 64 + tx * 4;
    u32x2 g = *(const u32x2*)gp;
    u32x2 u;
    u.x = pack2(o[i][0] * inv * nw.x * siluf(bflo(g.x)), o[i][1] * inv * nw.y * siluf(bfhi(g.x)));
    u.y = pack2(o[i][2] * inv * nw.z * siluf(bflo(g.y)), o[i][3] * inv * nw.w * siluf(bfhi(g.y)));
    if (dry) gp = (bf16_t*)(p.ws + OFF_Y1) + (size_t)((row0 + ty * 4 + i) & 16383) * PC + C_GLG + h * 64 + tx * 4;
    *(u32x2*)gp = u;
  }
}

DI void phase_mixA(const Params& p, int l, char* smem, bool dry = false) {
  const int NGQA = NB * 2 * 32, NGLA = NB * 4 * 36 * 2;
  for (int it = blockIdx.x; it < NGQA + NGLA; it += gridDim.x) {
    if (it < NGQA) {
      int b = it >> 6, rem = it & 63, g = rem >> 5, qt = rem & 31;
      attn_item<3>(p, b * NSEQ + qt * 64, C_GAQ + g * 192, C_GAK + g * 64, C_GAV + g * 64, b * NSEQ, 32, NLAT + b * LC, 4, false, 0, nullptr, smem, dry);
    } else gla_passA(p, l, it - NGQA, smem);
  }
}
DI void phase_mixB(const Params& p, int l, char* smem, bool dry = false) {
  const int cpl = (l == 0) ? 36 : 32;
  const int NGLB = NB * 4 * cpl, NNA = NB * 6 * 32, NCG = (l == 0) ? NB * 2 * 4 : 0, NCN = (l == 0) ? NB * 6 * 4 : 0;
  for (int it = blockIdx.x; it < NGLB + NNA + NCG + NCN; it += gridDim.x) {
    if (it < NGLB) {
      int cc = it % cpl, bh = it / cpl;
      gla_passB(p, l, bh >> 2, bh & 3, cc + (36 - cpl), smem, dry);
    } else if (it < NGLB + NNA) {
      int i = it - NGLB, b = i / 192, rem = i % 192, h = rem >> 5, r = rem & 31;
      int rs = min(max(r - 4, 0), 24);
      attn_item<1>(p, b * NSEQ + r * 64, C_NAQ + h * 64, C_NAK + h * 64, C_NAV + h * 64, b * NSEQ + rs * 64, 8, NLAT + b * LC, 4, true, rs - r + 7,
                   p.na_rpb + ((size_t)l * 6 + h) * 465, smem, dry);
    } else if (it < NGLB + NNA + NCG) {
      int i = it - NGLB - NNA, b = i >> 3, g = (i >> 2) & 1, qt = i & 3;
      attn_item<3>(p, NLAT + b * LC + qt * 64, C_GAQ + g * 192, C_GAK + g * 64, C_GAV + g * 64, 0, 0, NLAT + b * LC, 4, false, 0, nullptr, smem, dry);
    } else {
      int i = it - NGLB - NNA - NCG, b = i / 24, rem = i % 24, h = rem >> 2, qt = rem & 3;
      attn_item<1>(p, NLAT + b * LC + qt * 64, C_NAQ + h * 64, C_NAK + h * 64, C_NAV + h * 64, 0, 0, NLAT + b * LC, 4, false, 0, nullptr, smem, dry);
    }
  }
}

DI void phase_final(const Params& p) {
  const int lane = tidx() & 63, w = tidx() >> 6;
  const float* g = p.ln2_g + 1024; const float* bb = p.ln2_b + 1024;
  for (int r = blockIdx.x * 4 + w; r < NLAT; r += gridDim.x * 4) {
    float* row = p.out + (size_t)r * 1024;
    f32x4 v[4];
    float s = 0.f;
#pragma unroll
    for (int i = 0; i < 4; ++i) { v[i] = *(const f32x4*)(row + i * 256 + lane * 4); s += v[i].x + v[i].y + v[i].z + v[i].w; }
#pragma unroll
    for (int m = 1; m < 64; m <<= 1) s += shx(s, m);
    float mu = s * (1.f / 1024.f), ss = 0.f;
#pragma unroll
    for (int i = 0; i < 4; ++i) { float a = v[i].x - mu, b = v[i].y - mu, c = v[i].z - mu, d = v[i].w - mu; ss += a * a + b * b + c * c + d * d; }
#pragma unroll
    for (int m = 1; m < 64; m <<= 1) ss += shx(ss, m);
    float rs = rsqrtf(ss * (1.f / 1024.f) + 1e-5f);
#pragma unroll
    for (int i = 0; i < 4; ++i) {
      f32x4 gg = *(const f32x4*)(g + i * 256 + lane * 4), be = *(const f32x4*)(bb + i * 256 + lane * 4), o;
      o.x = (v[i].x - mu) * rs * gg.x + be.x; o.y = (v[i].y - mu) * rs * gg.y + be.y;
      o.z = (v[i].z - mu) * rs * gg.z + be.z; o.w = (v[i].w - mu) * rs * gg.w + be.w;
      *(f32x4*)(row + i * 256 + lane * 4) = o;
    }
  }
}

DI void phase_uconv(const Params& p, int kind, int l) {
  const int tid = tidx(), lane = tid & 63, w = tid >> 6;
  const int nrows = (kind == 1 && l == 1) ? NLAT : NROWS;
  const float* MODb = (const float*)(p.ws + OFF_MOD);
  const float* TABb = (const float*)(p.ws + OFF_TAB) + (size_t)l * 4 * 17 * 1024;
  for (int r = blockIdx.x * 4 + w; r < nrows; r += gridDim.x * 4) {
    const bool lat = r < NLAT;
    const int b = lat ? r / NSEQ : 16;
    const float* src; const float* st = nullptr; bf16_t* dst;
    if (kind == 0) {
      if (l == 0) src = lat ? p.x + (size_t)r * 1024 : p.ctx + (size_t)(r - NLAT) * 1024;
      else { src = lat ? p.out + (size_t)r * 1024 : (const float*)(p.ws + OFF_CTXY2) + (size_t)(r - NLAT) * 1024; st = (const float*)(p.ws + OFF_ST2) + (size_t)r * 16; }
      dst = (bf16_t*)(p.ws + OFF_Y1) + (size_t)r * 1024;
    } else {
      src = (const float*)(p.ws + OFF_Y1) + (size_t)r * 1024; st = (const float*)(p.ws + OFF_ST1) + (size_t)r * 16;
      dst = (bf16_t*)(p.ws + OFF_UF) + (size_t)r * 1024;
    }
    float mu = 0.f, rs = 1.f;
    if (st) row_stats(st, mu, rs);
    const bool raw = (kind == 0 && l == 0);
    const float* t1 = raw ? MODb + (size_t)b * 6144 + 1024 : TABb + (size_t)(kind * 2) * 17 * 1024 + b * 1024;
    const float* t2 = raw ? MODb + (size_t)b * 6144 : TABb + (size_t)(kind * 2 + 1) * 17 * 1024 + b * 1024;
#pragma unroll
    for (int i = 0; i < 4; ++i) {
      const int k = i * 256 + lane * 4;
      f32x4 v = *(const f32x4*)(src + k), a = *(const f32x4*)(t1 + k), c = *(const f32x4*)(t2 + k);
      if (raw) { a.x += 1.f; a.y += 1.f; a.z += 1.f; a.w += 1.f; }
      u32x2 u;
      u.x = pack2((v.x - mu) * rs * a.x + c.x, (v.y - mu) * rs * a.y + c.y);
      u.y = pack2((v.z - mu) * rs * a.z + c.z, (v.w - mu) * rs * a.w + c.w);
      *(u32x2*)(dst + k) = u;
    }
  }
}

#define XB_TMO      128
#define XB_XCNT(j)  (256  + 64 * (j))
#define XB_XSUB(j)  (1280 + 64 * (j))
#define XB_XGEN(j)  (2304 + 64 * (j))
#define XB_TOP      3328
#define XB_TOPGEN   3392
#define XCD_BAR_WORDS 3456
#define XB_SPIN_CAP (1u << 18)
#define LAS __attribute__((address_space(3)))

__device__ __forceinline__ unsigned xb_ld(unsigned* p)              { return __hip_atomic_load(p, __ATOMIC_RELAXED, __HIP_MEMORY_SCOPE_AGENT); }
__device__ __forceinline__ unsigned xb_add(unsigned* p, unsigned v) { return __hip_atomic_fetch_add(p, v, __ATOMIC_RELAXED, __HIP_MEMORY_SCOPE_AGENT); }
__device__ __forceinline__ unsigned xb_xcc_id() { return (unsigned)__builtin_amdgcn_s_getreg((3 << 11) | 20) & 0xFu; }
#define XB_SPIN(cond, bar) do { unsigned _sp = 0; while (cond) { __builtin_amdgcn_s_sleep(1); \
    if ((++_sp & 255u) == 0u) { if (xb_ld(&(bar)[XB_TMO])) break; if (_sp > XB_SPIN_CAP) { atomicAdd(&(bar)[XB_TMO], 1u); break; } } } } while (0)

struct XcdBarrier {
    unsigned* bar; unsigned x;
    volatile LAS unsigned* st;
};

__device__ __forceinline__ XcdBarrier xcd_barrier_post(unsigned* bar, volatile LAS unsigned* st) {
    XcdBarrier b; b.bar = bar; b.x = xb_xcc_id(); b.st = st;
    if (threadIdx.x == 0) (void)xb_add(&bar[XB_XCNT(b.x)], 1u);
    return b;
}
__device__ __forceinline__ void xcd_barrier_complete(unsigned* bar, unsigned x, unsigned& nloc, unsigned& nx) {
    const unsigned G = gridDim.x * gridDim.y * gridDim.z;
    unsigned sum, cnt, mine, sp = 0u;
    for (;;) {
        sum = 0u; cnt = 0u; mine = 0u;
#pragma unroll
        for (unsigned j = 0; j < 16; ++j) { const unsigned c = xb_ld(&bar[XB_XCNT(j)]); sum += c; cnt += (c > 0u) ? 1u : 0u; mine = (j == x) ? c : mine; }
        if (sum == G) break;
        __builtin_amdgcn_s_sleep(1);
        if ((++sp & 255u) == 0u) { if (xb_ld(&bar[XB_TMO])) break; if (sp > XB_SPIN_CAP) { atomicAdd(&bar[XB_TMO], 1u); break; } }
    }
    nloc = mine > 0u ? mine : 1u; nx = cnt > 0u ? cnt : 1u;
}

__device__ __forceinline__ void xcd_barrier(const XcdBarrier& b) {
    asm volatile("s_waitcnt vmcnt(0)" ::: "memory");
    __syncthreads();
    if (threadIdx.x == 0) {
        unsigned* bar = b.bar;
        __builtin_amdgcn_s_waitcnt(0);
        unsigned nloc = b.st[0], nx = b.st[1];
        if (nloc == 0u) { xcd_barrier_complete(bar, b.x, nloc, nx); b.st[0] = nloc; b.st[1] = nx; }
        const unsigned old = xb_add(&bar[XB_XSUB(b.x)], 1u);
        const unsigned gen = old / nloc;
        if (old + 1u == (gen + 1u) * nloc) {
            __builtin_amdgcn_fence(__ATOMIC_RELEASE, "agent");
            asm volatile("s_waitcnt vmcnt(0)" ::: "memory");
            const unsigned og = xb_add(&bar[XB_TOP], 1u);
            const unsigned tg = og / nx;
            if (og + 1u == (tg + 1u) * nx) xb_add(&bar[XB_TOPGEN], 1u);
            else XB_SPIN(xb_ld(&bar[XB_TOPGEN]) == tg, bar);
            __builtin_amdgcn_fence(__ATOMIC_ACQUIRE, "agent");
            xb_add(&bar[XB_XGEN(b.x)], 1u);
            asm volatile("s_waitcnt vmcnt(0)" ::: "memory");
        } else {
            XB_SPIN(xb_ld(&bar[XB_XGEN(b.x)]) == gen, bar);
            __builtin_amdgcn_fence(__ATOMIC_ACQUIRE, "agent");
            asm volatile("s_waitcnt vmcnt(0)" ::: "memory");
        }
    }
    __syncthreads();
}


__global__ void __launch_bounds__(256, 2) mega(Params p) {
  extern __shared__ __attribute__((aligned(16))) char smem[];
  __shared__ uint4 xb_words;
  cg::grid_group grid = cg::this_grid();
  if (p.ph_lo < 0) grid.sync();
  if (threadIdx.x == 0) xb_words = make_uint4(0u, 0u, 0u, 0u);
  __syncthreads();
  XcdBarrier xb = xcd_barrier_post((unsigned*)(p.ws + OFF_BAR), (volatile LAS unsigned*)&xb_words);
  if (DUP & 32) { for (int i = 0; i < 16; ++i) xcd_barrier(xb); }
  for (int ph = p.ph_lo; ph < p.ph_hi; ++ph) {
    if (ph > p.ph_lo) xcd_barrier(xb);
    if (ph == 0) { phase_prepA(p, smem); if (DUP & 8) phase_prepA(p, smem); }
    else if (ph == 1) { phase_prepB(p); phase_uconv(p, 0, 0); }
    else {
      const int l = (ph - 2) >> 3, s = (ph - 2) & 7;
      if (s == 0) { phase_gemm<0>(p, l, smem); if (DUP & 1) phase_gemm<0>(p, l, smem); }
      else if (s == 1) { if (DUP & 2) phase_mixA(p, l, smem, true); phase_mixA(p, l, smem); }
      else if (s == 2) { if (DUP & 4) phase_mixB(p, l, smem, true); phase_mixB(p, l, smem); }
      else if (s == 3) { phase_gemm<1>(p, l, smem); if (DUP & 1) phase_gemm<1>(p, l, smem); }
      else if (s == 4) { phase_uconv(p, 1, l); if (DUP & 16) phase_uconv(p, 1, l); }
      else if (s == 5) { phase_gemm<2>(p, l, smem); if (DUP & 1) phase_gemm<2>(p, l, smem); }
      else if (s == 6) { phase_gemm<3>(p, l, smem); if (DUP & 1) phase_gemm<3>(p, l, smem); }
      else if (l == 0) phase_uconv(p, 0, 1);
      else phase_final(p);
    }
  }
}

extern "C" void kernel_launch(void* const* d_in, const int* in_sizes, int n_in, void* d_out, int out_size, void* d_ws, size_t ws_size,
                              hipStream_t stream) {
  static int grid = 0;
  if (grid == 0) {
    if (n_in != 20 || out_size != NLAT * 1024 || ws_size < WS_END) {
      fprintf(stderr, "kernel_launch: unexpected shapes (n_in %d out %d ws %zu need %zu)\n", n_in, out_size, ws_size, (size_t)WS_END);
      grid = -1; return;
    }
    int dev = 0, cus = 0, per = 0;
    hipGetDevice(&dev);
    hipDeviceGetAttribute(&cus, hipDeviceAttributeMultiprocessorCount, dev);
    hipFuncSetAttribute((const void*)mega, hipFuncAttributeMaxDynamicSharedMemorySize, SMEM_BYTES);
    hipOccupancyMaxActiveBlocksPerMultiprocessor(&per, (const void*)mega, 256, SMEM_BYTES);
    if (per < 1) per = 1;
    if (per > 2) per = 2;
    grid = cus * per;
  }
  if (grid < 0) return;
  if (hipMemsetAsync((char*)d_ws + OFF_BAR, 0, BAR_BYTES, stream) != hipSuccess) { fprintf(stderr, "kernel_launch: memset failed\n"); return; }
  Params p{};
  const float** pp = (const float**)&p;
  for (int i = 0; i < 20; ++i) pp[i] = (const float*)d_in[i];
  p.out = (float*)d_out; p.ws = (char*)d_ws;
#if ONE_LAUNCH
  p.ph_lo = 0; p.ph_hi = NPHASE;
  void* args[] = {&p};
  hipError_t e = hipLaunchCooperativeKernel((const void*)mega, dim3(grid), dim3(256), args, SMEM_BYTES, stream);
  if (e != hipSuccess) fprintf(stderr, "cooperative launch failed: %s (grid %d)\n", hipGetErrorString(e), grid);
#else
  for (int ph = 0; ph < NPHASE; ++ph) {
    p.ph_lo = ph; p.ph_hi = ph + 1;
    hipLaunchKernelGGL(mega, dim3(grid), dim3(256), SMEM_BYTES, stream, p);
  }
#endif
}
```

```cpp
#include <hip/hip_runtime.h>
#include <hip/hip_cooperative_groups.h>
#include <cstdio>
#include <cstdint>
namespace cg = cooperative_groups;

#ifndef PM
#define PM 0x1ff
#endif
#ifndef DUP
#define DUP 0
#endif
#ifndef ONE_LAUNCH
#define ONE_LAUNCH 1
#endif

typedef unsigned short bf16_t;
typedef short bf16x8 __attribute__((ext_vector_type(8)));
typedef short s16x4 __attribute__((ext_vector_type(4)));
typedef float f32x4 __attribute__((ext_vector_type(4)));
typedef float f32x2 __attribute__((ext_vector_type(2)));
typedef unsigned u32x4 __attribute__((ext_vector_type(4)));
typedef unsigned u32x2 __attribute__((ext_vector_type(2)));
#define DI __device__ __forceinline__

constexpr int NB = 16, NSEQ = 2048, LC = 256, DM = 1024;
constexpr int NLAT = NB * NSEQ;
constexpr int NCTX = NB * LC;
constexpr int NROWS = NLAT + NCTX;
constexpr int PC = 2592;
constexpr int NPAD_IN = 2688;
constexpr int FH = 2816;
constexpr int C_NAQ = 0, C_NAK = 384, C_NAV = 768, C_GLQ = 1152, C_GLK = 1280, C_GLV = 1408, C_GLG = 1664,
              C_GAQ = 1920, C_GAK = 2304, C_GAV = 2432, C_GLR = 2560;
constexpr float ALPHA = 1.41421356237f;
constexpr float LOG2E = 1.44269504089f;
constexpr float QSCALE = 0.125f * LOG2E;

constexpr size_t al256(size_t x) { return (x + 255) & ~(size_t)255; }
constexpr size_t OFF_WTIN = 0;
constexpr size_t OFF_WTOUT = OFF_WTIN + al256((size_t)2 * NPAD_IN * 1024 * 2);
constexpr size_t OFF_WTFI = OFF_WTOUT + al256((size_t)2 * 1024 * 1024 * 2);
constexpr size_t OFF_WTFO = OFF_WTFI + al256((size_t)2 * 5632 * 1024 * 2);
constexpr size_t OFF_MOD = OFF_WTFO + al256((size_t)2 * 1024 * FH * 2);
constexpr size_t OFF_TAB = OFF_MOD + al256((size_t)2 * 17 * 6144 * 4);
constexpr size_t OFF_ROPE = OFF_TAB + al256((size_t)2 * 4 * 17 * 1024 * 4);
constexpr size_t OFF_ST1 = OFF_ROPE + al256((size_t)2 * 64 * 16 * 4);
constexpr size_t OFF_ST2 = OFF_ST1 + al256((size_t)NROWS * 16 * 4);
constexpr size_t OFF_LS = OFF_ST2 + al256((size_t)NROWS * 16 * 4);
constexpr size_t OFF_BL = OFF_LS + al256((size_t)NB * 4 * 2 * 36 * 2048 * 4);
constexpr size_t OFF_CTXY2 = OFF_BL + al256((size_t)NB * 4 * 2 * 36 * 32 * 4);
constexpr size_t OFF_UF = OFF_LS;
constexpr size_t OFF_Y1 = OFF_UF + al256((size_t)NROWS * 1024 * 2);
constexpr size_t OFF_P = OFF_Y1 + al256((size_t)NROWS * 1024 * 4);
constexpr size_t OFF_BAR = OFF_P + al256((size_t)NROWS * FH * 2);
constexpr size_t BAR_BYTES = 16384;
constexpr size_t WS_END = OFF_BAR + BAR_BYTES;

constexpr int SMEM_BYTES = 73728 + 6144;
constexpr int NPHASE = 20;

struct Params {
  const float *x, *c, *ctx, *c_ctx, *w_ada, *b_ada, *w_in, *na_rpb, *gla_wa2, *gla_ba, *gla_norm_w, *qnorm_w, *knorm_w,
      *w_out, *ln1_g, *ln1_b, *w_ffn_in, *w_ffn_out, *ln2_g, *ln2_b;
  float* out;
  char* ws;
  int ph_lo, ph_hi;
};

DI unsigned pack2(float lo, float hi) {
  unsigned r;
  asm("v_cvt_pk_bf16_f32 %0, %1, %2" : "=v"(r) : "v"(lo), "v"(hi));
  return r;
}
DI bf16_t f2bf(float f) { return (bf16_t)(pack2(f, 0.f) & 0xffffu); }
DI float bf2f(unsigned h) { return __uint_as_float(h << 16); }
DI float bflo(unsigned u) { return __uint_as_float(u << 16); }
DI float bfhi(unsigned u) { return __uint_as_float(u & 0xffff0000u); }
DI f32x4 mfma16(bf16x8 a, bf16x8 b, f32x4 c) { return __builtin_amdgcn_mfma_f32_16x16x32_bf16(a, b, c, 0, 0, 0); }
DI float siluf(float x) { return x / (1.f + __expf(-x)); }
DI int tidx() { int t = threadIdx.x; asm volatile("" : "+v"(t)); return t; }
DI float shx(float v, int m) { return __shfl_xor(v, m, 64); }

DI int dest_row(int kind, int n) {
  if (kind == 0) return n < 1920 ? n : (n < 1952 ? n + 640 : n - 32);
  if (kind == 2) { int q = n / FH, hd = n - q * FH; return (hd >> 6) * 128 + ((hd >> 5) & 1) * 64 + q * 32 + (hd & 31); }
  return n;
}

DI void wt_tile(const float* __restrict__ src, int K, int N, int kt, int nt, bf16_t* __restrict__ dst, int dstStride, int kind, char* smem) {
  float* tile = (float*)smem;
  const int tid = tidx(), k0 = kt * 64, n0 = nt * 64;
#pragma unroll 4
  for (int ii = 0; ii < 16; ++ii) {
    int i = (tid >> 6) + 4 * ii, j = tid & 63, n = n0 + j;
    tile[i * 65 + j] = (n < N) ? src[(size_t)(k0 + i) * N + n] : 0.f;
  }
  __syncthreads();
#pragma unroll 4
  for (int ii = 0; ii < 16; ++ii) {
    int jj = (tid >> 6) + 4 * ii, kk = tid & 63, n = n0 + jj;
    if (n < N) dst[((size_t)((k0 + kk) >> 5) * dstStride + dest_row(kind, n)) * 32 + ((k0 + kk) & 31)] = f2bf(tile[kk * 65 + jj]);
  }
}

DI void mod_item(const Params& p, int l, int cgi, char* smem) {
  float* sc = (float*)smem;
  float* red = sc + 17 * 256;
  const int tid = tidx(), col = tid & 31, kg = tid >> 5, n = cgi * 32 + col;
  float acc[17];
#pragma unroll
  for (int r = 0; r < 17; ++r) acc[r] = 0.f;
  const float* w = p.w_ada + (size_t)l * 1024 * 6144 + n;
  for (int kc = 0; kc < 4; ++kc) {
    __syncthreads();
#pragma unroll
    for (int r = 0; r < 17; ++r) {
      float v = (r < 16) ? p.c[r * 1024 + kc * 256 + tid] : p.c_ctx[kc * 256 + tid];
      sc[r * 256 + tid] = siluf(v);
    }
    __syncthreads();
#pragma unroll 4
    for (int kk = 0; kk < 32; ++kk) {
      int kl = kg * 32 + kk;
      float wv = w[(size_t)(kc * 256 + kl) * 6144];
#pragma unroll
      for (int r = 0; r < 17; ++r) acc[r] += sc[r * 256 + kl] * wv;
    }
  }
#pragma unroll
  for (int r = 0; r < 17; ++r) red[(kg * 17 + r) * 32 + col] = acc[r];
  __syncthreads();
  float* MOD = (float*)(p.ws + OFF_MOD);
  for (int o = tid; o < 17 * 32; o += 256) {
    int r = o >> 5, cc = o & 31;
    float s = p.b_ada[l * 6144 + cgi * 32 + cc];
#pragma unroll
    for (int g = 0; g < 8; ++g) s += red[(g * 17 + r) * 32 + cc];
    MOD[((size_t)l * 17 + r) * 6144 + cgi * 32 + cc] = s;
  }
}

DI void phase_prepA(const Params& p, char* smem) {
  const int tid = tidx();
  for (int it = blockIdx.x; it < 6435; it += gridDim.x) {
    __syncthreads();
    if (it < 6048) {
      int l = it / 3024, r = it % 3024;
      if (r < 656) wt_tile(p.w_in + (size_t)l * 1024 * 2592, 1024, 2592, r / 41, r % 41, (bf16_t*)(p.ws + OFF_WTIN) + (size_t)l * NPAD_IN * 1024, NPAD_IN, 0, smem);
      else if (r < 912) { r -= 656; wt_tile(p.w_out + (size_t)l * 1024 * 1024, 1024, 1024, r / 16, r % 16, (bf16_t*)(p.ws + OFF_WTOUT) + (size_t)l * 1024 * 1024, 1024, 1, smem); }
      else if (r < 2320) { r -= 912; wt_tile(p.w_ffn_in + (size_t)l * 1024 * 5632, 1024, 5632, r / 88, r % 88, (bf16_t*)(p.ws + OFF_WTFI) + (size_t)l * 5632 * 1024, 5632, 2, smem); }
      else { r -= 2320; wt_tile(p.w_ffn_out + (size_t)l * FH * 1024, FH, 1024, r / 16, r % 16, (bf16_t*)(p.ws + OFF_WTFO) + (size_t)l * 1024 * FH, 1024, 1, smem); }
    } else if (it < 6050) {
      int l = it - 6048;
      for (int i = tid; i < 32 * 384; i += 256) {
        u32x4* d = (u32x4*)((bf16_t*)(p.ws + OFF_WTIN) + (size_t)l * NPAD_IN * 1024 + ((size_t)(i / 384) * NPAD_IN + 2592) * 32);
        d[i % 384] = (u32x4){0u, 0u, 0u, 0u};
      }
    } else if (it < 6434) {
      int r = it - 6050;
      mod_item(p, r / 192, r % 192, smem);
    } else {
      float* rc = (float*)(p.ws + OFF_ROPE);
      for (int i = tid; i < 1024; i += 256) {
        int pos = i >> 4, f = i & 15;
        float invf = powf(10000.f, -(float)f / 16.f);
        float ang = (float)pos * invf;
        rc[i] = cosf(ang);
        rc[1024 + i] = sinf(ang);
      }
    }
  }
}

DI void phase_prepB(const Params& p) {
  const float* MOD = (const float*)(p.ws + OFF_MOD);
  float* TAB = (float*)(p.ws + OFF_TAB);
  for (int i = blockIdx.x * 256 + tidx(); i < 2 * 17 * 1024; i += gridDim.x * 256) {
    int k = i & 1023, b = (i >> 10) % 17, l = i / (17 * 1024);
    const float* m = MOD + ((size_t)l * 17 + b) * 6144;
    float sh1 = m[k], sc1 = m[1024 + k], sh2 = m[3072 + k], sc2 = m[4096 + k];
    float g0 = (l == 0) ? 1.f : p.ln2_g[k], b0 = (l == 0) ? 0.f : p.ln2_b[k];
    float* t = TAB + (size_t)l * 4 * 17 * 1024 + b * 1024 + k;
    t[0 * 17 * 1024] = g0 * (1.f + sc1);
    t[1 * 17 * 1024] = b0 * (1.f + sc1) + sh1;
    t[2 * 17 * 1024] = p.ln1_g[l * 1024 + k] * (1.f + sc2);
    t[3 * 17 * 1024] = p.ln1_b[l * 1024 + k] * (1.f + sc2) + sh2;
  }
}

DI void row_stats(const float* st, float& mu, float& rs) {
  const f32x4* s4 = (const f32x4*)st;
  f32x4 a = s4[0], b = s4[1], c = s4[2], d = s4[3];
  float S = a.x + a.z + b.x + b.z + c.x + c.z + d.x + d.z;
  float SS = a.y + a.w + b.y + b.w + c.y + c.w + d.y + d.w;
  mu = S * (1.f / 1024.f);
  float var = fmaxf(SS * (1.f / 1024.f) - mu * mu, 0.f);
  rs = rsqrtf(var + 1e-5f);
}

template <int MODE>
DI void gemm_tile(const Params& p, int l, int tm, int tn, char* smem) {
  constexpr int K = (MODE == 3) ? FH : 1024;
  constexpr int NK = K / 32;
  char* As = smem;
  char* Bs = smem + 16384;
  float* red = (float*)(smem + 73728);
  const int tid = tidx(), lane = tid & 63, wid = tid >> 6, wr = wid >> 1, wc = wid & 1, fr = lane & 15, fq = lane >> 4;
  const int row0 = tm * 256;
  const bool lat = row0 < NLAT;
  const int bidx = lat ? row0 / NSEQ : 16;
  float* Y1 = (float*)(p.ws + OFF_Y1);
  float* CTXY2 = (float*)(p.ws + OFF_CTXY2);
  const float* ST1 = (const float*)(p.ws + OFF_ST1);
  const float* ST2 = (const float*)(p.ws + OFF_ST2);
  bf16_t* P = (bf16_t*)(p.ws + OFF_P);
  const float* MOD = (const float*)(p.ws + OFF_MOD) + ((size_t)l * 17 + bidx) * 6144;

  const bf16_t* absrc; int astride;
  if (MODE == 0) { absrc = (const bf16_t*)(p.ws + OFF_Y1) + (size_t)row0 * 32; astride = 32; }
  else if (MODE == 1) { absrc = P + (size_t)row0 * PC; astride = PC; }
  else if (MODE == 2) { absrc = (const bf16_t*)(p.ws + OFF_UF) + (size_t)row0 * 32; astride = 32; }
  else { absrc = P + (size_t)row0 * 32; astride = 32; }
  constexpr int NPADB = (MODE == 0) ? NPAD_IN : (MODE == 2 ? 5632 : 1024);
  const bf16_t* wt;
  if (MODE == 0) wt = (const bf16_t*)(p.ws + OFF_WTIN) + (size_t)l * NPAD_IN * 1024;
  else if (MODE == 1) wt = (const bf16_t*)(p.ws + OFF_WTOUT) + (size_t)l * 1024 * 1024;
  else if (MODE == 2) wt = (const bf16_t*)(p.ws + OFF_WTFI) + (size_t)l * 5632 * 1024;
  else wt = (const bf16_t*)(p.ws + OFF_WTFO) + (size_t)l * 1024 * FH;
  const int prow = lane >> 2, pch = (lane & 3) ^ ((-(prow >> 2)) & 3);
  const bf16_t* asrc_t = absrc + (size_t)(wid * 64 + prow) * astride + pch * 8;
  const bf16_t* bsrc_t = wt + (size_t)(tn * 128 + wid * 32 + prow) * 32 + pch * 8;
  char* adst_t = As + wid * 4096 + lane * 16;
  char* bdst_t = Bs + wid * 2048 + lane * 16;
  auto dma_a = [&](int kt, int buf, int i) __attribute__((always_inline)) {
    size_t kk;
    if (MODE == 1) { kk = kt * 32; if (kk >= 384) kk += 1280; }
    else kk = (size_t)kt * NROWS * 32;
    __builtin_amdgcn_global_load_lds((const unsigned*)(asrc_t + (size_t)i * 16 * astride + kk), (unsigned*)(adst_t + buf * 24576 + i * 1024), 16, 0, 0);
  };
  auto dma_b = [&](int kt, int buf, int i) __attribute__((always_inline)) {
    __builtin_amdgcn_global_load_lds((const unsigned*)(bsrc_t + (size_t)i * 16 * 32 + (size_t)kt * NPADB * 32), (unsigned*)(bdst_t + buf * 24576 + i * 1024), 16, 0, 0);
  };
  auto dma = [&](int kt, int buf) __attribute__((always_inline)) {
#pragma unroll
    for (int i = 0; i < 4; ++i) dma_a(kt, buf, i);
#pragma unroll
    for (int i = 0; i < 2; ++i) dma_b(kt, buf, i);
  };
  const int fpos = (fq ^ ((-(fr >> 2)) & 3)) * 16;

  f32x4 acc[8][4];
#pragma unroll
  for (int m = 0; m < 8; ++m)
#pragma unroll
    for (int n = 0; n < 4; ++n) acc[m][n] = (f32x4){0.f, 0.f, 0.f, 0.f};

  __syncthreads();
  dma(0, 0);
  dma(1, 1);
  asm volatile("s_waitcnt vmcnt(6)" ::: "memory");
  __syncthreads();
  int sc = 0, sn = 2;
  for (int kt = 0; kt < NK; ++kt) {
    const bool pf = kt + 2 < NK;
    {
      bf16x8 af[8], bf[4];
      const char* ab = As + sc * 24576 + (wr * 128 + fr) * 64 + fpos;
      const char* bb = Bs + sc * 24576 + (wc * 64 + fr) * 64 + fpos;
#pragma unroll
      for (int n = 0; n < 4; ++n) bf[n] = *(const bf16x8*)(bb + n * 1024);
#pragma unroll
      for (int m = 0; m < 8; ++m) af[m] = *(const bf16x8*)(ab + m * 1024);
      __builtin_amdgcn_sched_barrier(0);
      if (pf) { dma_a(kt + 2, sn, 0); dma_a(kt + 2, sn, 1); }
      __builtin_amdgcn_sched_barrier(0);
#pragma unroll
      for (int m = 0; m < 2; ++m)
#pragma unroll
        for (int n = 0; n < 4; ++n) acc[m][n] = mfma16(bf[n], af[m], acc[m][n]);
      __builtin_amdgcn_sched_barrier(0);
      if (pf) { dma_a(kt + 2, sn, 2); dma_a(kt + 2, sn, 3); }
      __builtin_amdgcn_sched_barrier(0);
#pragma unroll
      for (int m = 2; m < 4; ++m)
#pragma unroll
        for (int n = 0; n < 4; ++n) acc[m][n] = mfma16(bf[n], af[m], acc[m][n]);
      __builtin_amdgcn_sched_barrier(0);
      if (pf) { dma_b(kt + 2, sn, 0); dma_b(kt + 2, sn, 1); }
      __builtin_amdgcn_sched_barrier(0);
#pragma unroll
      for (int m = 4; m < 8; ++m)
#pragma unroll
        for (int n = 0; n < 4; ++n) acc[m][n] = mfma16(bf[n], af[m], acc[m][n]);
      __builtin_amdgcn_sched_barrier(0);
    }
    if (kt + 2 < NK) asm volatile("s_waitcnt vmcnt(6)" ::: "memory");
    else asm volatile("s_waitcnt vmcnt(0)" ::: "memory");
    __syncthreads();
    sc = (sc == 2) ? 0 : sc + 1;
    sn = (sn == 2) ? 0 : sn + 1;
  }
  if (MODE == 0) {
    const int hs = tn * 2 + wc;
    if (hs > 40) return;
    const bool isq = (hs >= 30 && hs < 36), isk = (hs == 36 || hs == 37);
    if (isq || isk) {
      const float* nw = (isq ? p.qnorm_w : p.knorm_w) + l * 64;
      const float* rc = (const float*)(p.ws + OFF_ROPE);
      float w_[4][4];
#pragma unroll
      for (int n = 0; n < 4; ++n)
#pragma unroll
        for (int j = 0; j < 4; ++j) w_[n][j] = nw[n * 16 + fq * 4 + j];
#pragma unroll
      for (int m = 0; m < 8; ++m) {
        float ss = 0.f;
#pragma unroll
        for (int n = 0; n < 4; ++n)
#pragma unroll
          for (int j = 0; j < 4; ++j) ss += acc[m][n][j] * acc[m][n][j];
        ss += shx(ss, 16); ss += shx(ss, 32);
        float inv = rsqrtf(ss * (1.f / 64.f) + 1e-6f);
#pragma unroll
        for (int n = 0; n < 4; ++n)
#pragma unroll
          for (int j = 0; j < 4; ++j) acc[m][n][j] *= inv * w_[n][j];
        if (lat) {
          int t = (row0 + wr * 128 + m * 16 + fr) & (NSEQ - 1);
          int gr = t >> 6, gc = t & 63;
#pragma unroll
          for (int j = 0; j < 4; ++j) {
            float cr = rc[gr * 16 + fq * 4 + j], sr = rc[1024 + gr * 16 + fq * 4 + j];
            float cc = rc[gc * 16 + fq * 4 + j], sn = rc[1024 + gc * 16 + fq * 4 + j];
            float x1 = acc[m][0][j], x2 = acc[m][1][j], x3 = acc[m][2][j], x4 = acc[m][3][j];
            acc[m][0][j] = x1 * cr - x2 * sr; acc[m][1][j] = x2 * cr + x1 * sr;
            acc[m][2][j] = x3 * cc - x4 * sn; acc[m][3][j] = x4 * cc + x3 * sn;
          }
        }
      }
    }
    float scl = 1.f;
    if (hs < 6 || isq) scl = QSCALE;
    else if (hs == 18 || hs == 19) scl = 0.17677669529663687f;
    const int nmax = (hs == 40) ? 2 : 4;
#pragma unroll
    for (int m = 0; m < 8; ++m) {
      bf16_t* pr = P + (size_t)(row0 + wr * 128 + m * 16 + fr) * PC + hs * 64 + fq * 4;
#pragma unroll
      for (int n = 0; n < 4; ++n) {
        if (n < nmax) {
          u32x2 u; u.x = pack2(acc[m][n][0] * scl, acc[m][n][1] * scl); u.y = pack2(acc[m][n][2] * scl, acc[m][n][3] * scl);
          *(u32x2*)(pr + n * 16) = u;
        }
      }
    }
  } else if (MODE == 2) {
    bf16_t* H = P;
#pragma unroll
    for (int m = 0; m < 8; ++m) {
      bf16_t* hr = H + ((size_t)(tn * 2 + wc) * NROWS + row0 + wr * 128 + m * 16 + fr) * 32 + fq * 4;
#pragma unroll
      for (int n = 0; n < 2; ++n) {
        float h0 = siluf(acc[m][n][0]) * acc[m][n + 2][0], h1 = siluf(acc[m][n][1]) * acc[m][n + 2][1];
        float h2 = siluf(acc[m][n][2]) * acc[m][n + 2][2], h3 = siluf(acc[m][n][3]) * acc[m][n + 2][3];
        u32x2 u; u.x = pack2(h0, h1); u.y = pack2(h2, h3);
        *(u32x2*)(hr + n * 16) = u;
      }
    }
  } else {
    const float* gate = MOD + (MODE == 1 ? 2048 : 5120) + tn * 128 + wc * 64 + fq * 4;
    const float* lng = nullptr; const float* lnb = nullptr; const float* xs; const float* st = nullptr;
    float* dst; float* stout;
    bool doln;
    if (MODE == 1) {
      doln = (l == 1);
      if (l == 0) xs = lat ? p.x + (size_t)row0 * 1024 : p.ctx + (size_t)(row0 - NLAT) * 1024;
      else { xs = p.out + (size_t)row0 * 1024; st = ST2 + (size_t)row0 * 16; lng = p.ln2_g; lnb = p.ln2_b; }
      dst = Y1 + (size_t)row0 * 1024;
      stout = (float*)(p.ws + OFF_ST1) + (size_t)row0 * 16;
    } else {
      doln = true;
      xs = Y1 + (size_t)row0 * 1024; st = ST1 + (size_t)row0 * 16; lng = p.ln1_g + l * 1024; lnb = p.ln1_b + l * 1024;
      dst = lat ? p.out + (size_t)row0 * 1024 : CTXY2 + (size_t)(row0 - NLAT) * 1024;
      stout = (float*)(p.ws + OFF_ST2) + (size_t)row0 * 16;
    }
    const int cb = tn * 128 + wc * 64 + fq * 4;
    float* rst = red + 1024;
    if (doln) { float m_, r_; row_stats(st + (size_t)tid * 16, m_, r_); rst[tid * 2] = m_; rst[tid * 2 + 1] = r_; }
    __syncthreads();
#pragma unroll
    for (int m = 0; m < 8; ++m) {
      const int rl = wr * 128 + m * 16 + fr;
      float rmu = 0.f, rrs = 1.f;
      if (doln) { rmu = rst[rl * 2]; rrs = rst[rl * 2 + 1]; }
      float s_ = 0.f, ss = 0.f;
      const float* xr = xs + (size_t)rl * 1024 + cb;
      float* dr = dst + (size_t)rl * 1024 + cb;
#pragma unroll
      for (int n = 0; n < 4; ++n) {
        const f32x4 gv = *(const f32x4*)(gate + n * 16);
        f32x4 xv = *(const f32x4*)(xr + n * 16);
        if (doln) {
          const f32x4 lg = *(const f32x4*)(lng + cb + n * 16), lb = *(const f32x4*)(lnb + cb + n * 16);
          xv.x = (xv.x - rmu) * rrs * lg.x + lb.x; xv.y = (xv.y - rmu) * rrs * lg.y + lb.y;
          xv.z = (xv.z - rmu) * rrs * lg.z + lb.z; xv.w = (xv.w - rmu) * rrs * lg.w + lb.w;
        }
        f32x4 o;
        o.x = ALPHA * xv.x + gv.x * acc[m][n][0]; o.y = ALPHA * xv.y + gv.y * acc[m][n][1];
        o.z = ALPHA * xv.z + gv.z * acc[m][n][2]; o.w = ALPHA * xv.w + gv.w * acc[m][n][3];
        *(f32x4*)(dr + n * 16) = o;
        s_ += o.x + o.y + o.z + o.w;
        ss += o.x * o.x + o.y * o.y + o.z * o.z + o.w * o.w;
      }
      s_ += shx(s_, 16); s_ += shx(s_, 32);
      ss += shx(ss, 16); ss += shx(ss, 32);
      if (fq == 0) { red[((wr * 2 + wc) * 128 + m * 16 + fr) * 2] = s_; red[((wr * 2 + wc) * 128 + m * 16 + fr) * 2 + 1] = ss; }
      if (m & 1) __builtin_amdgcn_sched_barrier(0);
    }
    __syncthreads();
    {
      int r = tid, w_ = r >> 7, rr = r & 127;
      float s = red[((w_ * 2 + 0) * 128 + rr) * 2] + red[((w_ * 2 + 1) * 128 + rr) * 2];
      float ss = red[((w_ * 2 + 0) * 128 + rr) * 2 + 1] + red[((w_ * 2 + 1) * 128 + rr) * 2 + 1];
      *(f32x2*)(stout + (size_t)r * 16 + tn * 2) = (f32x2){s, ss};
    }
  }
}

template <int MODE>
DI void phase_gemm(const Params& p, int l, char* smem) {
  const int NT = (MODE == 0) ? 21 : (MODE == 2 ? 44 : 8);
  const int MT = (l == 0 || MODE == 0) ? 144 : 128;
  const int vb = (blockIdx.x & 7) * (gridDim.x >> 3) + (blockIdx.x >> 3);
  for (int t = vb; t < MT * NT; t += gridDim.x) gemm_tile<MODE>(p, l, t / NT, t % NT, smem);
}

typedef __attribute__((address_space(3))) s16x4 lds_s16x4;
template <int NH>
DI void attn_item(const Params& p, int qrow0, int qcol, int kcol, int vcol, int lat_row0, int nb_lat, int ctx_row0, int nb_ctx,
                  bool na, int dr0, const float* rpb_h, char* smem, bool dry = false) {
  bf16_t* KV = (bf16_t*)smem;
  float* rpbs = (float*)(KV + 4 * 64 * 72);
  const int tid = tidx(), lane = tid & 63, w = tid >> 6, fr = lane & 15, fq = lane >> 4;
  bf16_t* P = (bf16_t*)(p.ws + OFF_P);
  __syncthreads();
  if (na) for (int i = tid; i < 465; i += 256) rpbs[i] = rpb_h[i] * LOG2E;
  bf16x8 qf[NH][2];
  f32x4 o[NH][4];
  float mrun[NH], lrun[NH];
#pragma unroll
  for (int hh = 0; hh < NH; ++hh) {
    const bf16_t* qp = P + (size_t)(qrow0 + w * 16 + fr) * PC + qcol + hh * 64 + fq * 8;
    qf[hh][0] = *(const bf16x8*)qp; qf[hh][1] = *(const bf16x8*)(qp + 32);
#pragma unroll
    for (int i = 0; i < 4; ++i) o[hh][i] = (f32x4){0.f, 0.f, 0.f, 0.f};
    mrun[hh] = -1e30f; lrun[hh] = 0.f;
  }
  const int nb = nb_lat + nb_ctx;
  u32x4 rk[2], rv[2];
  const int lkey = tid >> 3, ldc = (tid & 7) * 8;
  auto gload = [&](int kb) __attribute__((always_inline)) {
    int rb = kb < nb_lat ? lat_row0 + kb * 64 : ctx_row0 + (kb - nb_lat) * 64;
#pragma unroll
    for (int i = 0; i < 2; ++i) {
      const bf16_t* rp = P + (size_t)(rb + lkey + i * 32) * PC + ldc;
      rk[i] = *(const u32x4*)(rp + kcol);
      rv[i] = *(const u32x4*)(rp + vcol);
    }
  };
  auto lstore = [&](int buf) __attribute__((always_inline)) {
#pragma unroll
    for (int i = 0; i < 2; ++i) {
      bf16_t* d = KV + buf * 2 * 64 * 72 + (lkey + i * 32) * 72 + ldc;
      *(u32x4*)d = rk[i];
      *(u32x4*)(d + 64 * 72) = rv[i];
    }
  };
  const int qj = w * 16 + fr;
  const int cs = min(max(qj - 8, 0), 48);
  gload(0);
  lstore(0);
  __syncthreads();
  for (int kb = 0; kb < nb; ++kb) {
    const bf16_t* Kb = KV + (kb & 1) * 2 * 64 * 72;
    const bf16_t* Vb = Kb + 64 * 72;
    if (kb + 1 < nb) gload(kb + 1);
    const bool msk = na && kb < nb_lat;
    int mt_lo = 0, mt_hi = 3;
    if (msk) { mt_lo = (w >= 2) ? w - 1 : 0; mt_hi = (w <= 1) ? w + 1 : 3; }
    bf16x8 kf[4][2];
#pragma unroll
    for (int mt = 0; mt < 4; ++mt)
      if (mt >= mt_lo && mt <= mt_hi) {
        kf[mt][0] = *(const bf16x8*)(Kb + (mt * 16 + fr) * 72 + fq * 8);
        kf[mt][1] = *(const bf16x8*)(Kb + (mt * 16 + fr) * 72 + 32 + fq * 8);
      }
    bf16x8 pf[NH][2];
#pragma unroll
    for (int hh = 0; hh < NH; ++hh) {
      f32x4 s[4];
#pragma unroll
      for (int mt = 0; mt < 4; ++mt) {
        if (mt >= mt_lo && mt <= mt_hi) {
          s[mt] = mfma16(kf[mt][0], qf[hh][0], (f32x4){0.f, 0.f, 0.f, 0.f});
          s[mt] = mfma16(kf[mt][1], qf[hh][1], s[mt]);
          if (msk) {
#pragma unroll
            for (int j = 0; j < 4; ++j) {
              int kc = mt * 16 + fq * 4 + j;
              bool valid = (kc >= cs) && (kc < cs + 16);
              int bi = min(max(kc - qj, -15), 15);
              s[mt][j] = valid ? s[mt][j] + rpbs[(dr0 + kb) * 31 + bi + 15] : -1e30f;
            }
          }
        } else s[mt] = (f32x4){-1e30f, -1e30f, -1e30f, -1e30f};
      }
      float mx = fmaxf(fmaxf(fmaxf(s[0][0], s[0][1]), fmaxf(s[0][2], s[0][3])), fmaxf(fmaxf(s[1][0], s[1][1]), fmaxf(s[1][2], s[1][3])));
      mx = fmaxf(mx, fmaxf(fmaxf(fmaxf(s[2][0], s[2][1]), fmaxf(s[2][2], s[2][3])), fmaxf(fmaxf(s[3][0], s[3][1]), fmaxf(s[3][2], s[3][3]))));
      mx = fmaxf(mx, shx(mx, 16)); mx = fmaxf(mx, shx(mx, 32));
      const float mnew = fmaxf(mrun[hh], mx);
      if (__builtin_amdgcn_ballot_w64(mnew > mrun[hh]) != 0) {
        const float alpha = __builtin_amdgcn_exp2f(mrun[hh] - mnew);
        mrun[hh] = mnew;
        lrun[hh] *= alpha;
#pragma unroll
        for (int i = 0; i < 4; ++i) { o[hh][i][0] *= alpha; o[hh][i][1] *= alpha; o[hh][i][2] *= alpha; o[hh][i][3] *= alpha; }
      }
      float ps = 0.f;
#pragma unroll
      for (int mt = 0; mt < 4; ++mt)
#pragma unroll
        for (int j = 0; j < 4; ++j) { float e = __builtin_amdgcn_exp2f(s[mt][j] - mnew); s[mt][j] = e; ps += e; }
      lrun[hh] += ps;
#pragma unroll
      for (int kp = 0; kp < 2; ++kp) {
        u32x4 pk;
        pk.x = pack2(s[2 * kp][0], s[2 * kp][1]); pk.y = pack2(s[2 * kp][2], s[2 * kp][3]);
        pk.z = pack2(s[2 * kp + 1][0], s[2 * kp + 1][1]); pk.w = pack2(s[2 * kp + 1][2], s[2 * kp + 1][3]);
        pf[hh][kp] = __builtin_bit_cast(bf16x8, pk);
      }
    }
#pragma unroll
    for (int kp = 0; kp < 2; ++kp) {
      if ((kp == 0 && mt_lo <= 1) || (kp == 1 && mt_hi >= 2)) {
#pragma unroll
        for (int dt = 0; dt < 4; ++dt) {
          const bf16_t* vp = Vb + (kp * 32 + fq * 4 + (fr >> 2)) * 72 + dt * 16 + (fr & 3) * 4;
          s16x4 lo = __builtin_amdgcn_ds_read_tr16_b64_v4i16((lds_s16x4*)vp);
          s16x4 hi = __builtin_amdgcn_ds_read_tr16_b64_v4i16((lds_s16x4*)(vp + 16 * 72));
          bf16x8 vf = __builtin_shufflevector(lo, hi, 0, 1, 2, 3, 4, 5, 6, 7);
#pragma unroll
          for (int hh = 0; hh < NH; ++hh) o[hh][dt] = mfma16(vf, pf[hh][kp], o[hh][dt]);
        }
      }
    }
    if (kb + 1 < nb) lstore((kb + 1) & 1);
    __syncthreads();
  }
#pragma unroll
  for (int hh = 0; hh < NH; ++hh) {
    float lt = lrun[hh];
    lt += shx(lt, 16); lt += shx(lt, 32);
    const float inv = 1.f / lt;
    bf16_t* op = dry ? (bf16_t*)(p.ws + OFF_Y1) + (size_t)((qrow0 + w * 16 + fr) & 16383) * PC + qcol + hh * 64 + fq * 4
                     : P + (size_t)(qrow0 + w * 16 + fr) * PC + qcol + hh * 64 + fq * 4;
#pragma unroll
    for (int dt = 0; dt < 4; ++dt) {
      u32x2 u; u.x = pack2(o[hh][dt][0] * inv, o[hh][dt][1] * inv); u.y = pack2(o[hh][dt][2] * inv, o[hh][dt][3] * inv);
      *(u32x2*)(op + dt * 16) = u;
    }
  }
}

DI float logsig(float z) { return fminf(z, 0.f) - __logf(1.f + __expf(-fabsf(z))); }
DI int chunk_row0(int b, int cidx) { return cidx < 4 ? NLAT + b * LC + cidx * 64 : b * NSEQ + (cidx - 4) * 64; }
DI int chain_pos(int cidx, int dir) { return dir == 0 ? cidx : (cidx < 4 ? 3 - cidx : 39 - cidx); }

DI void gla_gates(const Params& p, int l, int h, int dir, int row0, float* bs, float* lrs, float* was, float* segt) {
  const int tid = tidx();
  const bf16_t* P = (const bf16_t*)(p.ws + OFF_P);
  {
    int s = tid >> 2, r4 = (tid & 3) * 4;
    u32x2 u = *(const u32x2*)(P + (size_t)(row0 + s) * PC + C_GLR + dir * 16 + r4);
    lrs[s * 17 + r4] = bflo(u.x); lrs[s * 17 + r4 + 1] = bfhi(u.x); lrs[s * 17 + r4 + 2] = bflo(u.y); lrs[s * 17 + r4 + 3] = bfhi(u.y);
    for (int i = tid; i < 512; i += 256) was[i] = p.gla_wa2[(((size_t)l * 2 + dir) * 16 + (i >> 5)) * 128 + h * 32 + (i & 31)];
  }
  __syncthreads();
  const int d = tid & 31, sg = tid >> 5;
  const float ba = p.gla_ba[(l * 2 + dir) * 128 + h * 32 + d];
  float la[8];
#pragma unroll
  for (int i = 0; i < 8; ++i) {
    int s = sg * 8 + i;
    float z = ba;
#pragma unroll
    for (int r = 0; r < 16; ++r) z += lrs[s * 17 + r] * was[r * 32 + d];
    la[i] = logsig(z) * (1.f / 16.f);
  }
  if (dir == 0) {
#pragma unroll
    for (int i = 1; i < 8; ++i) la[i] += la[i - 1];
    segt[sg * 32 + d] = la[7];
  } else {
#pragma unroll
    for (int i = 6; i >= 0; --i) la[i] += la[i + 1];
    segt[sg * 32 + d] = la[0];
  }
  __syncthreads();
  float pre = 0.f;
#pragma unroll
  for (int g = 0; g < 8; ++g) {
    float v = segt[g * 32 + d];
    if (dir == 0 ? (g < sg) : (g > sg)) pre += v;
  }
#pragma unroll
  for (int i = 0; i < 8; ++i) bs[(sg * 8 + i) * 33 + d] = la[i] + pre;
  __syncthreads();
}

DI void gla_passA(const Params& p, int l, int item, char* smem) {
  float* bs = (float*)smem;
  float* kw = bs + 64 * 33;
  float* vs = kw + 64 * 32;
  float* lrs = vs + 64 * 64;
  float* was = lrs + 64 * 17;
  float* segt = was + 512;
  const int tid = tidx();
  int dir = item & 1, cidx = (item >> 1) % 36, bh = item / 72, h = bh & 3, b = bh >> 2;
  const int row0 = chunk_row0(b, cidx);
  const bf16_t* P = (const bf16_t*)(p.ws + OFF_P);
  __syncthreads();
  gla_gates(p, l, h, dir, row0, bs, lrs, was, segt);
  {
    int s = tid >> 2, d8 = (tid & 3) * 8;
    u32x4 u = *(const u32x4*)(P + (size_t)(row0 + s) * PC + C_GLK + h * 32 + d8);
    unsigned uu[4] = {u.x, u.y, u.z, u.w};
    const int slast = dir == 0 ? 63 : 0;
#pragma unroll
    for (int e = 0; e < 4; ++e) {
      int d0 = d8 + 2 * e;
      kw[s * 32 + d0] = bflo(uu[e]) * __expf(bs[slast * 33 + d0] - bs[s * 33 + d0]);
      kw[s * 32 + d0 + 1] = bfhi(uu[e]) * __expf(bs[slast * 33 + d0 + 1] - bs[s * 33 + d0 + 1]);
    }
    int v16 = (tid & 3) * 16;
#pragma unroll
    for (int q = 0; q < 2; ++q) {
      u32x4 w = *(const u32x4*)(P + (size_t)(row0 + s) * PC + C_GLV + h * 64 + v16 + q * 8);
      unsigned ww[4] = {w.x, w.y, w.z, w.w};
#pragma unroll
      for (int e = 0; e < 4; ++e) { vs[s * 64 + v16 + q * 8 + 2 * e] = bflo(ww[e]); vs[s * 64 + v16 + q * 8 + 2 * e + 1] = bfhi(ww[e]); }
    }
  }
  __syncthreads();
  const int v = tid & 63, dg = (tid >> 6) * 8;
  float acc[8];
#pragma unroll
  for (int i = 0; i < 8; ++i) acc[i] = 0.f;
  for (int s = 0; s < 64; ++s) {
    float vv = vs[s * 64 + v];
    f32x4 k0 = *(const f32x4*)(kw + s * 32 + dg), k1 = *(const f32x4*)(kw + s * 32 + dg + 4);
    acc[0] += k0.x * vv; acc[1] += k0.y * vv; acc[2] += k0.z * vv; acc[3] += k0.w * vv;
    acc[4] += k1.x * vv; acc[5] += k1.y * vv; acc[6] += k1.z * vv; acc[7] += k1.w * vv;
  }
  const int pos = chain_pos(cidx, dir);
  float* LS = (float*)(p.ws + OFF_LS) + ((size_t)((b * 4 + h) * 2 + dir) * 36 + pos) * 2048;
#pragma unroll
  for (int i = 0; i < 8; ++i) LS[(dg + i) * 64 + v] = acc[i];
  if (tid < 32) {
    float* BL = (float*)(p.ws + OFF_BL) + ((size_t)((b * 4 + h) * 2 + dir) * 36 + pos) * 32;
    BL[tid] = bs[(dir == 0 ? 63 : 0) * 33 + tid];
  }
}

DI void gla_scan(const Params& p, int item) {
  const int tid = tidx();
  const int chain = item >> 3, e = (item & 7) * 256 + tid, d = e >> 6;
  float* LS = (float*)(p.ws + OFF_LS) + (size_t)chain * 36 * 2048 + e;
  const float* BL = (const float*)(p.ws + OFF_BL) + (size_t)chain * 36 * 32 + d;
  float S = 0.f;
#pragma unroll 6
  for (int pos = 0; pos < 36; ++pos) {
    float x = LS[(size_t)pos * 2048], bl = BL[pos * 32];
    LS[(size_t)pos * 2048] = S;
    S = __expf(bl) * S + x;
  }
}

DI void gla_passB(const Params& p, int l, int b, int h, int cidx, char* smem, bool dry = false) {
  float* bs = (float*)smem;
  bf16_t* Qe = (bf16_t*)(bs + 64 * 33);
  bf16_t* Ke = Qe + 64 * 40;
  bf16_t* Vs = Ke + 64 * 40;
  bf16_t* S0 = Vs + 64 * 72;
  float* lrs = (float*)(S0 + 32 * 72);
  float* was = lrs + 64 * 17;
  float* segt = was + 512;
  const int tid = tidx(), lane = tid & 63, w = tid >> 6, fr = lane & 15, fq = lane >> 4;
  const int row0 = chunk_row0(b, cidx);
  bf16_t* P = (bf16_t*)(p.ws + OFF_P);
  f32x4 o[4];
#pragma unroll
  for (int i = 0; i < 4; ++i) o[i] = (f32x4){0.f, 0.f, 0.f, 0.f};
  __syncthreads();
  {
    int s = tid >> 2, v16 = (tid & 3) * 16;
    const bf16_t* vp = P + (size_t)(row0 + s) * PC + C_GLV + h * 64 + v16;
    *(u32x4*)(Vs + s * 72 + v16) = *(const u32x4*)vp;
    *(u32x4*)(Vs + s * 72 + v16 + 8) = *(const u32x4*)(vp + 8);
  }
  for (int dir = 0; dir < 2; ++dir) {
    gla_gates(p, l, h, dir, row0, bs, lrs, was, segt);
    {
      int s = tid >> 2, d8 = (tid & 3) * 8;
      u32x4 uq = *(const u32x4*)(P + (size_t)(row0 + s) * PC + C_GLQ + h * 32 + d8);
      u32x4 uk = *(const u32x4*)(P + (size_t)(row0 + s) * PC + C_GLK + h * 32 + d8);
      u32x4 oq, ok;
#pragma unroll
      for (int e = 0; e < 4; ++e) {
        int d0 = d8 + 2 * e;
        float b0 = bs[s * 33 + d0], b1 = bs[s * 33 + d0 + 1];
        oq[e] = pack2(bflo(uq[e]) * __expf(b0), bfhi(uq[e]) * __expf(b1));
        ok[e] = pack2(bflo(uk[e]) * __expf(-b0), bfhi(uk[e]) * __expf(-b1));
      }
      *(u32x4*)(Qe + s * 40 + d8) = oq;
      *(u32x4*)(Ke + s * 40 + d8) = ok;
      const int pos = chain_pos(cidx, dir);
      const float* LS = (const float*)(p.ws + OFF_LS) + ((size_t)((b * 4 + h) * 2 + dir) * 36 + pos) * 2048;
      int d = tid >> 3, v8 = (tid & 7) * 8;
      f32x4 s0 = *(const f32x4*)(LS + d * 64 + v8), s1 = *(const f32x4*)(LS + d * 64 + v8 + 4);
      u32x4 os;
      os.x = pack2(s0.x, s0.y); os.y = pack2(s0.z, s0.w); os.z = pack2(s1.x, s1.y); os.w = pack2(s1.z, s1.w);
      *(u32x4*)(S0 + d * 72 + v8) = os;
    }
    __syncthreads();
    {
      const bf16x8 qf = *(const bf16x8*)(Qe + (w * 16 + fr) * 40 + fq * 8);
      f32x4 at[4];
#pragma unroll
      for (int mt = 0; mt < 4; ++mt) {
        const bool need = dir == 0 ? (mt <= w) : (mt >= w);
        if (need) {
          const bf16x8 kf = *(const bf16x8*)(Ke + (mt * 16 + fr) * 40 + fq * 8);
          at[mt] = mfma16(kf, qf, (f32x4){0.f, 0.f, 0.f, 0.f});
          if (mt == w) {
#pragma unroll
            for (int j = 0; j < 4; ++j) {
              const int sI = fq * 4 + j;
              const bool keep = dir == 0 ? (sI <= fr) : (sI >= fr);
              at[mt][j] = keep ? at[mt][j] : 0.f;
            }
          }
        } else at[mt] = (f32x4){0.f, 0.f, 0.f, 0.f};
      }
#pragma unroll
      for (int kp = 0; kp < 2; ++kp) {
        const bool needp = dir == 0 ? (2 * kp <= w) : (2 * kp + 1 >= w);
        if (needp) {
          u32x4 pk;
          pk.x = pack2(at[2 * kp][0], at[2 * kp][1]); pk.y = pack2(at[2 * kp][2], at[2 * kp][3]);
          pk.z = pack2(at[2 * kp + 1][0], at[2 * kp + 1][1]); pk.w = pack2(at[2 * kp + 1][2], at[2 * kp + 1][3]);
          const bf16x8 pf = __builtin_bit_cast(bf16x8, pk);
#pragma unroll
          for (int dt = 0; dt < 4; ++dt) {
            const bf16_t* vp = Vs + (kp * 32 + fq * 4 + (fr >> 2)) * 72 + dt * 16 + (fr & 3) * 4;
            s16x4 lo = __builtin_amdgcn_ds_read_tr16_b64_v4i16((lds_s16x4*)vp);
            s16x4 hi = __builtin_amdgcn_ds_read_tr16_b64_v4i16((lds_s16x4*)(vp + 16 * 72));
            bf16x8 vf = __builtin_shufflevector(lo, hi, 0, 1, 2, 3, 4, 5, 6, 7);
            o[dt] = mfma16(vf, pf, o[dt]);
          }
        }
      }
#pragma unroll
      for (int dt = 0; dt < 4; ++dt) {
        const bf16_t* sp = S0 + (fq * 8 + (fr >> 2)) * 72 + dt * 16 + (fr & 3) * 4;
        s16x4 lo = __builtin_amdgcn_ds_read_tr16_b64_v4i16((lds_s16x4*)sp);
        s16x4 hi = __builtin_amdgcn_ds_read_tr16_b64_v4i16((lds_s16x4*)(sp + 4 * 72));
        bf16x8 sf = __builtin_shufflevector(lo, hi, 0, 1, 2, 3, 4, 5, 6, 7);
        o[dt] = mfma16(sf, qf, o[dt]);
      }
    }
    __syncthreads();
  }
  float ss = 0.f;
#pragma unroll
  for (int dt = 0; dt < 4; ++dt) ss += o[dt][0] * o[dt][0] + o[dt][1] * o[dt][1] + o[dt][2] * o[dt][2] + o[dt][3] * o[dt][3];
  ss += shx(ss, 16); ss += shx(ss, 32);
  const float inv = rsqrtf(ss * (1.f / 64.f) + 1e-6f);
#pragma unroll
  for (int dt = 0; dt < 4; ++dt) {
    const f32x4 nw = *(const f32x4*)(p.gla_norm_w + l * 64 + dt * 16 + fq * 4);
    bf16_t* gp = P + (size_t)(row0 + w * 16 + fr) * PC + C_GLG + h * 64 + dt * 16 + fq * 4;
    u32x2 g = *(const u32x2*)gp;
    u32x2 u;
    u.x = pack2(o[dt][0] * inv * nw.x * siluf(bflo(g.x)), o[dt][1] * inv * nw.y * siluf(bfhi(g.x)));
    u.y = pack2(o[dt][2] * inv * nw.z * siluf(bflo(g.y)), o[dt][3] * inv * nw.w * siluf(bfhi(g.y)));
    if (dry) gp = (bf16_t*)(p.ws + OFF_Y1) + (size_t)((row0 + w * 16 + fr) & 16383) * PC + C_GLG + h * 64 + dt * 16 + fq * 4;
    *(u32x2*)gp = u;
  }
}

DI void phase_mixA(const Params& p, int l, char* smem, bool dry = false, int only = 3) {
  const int NGQA = NB * 2 * 32, NGLA = NB * 4 * 36 * 2;
  for (int it = blockIdx.x; it < NGQA + NGLA; it += gridDim.x) {
    if (it < NGQA) {
      if (!(only & 1)) continue;
      int b = it >> 6, rem = it & 63, g = rem >> 5, qt = rem & 31;
      attn_item<3>(p, b * NSEQ + qt * 64, C_GAQ + g * 192, C_GAK + g * 64, C_GAV + g * 64, b * NSEQ, 32, NLAT + b * LC, 4, false, 0, nullptr, smem, dry);
    } else if (only & 2) gla_passA(p, l, it - NGQA, smem);
  }
}
DI void phase_mixS(const Params& p, int l, char* smem, bool dry = false) {
  const int NSC = NB * 4 * 2 * 8, NNA = NB * 6 * 32, NCG = (l == 0) ? NB * 2 * 4 : 0, NCN = (l == 0) ? NB * 6 * 4 : 0;
  for (int it = blockIdx.x; it < NSC + NNA + NCG + NCN; it += gridDim.x) {
    if (it < NSC) {
      if (!dry) gla_scan(p, it);
    } else if (it < NSC + NNA) {
      int i = it - NSC, b = i / 192, rem = i % 192, h = rem >> 5, r = rem & 31;
      int rs = min(max(r - 4, 0), 24);
      attn_item<1>(p, b * NSEQ + r * 64, C_NAQ + h * 64, C_NAK + h * 64, C_NAV + h * 64, b * NSEQ + rs * 64, 8, NLAT + b * LC, 4, true, rs - r + 7,
                   p.na_rpb + ((size_t)l * 6 + h) * 465, smem, dry);
    } else if (it < NSC + NNA + NCG) {
      int i = it - NSC - NNA, b = i >> 3, g = (i >> 2) & 1, qt = i & 3;
      attn_item<3>(p, NLAT + b * LC + qt * 64, C_GAQ + g * 192, C_GAK + g * 64, C_GAV + g * 64, 0, 0, NLAT + b * LC, 4, false, 0, nullptr, smem, dry);
    } else {
      int i = it - NSC - NNA - NCG, b = i / 24, rem = i % 24, h = rem >> 2, qt = rem & 3;
      attn_item<1>(p, NLAT + b * LC + qt * 64, C_NAQ + h * 64, C_NAK + h * 64, C_NAV + h * 64, 0, 0, NLAT + b * LC, 4, false, 0, nullptr, smem, dry);
    }
  }
}
DI void phase_mixB(const Params& p, int l, char* smem, bool dry = false) {
  const int cpl = (l == 0) ? 36 : 32;
  const int NGLB = NB * 4 * cpl;
  for (int it = blockIdx.x; it < NGLB; it += gridDim.x) {
    int cc = it % cpl, bh = it / cpl;
    gla_passB(p, l, bh >> 2, bh & 3, cc + (36 - cpl), smem, dry);
  }
}

DI void phase_final(const Params& p) {
  const int lane = tidx() & 63, w = tidx() >> 6;
  const float* g = p.ln2_g + 1024; const float* bb = p.ln2_b + 1024;
  for (int r = blockIdx.x * 4 + w; r < NLAT; r += gridDim.x * 4) {
    float* row = p.out + (size_t)r * 1024;
    f32x4 v[4];
    float s = 0.f;
#pragma unroll
    for (int i = 0; i < 4; ++i) { v[i] = *(const f32x4*)(row + i * 256 + lane * 4); s += v[i].x + v[i].y + v[i].z + v[i].w; }
#pragma unroll
    for (int m = 1; m < 64; m <<= 1) s += shx(s, m);
    float mu = s * (1.f / 1024.f), ss = 0.f;
#pragma unroll
    for (int i = 0; i < 4; ++i) { float a = v[i].x - mu, b = v[i].y - mu, c = v[i].z - mu, d = v[i].w - mu; ss += a * a + b * b + c * c + d * d; }
#pragma unroll
    for (int m = 1; m < 64; m <<= 1) ss += shx(ss, m);
    float rs = rsqrtf(ss * (1.f / 1024.f) + 1e-5f);
#pragma unroll
    for (int i = 0; i < 4; ++i) {
      f32x4 gg = *(const f32x4*)(g + i * 256 + lane * 4), be = *(const f32x4*)(bb + i * 256 + lane * 4), o;
      o.x = (v[i].x - mu) * rs * gg.x + be.x; o.y = (v[i].y - mu) * rs * gg.y + be.y;
      o.z = (v[i].z - mu) * rs * gg.z + be.z; o.w = (v[i].w - mu) * rs * gg.w + be.w;
      *(f32x4*)(row + i * 256 + lane * 4) = o;
    }
  }
}

DI void phase_uconv(const Params& p, int kind, int l) {
  const int tid = tidx(), lane = tid & 63, w = tid >> 6;
  const int nrows = (kind == 1 && l == 1) ? NLAT : NROWS;
  const float* MODb = (const float*)(p.ws + OFF_MOD);
  const float* TABb = (const float*)(p.ws + OFF_TAB) + (size_t)l * 4 * 17 * 1024;
  for (int r = blockIdx.x * 4 + w; r < nrows; r += gridDim.x * 4) {
    const bool lat = r < NLAT;
    const int b = lat ? r / NSEQ : 16;
    const float* src; const float* st = nullptr; bf16_t* dstb;
    if (kind == 0) {
      if (l == 0) src = lat ? p.x + (size_t)r * 1024 : p.ctx + (size_t)(r - NLAT) * 1024;
      else { src = lat ? p.out + (size_t)r * 1024 : (const float*)(p.ws + OFF_CTXY2) + (size_t)(r - NLAT) * 1024; st = (const float*)(p.ws + OFF_ST2) + (size_t)r * 16; }
      dstb = (bf16_t*)(p.ws + OFF_Y1);
    } else {
      src = (const float*)(p.ws + OFF_Y1) + (size_t)r * 1024; st = (const float*)(p.ws + OFF_ST1) + (size_t)r * 16;
      dstb = (bf16_t*)(p.ws + OFF_UF);
    }
    float mu = 0.f, rs = 1.f;
    if (st) row_stats(st, mu, rs);
    const bool raw = (kind == 0 && l == 0);
    const float* t1 = raw ? MODb + (size_t)b * 6144 + 1024 : TABb + (size_t)(kind * 2) * 17 * 1024 + b * 1024;
    const float* t2 = raw ? MODb + (size_t)b * 6144 : TABb + (size_t)(kind * 2 + 1) * 17 * 1024 + b * 1024;
#pragma unroll
    for (int i = 0; i < 4; ++i) {
      const int k = i * 256 + lane * 4;
      f32x4 v = *(const f32x4*)(src + k), a = *(const f32x4*)(t1 + k), c = *(const f32x4*)(t2 + k);
      if (raw) { a.x += 1.f; a.y += 1.f; a.z += 1.f; a.w += 1.f; }
      u32x2 u;
      u.x = pack2((v.x - mu) * rs * a.x + c.x, (v.y - mu) * rs * a.y + c.y);
      u.y = pack2((v.z - mu) * rs * a.z + c.z, (v.w - mu) * rs * a.w + c.w);
      *(u32x2*)(dstb + ((size_t)(k >> 5) * NROWS + r) * 32 + (k & 31)) = u;
    }
  }
}

#define XB_TMO      128
#define XB_XCNT(j)  (256  + 64 * (j))
#define XB_XSUB(j)  (1280 + 64 * (j))
#define XB_XGEN(j)  (2304 + 64 * (j))
#define XB_TOP      3328
#define XB_TOPGEN   3392
#define XCD_BAR_WORDS 3456
#define XB_SPIN_CAP (1u << 18)
#define LAS __attribute__((address_space(3)))

__device__ __forceinline__ unsigned xb_ld(unsigned* p)              { return __hip_atomic_load(p, __ATOMIC_RELAXED, __HIP_MEMORY_SCOPE_AGENT); }
__device__ __forceinline__ unsigned xb_add(unsigned* p, unsigned v) { return __hip_atomic_fetch_add(p, v, __ATOMIC_RELAXED, __HIP_MEMORY_SCOPE_AGENT); }
__device__ __forceinline__ unsigned xb_xcc_id() { return (unsigned)__builtin_amdgcn_s_getreg((3 << 11) | 20) & 0xFu; }
#define XB_SPIN(cond, bar) do { unsigned _sp = 0; while (cond) { __builtin_amdgcn_s_sleep(1); \
    if ((++_sp & 255u) == 0u) { if (xb_ld(&(bar)[XB_TMO])) break; if (_sp > XB_SPIN_CAP) { atomicAdd(&(bar)[XB_TMO], 1u); break; } } } } while (0)

struct XcdBarrier {
    unsigned* bar; unsigned x;
    volatile LAS unsigned* st;
};

__device__ __forceinline__ XcdBarrier xcd_barrier_post(unsigned* bar, volatile LAS unsigned* st) {
    XcdBarrier b; b.bar = bar; b.x = xb_xcc_id(); b.st = st;
    if (threadIdx.x == 0) (void)xb_add(&bar[XB_XCNT(b.x)], 1u);
    return b;
}
__device__ __forceinline__ void xcd_barrier_complete(unsigned* bar, unsigned x, unsigned& nloc, unsigned& nx) {
    const unsigned G = gridDim.x * gridDim.y * gridDim.z;
    unsigned sum, cnt, mine, sp = 0u;
    for (;;) {
        sum = 0u; cnt = 0u; mine = 0u;
#pragma unroll
        for (unsigned j = 0; j < 16; ++j) { const unsigned c = xb_ld(&bar[XB_XCNT(j)]); sum += c; cnt += (c > 0u) ? 1u : 0u; mine = (j == x) ? c : mine; }
        if (sum == G) break;
        __builtin_amdgcn_s_sleep(1);
        if ((++sp & 255u) == 0u) { if (xb_ld(&bar[XB_TMO])) break; if (sp > XB_SPIN_CAP) { atomicAdd(&bar[XB_TMO], 1u); break; } }
    }
    nloc = mine > 0u ? mine : 1u; nx = cnt > 0u ? cnt : 1u;
}

__device__ __forceinline__ void xcd_barrier(const XcdBarrier& b) {
    asm volatile("s_waitcnt vmcnt(0)" ::: "memory");
    __syncthreads();
    if (threadIdx.x == 0) {
        unsigned* bar = b.bar;
        __builtin_amdgcn_s_waitcnt(0);
        unsigned nloc = b.st[0], nx = b.st[1];
        if (nloc == 0u) { xcd_barrier_complete(bar, b.x, nloc, nx); b.st[0] = nloc; b.st[1] = nx; }
        const unsigned old = xb_add(&bar[XB_XSUB(b.x)], 1u);
        const unsigned gen = old / nloc;
        if (old + 1u == (gen + 1u) * nloc) {
            __builtin_amdgcn_fence(__ATOMIC_RELEASE, "agent");
            asm volatile("s_waitcnt vmcnt(0)" ::: "memory");
            const unsigned og = xb_add(&bar[XB_TOP], 1u);
            const unsigned tg = og / nx;
            if (og + 1u == (tg + 1u) * nx) xb_add(&bar[XB_TOPGEN], 1u);
            else XB_SPIN(xb_ld(&bar[XB_TOPGEN]) == tg, bar);
            __builtin_amdgcn_fence(__ATOMIC_ACQUIRE, "agent");
            xb_add(&bar[XB_XGEN(b.x)], 1u);
            asm volatile("s_waitcnt vmcnt(0)" ::: "memory");
        } else {
            XB_SPIN(xb_ld(&bar[XB_XGEN(b.x)]) == gen, bar);
            __builtin_amdgcn_fence(__ATOMIC_ACQUIRE, "agent");
            asm volatile("s_waitcnt vmcnt(0)" ::: "memory");
        }
    }
    __syncthreads();
}


__global__ void __launch_bounds__(256, 2) mega(Params p) {
  extern __shared__ __attribute__((aligned(16))) char smem[];
  __shared__ uint4 xb_words;
  cg::grid_group grid = cg::this_grid();
  if (p.ph_lo < 0) grid.sync();
  if (threadIdx.x == 0) xb_words = make_uint4(0u, 0u, 0u, 0u);
  __syncthreads();
  XcdBarrier xb = xcd_barrier_post((unsigned*)(p.ws + OFF_BAR), (volatile LAS unsigned*)&xb_words);
  if (DUP & 32) { for (int i = 0; i < 16; ++i) xcd_barrier(xb); }
  for (int ph = p.ph_lo; ph < p.ph_hi; ++ph) {
    if (ph > p.ph_lo) xcd_barrier(xb);
    if (ph == 0) { phase_prepA(p, smem); if (DUP & 8) phase_prepA(p, smem); }
    else if (ph == 1) { phase_prepB(p); phase_uconv(p, 0, 0); }
    else {
      const int l = (ph - 2) / 9, s = (ph - 2) % 9;
      if (s == 0) { phase_gemm<0>(p, l, smem); if (DUP & 1) phase_gemm<0>(p, l, smem); }
      else if (s == 1) { if (DUP & 2) phase_mixA(p, l, smem, true); if (DUP & 64) phase_mixA(p, l, smem, true, 2); phase_mixA(p, l, smem); }
      else if (s == 2) { if (DUP & 4) phase_mixS(p, l, smem, true); phase_mixS(p, l, smem); }
      else if (s == 3) { if (DUP & 128) phase_mixB(p, l, smem, true); phase_mixB(p, l, smem); }
      else if (s == 4) { phase_gemm<1>(p, l, smem); if (DUP & 1) phase_gemm<1>(p, l, smem); }
      else if (s == 5) { phase_uconv(p, 1, l); if (DUP & 16) phase_uconv(p, 1, l); }
      else if (s == 6) { phase_gemm<2>(p, l, smem); if (DUP & 1) phase_gemm<2>(p, l, smem); }
      else if (s == 7) { phase_gemm<3>(p, l, smem); if (DUP & 1) phase_gemm<3>(p, l, smem); }
      else if (l == 0) phase_uconv(p, 0, 1);
      else phase_final(p);
    }
  }
}

extern "C" void kernel_launch(void* const* d_in, const int* in_sizes, int n_in, void* d_out, int out_size, void* d_ws, size_t ws_size,
                              hipStream_t stream) {
  static int grid = 0;
  if (grid == 0) {
    if (n_in != 20 || out_size != NLAT * 1024 || ws_size < WS_END) {
      fprintf(stderr, "kernel_launch: unexpected shapes (n_in %d out %d ws %zu need %zu)\n", n_in, out_size, ws_size, (size_t)WS_END);
      grid = -1; return;
    }
    int dev = 0, cus = 0, per = 0;
    hipGetDevice(&dev);
    hipDeviceGetAttribute(&cus, hipDeviceAttributeMultiprocessorCount, dev);
    hipFuncSetAttribute((const void*)mega, hipFuncAttributeMaxDynamicSharedMemorySize, SMEM_BYTES);
    hipOccupancyMaxActiveBlocksPerMultiprocessor(&per, (const void*)mega, 256, SMEM_BYTES);
    if (per < 1) per = 1;
    if (per > 2) per = 2;
    grid = cus * per;
  }
  if (grid < 0) return;
  if (hipMemsetAsync((char*)d_ws + OFF_BAR, 0, BAR_BYTES, stream) != hipSuccess) { fprintf(stderr, "kernel_launch: memset failed\n"); return; }
  Params p{};
  const float** pp = (const float**)&p;
  for (int i = 0; i < 20; ++i) pp[i] = (const float*)d_in[i];
  p.out = (float*)d_out; p.ws = (char*)d_ws;
#if ONE_LAUNCH
  p.ph_lo = 0; p.ph_hi = NPHASE;
  void* args[] = {&p};
  hipError_t e = hipLaunchCooperativeKernel((const void*)mega, dim3(grid), dim3(256), args, SMEM_BYTES, stream);
  if (e != hipSuccess) fprintf(stderr, "cooperative launch failed: %s (grid %d)\n", hipGetErrorString(e), grid);
#else
  for (int ph = 0; ph < NPHASE; ++ph) {
    p.ph_lo = ph; p.ph_hi = ph + 1;
    hipLaunchKernelGGL(mega, dim3(grid), dim3(256), SMEM_BYTES, stream, p);
  }
#endif
}
```

```cpp
#include <hip/hip_runtime.h>
#include <hip/hip_cooperative_groups.h>
#include <cstdio>
#include <cstdint>
namespace cg = cooperative_groups;

#ifndef PM
#define PM 0x1ff
#endif
#ifndef GV
#define GV 0
#endif
#ifndef DUP
#define DUP 0
#endif
#ifndef ONE_LAUNCH
#define ONE_LAUNCH 1
#endif

typedef unsigned short bf16_t;
typedef short bf16x8 __attribute__((ext_vector_type(8)));
typedef short s16x4 __attribute__((ext_vector_type(4)));
typedef float f32x4 __attribute__((ext_vector_type(4)));
typedef float f32x2 __attribute__((ext_vector_type(2)));
typedef unsigned u32x4 __attribute__((ext_vector_type(4)));
typedef unsigned u32x2 __attribute__((ext_vector_type(2)));
#define DI __device__ __forceinline__

constexpr int NB = 16, NSEQ = 2048, LC = 256, DM = 1024;
constexpr int NLAT = NB * NSEQ;
constexpr int NCTX = NB * LC;
constexpr int NROWS = NLAT + NCTX;
constexpr int PC = 2592;
constexpr int NPAD_IN = 2688;
constexpr int FH = 2816;
constexpr int C_NAQ = 0, C_NAK = 384, C_NAV = 768, C_GLQ = 1152, C_GLK = 1280, C_GLV = 1408, C_GLG = 1664,
              C_GAQ = 1920, C_GAK = 2304, C_GAV = 2432, C_GLR = 2560;
constexpr float ALPHA = 1.41421356237f;
constexpr float LOG2E = 1.44269504089f;
constexpr float QSCALE = 0.125f * LOG2E;

constexpr size_t al256(size_t x) { return (x + 255) & ~(size_t)255; }
constexpr size_t OFF_WTIN = 0;
constexpr size_t OFF_WTOUT = OFF_WTIN + al256((size_t)2 * NPAD_IN * 1024 * 2);
constexpr size_t OFF_WTFI = OFF_WTOUT + al256((size_t)2 * 1024 * 1024 * 2);
constexpr size_t OFF_WTFO = OFF_WTFI + al256((size_t)2 * 5632 * 1024 * 2);
constexpr size_t OFF_MOD = OFF_WTFO + al256((size_t)2 * 1024 * FH * 2);
constexpr size_t OFF_TAB = OFF_MOD + al256((size_t)2 * 17 * 6144 * 4);
constexpr size_t OFF_ROPE = OFF_TAB + al256((size_t)2 * 4 * 17 * 1024 * 4);
constexpr size_t OFF_ST1 = OFF_ROPE + al256((size_t)2 * 64 * 16 * 4);
constexpr size_t OFF_ST2 = OFF_ST1 + al256((size_t)NROWS * 16 * 4);
constexpr size_t OFF_LS = OFF_ST2 + al256((size_t)NROWS * 16 * 4);
constexpr size_t OFF_BL = OFF_LS + al256((size_t)NB * 4 * 2 * 36 * 2048 * 4);
constexpr size_t OFF_CTXY2 = OFF_BL + al256((size_t)NB * 4 * 2 * 36 * 32 * 4);
constexpr size_t OFF_UF = OFF_LS;
constexpr size_t OFF_Y1 = OFF_UF + al256((size_t)NROWS * 1024 * 2);
constexpr size_t OFF_P = OFF_Y1 + al256((size_t)NROWS * 1024 * 4);
constexpr size_t OFF_BAR = OFF_P + al256((size_t)NROWS * FH * 2);
constexpr size_t BAR_BYTES = 16384;
constexpr size_t WS_END = OFF_BAR + BAR_BYTES;

constexpr int SMEM_BYTES = 73728 + 6144;
constexpr int NPHASE = 20;

struct Params {
  const float *x, *c, *ctx, *c_ctx, *w_ada, *b_ada, *w_in, *na_rpb, *gla_wa2, *gla_ba, *gla_norm_w, *qnorm_w, *knorm_w,
      *w_out, *ln1_g, *ln1_b, *w_ffn_in, *w_ffn_out, *ln2_g, *ln2_b;
  float* out;
  char* ws;
  int ph_lo, ph_hi;
  int wave_id, pad_;
};

DI unsigned pack2(float lo, float hi) {
  unsigned r;
  asm("v_cvt_pk_bf16_f32 %0, %1, %2" : "=v"(r) : "v"(lo), "v"(hi));
  return r;
}
DI bf16_t f2bf(float f) { return (bf16_t)(pack2(f, 0.f) & 0xffffu); }
DI float bf2f(unsigned h) { return __uint_as_float(h << 16); }
DI float bflo(unsigned u) { return __uint_as_float(u << 16); }
DI float bfhi(unsigned u) { return __uint_as_float(u & 0xffff0000u); }
DI f32x4 mfma16(bf16x8 a, bf16x8 b, f32x4 c) { return __builtin_amdgcn_mfma_f32_16x16x32_bf16(a, b, c, 0, 0, 0); }
DI float siluf(float x) { return x / (1.f + __expf(-x)); }
DI int tidx(const Params& p) {
  int t = (p.wave_id << 6) | (int)__builtin_amdgcn_mbcnt_hi(~0u, __builtin_amdgcn_mbcnt_lo(~0u, 0u));
  asm volatile("" : "+v"(t));
  return t;
}
DI float shx(float v, int m) { return __shfl_xor(v, m, 64); }

DI int dest_row(int kind, int n) {
  if (kind == 0) return n < 1920 ? n : (n < 1952 ? n + 640 : n - 32);
  if (kind == 2) { int q = n / FH, hd = n - q * FH; return (hd >> 6) * 128 + ((hd >> 5) & 1) * 64 + q * 32 + (hd & 31); }
  return n;
}

DI void wt_tile(const Params& p, const float* __restrict__ src, int K, int N, int kt, int nt, bf16_t* __restrict__ dst, int dstStride, int kind, char* smem) {
  float* tile = (float*)smem;
  const int tid = tidx(p), k0 = kt * 64, n0 = nt * 64;
#pragma unroll 4
  for (int ii = 0; ii < 16; ++ii) {
    int i = (tid >> 6) + 4 * ii, j = tid & 63, n = n0 + j;
    tile[i * 65 + j] = (n < N) ? src[(size_t)(k0 + i) * N + n] : 0.f;
  }
  __syncthreads();
#pragma unroll 4
  for (int ii = 0; ii < 16; ++ii) {
    int jj = (tid >> 6) + 4 * ii, kk = tid & 63, n = n0 + jj;
    if (n < N) dst[((size_t)((k0 + kk) >> 5) * dstStride + dest_row(kind, n)) * 32 + ((k0 + kk) & 31)] = f2bf(tile[kk * 65 + jj]);
  }
}

DI void mod_item(const Params& p, int l, int cgi, char* smem) {
  float* sc = (float*)smem;
  float* red = sc + 17 * 256;
  const int tid = tidx(p), col = tid & 31, kg = tid >> 5, n = cgi * 32 + col;
  float acc[17];
#pragma unroll
  for (int r = 0; r < 17; ++r) acc[r] = 0.f;
  const float* w = p.w_ada + (size_t)l * 1024 * 6144 + n;
  for (int kc = 0; kc < 4; ++kc) {
    __syncthreads();
#pragma unroll
    for (int r = 0; r < 17; ++r) {
      float v = (r < 16) ? p.c[r * 1024 + kc * 256 + tid] : p.c_ctx[kc * 256 + tid];
      sc[r * 256 + tid] = siluf(v);
    }
    __syncthreads();
#pragma unroll 4
    for (int kk = 0; kk < 32; ++kk) {
      int kl = kg * 32 + kk;
      float wv = w[(size_t)(kc * 256 + kl) * 6144];
#pragma unroll
      for (int r = 0; r < 17; ++r) acc[r] += sc[r * 256 + kl] * wv;
    }
  }
#pragma unroll
  for (int r = 0; r < 17; ++r) red[(kg * 17 + r) * 32 + col] = acc[r];
  __syncthreads();
  float* MOD = (float*)(p.ws + OFF_MOD);
  for (int o = tid; o < 17 * 32; o += 256) {
    int r = o >> 5, cc = o & 31;
    float s = p.b_ada[l * 6144 + cgi * 32 + cc];
#pragma unroll
    for (int g = 0; g < 8; ++g) s += red[(g * 17 + r) * 32 + cc];
    MOD[((size_t)l * 17 + r) * 6144 + cgi * 32 + cc] = s;
  }
}

DI void phase_prepA(const Params& p, char* smem) {
  const int tid = tidx(p);
  for (int it = blockIdx.x; it < 6435; it += gridDim.x) {
    __syncthreads();
    if (it < 6048) {
      int l = it / 3024, r = it % 3024;
      if (r < 656) wt_tile(p, p.w_in + (size_t)l * 1024 * 2592, 1024, 2592, r / 41, r % 41, (bf16_t*)(p.ws + OFF_WTIN) + (size_t)l * NPAD_IN * 1024, NPAD_IN, 0, smem);
      else if (r < 912) { r -= 656; wt_tile(p, p.w_out + (size_t)l * 1024 * 1024, 1024, 1024, r / 16, r % 16, (bf16_t*)(p.ws + OFF_WTOUT) + (size_t)l * 1024 * 1024, 1024, 1, smem); }
      else if (r < 2320) { r -= 912; wt_tile(p, p.w_ffn_in + (size_t)l * 1024 * 5632, 1024, 5632, r / 88, r % 88, (bf16_t*)(p.ws + OFF_WTFI) + (size_t)l * 5632 * 1024, 5632, 2, smem); }
      else { r -= 2320; wt_tile(p, p.w_ffn_out + (size_t)l * FH * 1024, FH, 1024, r / 16, r % 16, (bf16_t*)(p.ws + OFF_WTFO) + (size_t)l * 1024 * FH, 1024, 1, smem); }
    } else if (it < 6050) {
      int l = it - 6048;
      for (int i = tid; i < 32 * 384; i += 256) {
        u32x4* d = (u32x4*)((bf16_t*)(p.ws + OFF_WTIN) + (size_t)l * NPAD_IN * 1024 + ((size_t)(i / 384) * NPAD_IN + 2592) * 32);
        d[i % 384] = (u32x4){0u, 0u, 0u, 0u};
      }
    } else if (it < 6434) {
      int r = it - 6050;
      mod_item(p, r / 192, r % 192, smem);
    } else {
      float* rc = (float*)(p.ws + OFF_ROPE);
      for (int i = tid; i < 1024; i += 256) {
        int pos = i >> 4, f = i & 15;
        float invf = powf(10000.f, -(float)f / 16.f);
        float ang = (float)pos * invf;
        rc[i] = cosf(ang);
        rc[1024 + i] = sinf(ang);
      }
    }
  }
}

DI void phase_prepB(const Params& p) {
  const float* MOD = (const float*)(p.ws + OFF_MOD);
  float* TAB = (float*)(p.ws + OFF_TAB);
  for (int i = blockIdx.x * 256 + tidx(p); i < 2 * 17 * 1024; i += gridDim.x * 256) {
    int k = i & 1023, b = (i >> 10) % 17, l = i / (17 * 1024);
    const float* m = MOD + ((size_t)l * 17 + b) * 6144;
    float sh1 = m[k], sc1 = m[1024 + k], sh2 = m[3072 + k], sc2 = m[4096 + k];
    float g0 = (l == 0) ? 1.f : p.ln2_g[k], b0 = (l == 0) ? 0.f : p.ln2_b[k];
    float* t = TAB + (size_t)l * 4 * 17 * 1024 + b * 1024 + k;
    t[0 * 17 * 1024] = g0 * (1.f + sc1);
    t[1 * 17 * 1024] = b0 * (1.f + sc1) + sh1;
    t[2 * 17 * 1024] = p.ln1_g[l * 1024 + k] * (1.f + sc2);
    t[3 * 17 * 1024] = p.ln1_b[l * 1024 + k] * (1.f + sc2) + sh2;
  }
}

DI void row_stats(const float* st, float& mu, float& rs) {
  const f32x4* s4 = (const f32x4*)st;
  f32x4 a = s4[0], b = s4[1], c = s4[2], d = s4[3];
  float S = a.x + a.z + b.x + b.z + c.x + c.z + d.x + d.z;
  float SS = a.y + a.w + b.y + b.w + c.y + c.w + d.y + d.w;
  mu = S * (1.f / 1024.f);
  float var = fmaxf(SS * (1.f / 1024.f) - mu * mu, 0.f);
  rs = rsqrtf(var + 1e-5f);
}

template <int MODE, int VAR = 0>
DI void gemm_tile(const Params& p, int l, int tm, int tn, char* smem) {
  constexpr int K = (MODE == 3) ? FH : 1024;
  constexpr int NK = K / 32;
  char* As = smem;
  char* Bs = smem + 16384;
  float* red = (float*)(smem + 73728);
  const int tid = tidx(p), lane = tid & 63, wid = tid >> 6, wr = wid >> 1, wc = wid & 1, fr = lane & 15, fq = lane >> 4;
  const int row0 = tm * 256;
  const bool lat = row0 < NLAT;
  const int bidx = lat ? row0 / NSEQ : 16;
  float* Y1 = (float*)(p.ws + OFF_Y1);
  float* CTXY2 = (float*)(p.ws + OFF_CTXY2);
  const float* ST1 = (const float*)(p.ws + OFF_ST1);
  const float* ST2 = (const float*)(p.ws + OFF_ST2);
  bf16_t* P = (bf16_t*)(p.ws + OFF_P);
  const float* MOD = (const float*)(p.ws + OFF_MOD) + ((size_t)l * 17 + bidx) * 6144;

  const bf16_t* absrc; int astride;
  if (MODE == 0) { absrc = (const bf16_t*)(p.ws + OFF_Y1) + (size_t)row0 * 32; astride = 32; }
  else if (MODE == 1) { absrc = P + (size_t)row0 * PC; astride = PC; }
  else if (MODE == 2) { absrc = (const bf16_t*)(p.ws + OFF_UF) + (size_t)row0 * 32; astride = 32; }
  else { absrc = P + (size_t)row0 * 32; astride = 32; }
  constexpr int NPADB = (MODE == 0) ? NPAD_IN : (MODE == 2 ? 5632 : 1024);
  const bf16_t* wt;
  if (MODE == 0) wt = (const bf16_t*)(p.ws + OFF_WTIN) + (size_t)l * NPAD_IN * 1024;
  else if (MODE == 1) wt = (const bf16_t*)(p.ws + OFF_WTOUT) + (size_t)l * 1024 * 1024;
  else if (MODE == 2) wt = (const bf16_t*)(p.ws + OFF_WTFI) + (size_t)l * 5632 * 1024;
  else wt = (const bf16_t*)(p.ws + OFF_WTFO) + (size_t)l * 1024 * FH;
  const int prow = lane >> 2, pch = (lane & 3) ^ ((-(prow >> 2)) & 3);
  const unsigned aoff = (unsigned)(((wid * 64 + prow) * astride + pch * 8) * 2);
  const unsigned apiece = (unsigned)(16 * astride * 2);
  const unsigned boff = (unsigned)(((tn * 128 + wid * 32 + prow) * 32 + pch * 8) * 2);
  const char* abase0 = (const char*)absrc;
  const char* bbase0 = (const char*)wt;
  char* adst_t = As + wid * 4096 + lane * 16;
  char* bdst_t = Bs + wid * 2048 + lane * 16;
  auto dma_a = [&](int kt, int buf, int i) __attribute__((always_inline)) {
    size_t kk;
    if (MODE == 1) { kk = kt * 64; if (kk >= 768) kk += 2560; }
    else kk = (size_t)kt * NROWS * 64;
    const char* ub = abase0 + kk;
    __builtin_amdgcn_global_load_lds((const unsigned*)(ub + (aoff + (unsigned)i * apiece)), (unsigned*)(adst_t + buf * 24576 + i * 1024), 16, 0, 0);
  };
  auto dma_b = [&](int kt, int buf, int i) __attribute__((always_inline)) {
    const char* ub = bbase0 + (size_t)kt * NPADB * 64;
    __builtin_amdgcn_global_load_lds((const unsigned*)(ub + (boff + (unsigned)i * 1024u)), (unsigned*)(bdst_t + buf * 24576 + i * 1024), 16, 0, 0);
  };
  auto dma = [&](int kt, int buf) __attribute__((always_inline)) {
#pragma unroll
    for (int i = 0; i < 4; ++i) dma_a(kt, buf, i);
#pragma unroll
    for (int i = 0; i < 2; ++i) dma_b(kt, buf, i);
  };
  const int fpos = (fq ^ ((-(fr >> 2)) & 3)) * 16;

  f32x4 acc[8][4];
#pragma unroll
  for (int m = 0; m < 8; ++m)
#pragma unroll
    for (int n = 0; n < 4; ++n) acc[m][n] = (f32x4){0.f, 0.f, 0.f, 0.f};

  __syncthreads();
  dma(0, 0);
  dma(1, 1);
  dma(2, 2);
  asm volatile("s_waitcnt vmcnt(12)" ::: "memory");
  __syncthreads();
  bf16x8 af[8], bfc[4], bfn[4];
  {
    const char* ab = As + (wr * 128 + fr) * 64 + fpos;
    const char* bb = Bs + (wc * 64 + fr) * 64 + fpos;
#pragma unroll
    for (int n = 0; n < 4; ++n) bfc[n] = *(const bf16x8*)(bb + n * 1024);
#pragma unroll
    for (int m = 0; m < 4; ++m) af[m] = *(const bf16x8*)(ab + m * 1024);
#pragma unroll
    for (int n = 0; n < 4; ++n) bfn[n] = bfc[n];
    __builtin_amdgcn_s_waitcnt(0xC07F);
  }
  int sc = 0;
#pragma unroll 1
  for (int kt = 0; kt < NK; ++kt) {
    const int sn = (sc == 2) ? 0 : sc + 1;
    {
      const char* ab = As + sc * 24576 + (wr * 128 + fr) * 64 + fpos;
#pragma unroll
      for (int m = 4; m < 8; ++m) af[m] = *(const bf16x8*)(ab + m * 1024);
    }
    __builtin_amdgcn_sched_barrier(0);
#pragma unroll
    for (int m = 0; m < 4; ++m)
#pragma unroll
      for (int n = 0; n < 4; ++n) { if (VAR != 2 && VAR != 3) acc[m][n] = mfma16(bfc[n], af[m], acc[m][n]); else asm volatile("" :: "v"(bfc[n]), "v"(af[m])); }
    __builtin_amdgcn_sched_barrier(0);
    if (kt + 2 < NK) asm volatile("s_waitcnt vmcnt(6) lgkmcnt(0)" ::: "memory");
    else asm volatile("s_waitcnt vmcnt(0) lgkmcnt(0)" ::: "memory");
    __syncthreads();
    if (VAR != 1 && VAR != 3 && kt + 3 < NK) dma(kt + 3, sc);
    if (kt + 1 < NK) {
      const char* ab = As + sn * 24576 + (wr * 128 + fr) * 64 + fpos;
      const char* bb = Bs + sn * 24576 + (wc * 64 + fr) * 64 + fpos;
#pragma unroll
      for (int n = 0; n < 4; ++n) bfn[n] = *(const bf16x8*)(bb + n * 1024);
#pragma unroll
      for (int m = 0; m < 4; ++m) af[m] = *(const bf16x8*)(ab + m * 1024);
    }
    __builtin_amdgcn_sched_barrier(0);
#pragma unroll
    for (int m = 4; m < 8; ++m)
#pragma unroll
      for (int n = 0; n < 4; ++n) { if (VAR != 2 && VAR != 3) acc[m][n] = mfma16(bfc[n], af[m], acc[m][n]); else asm volatile("" :: "v"(bfc[n]), "v"(af[m])); }
    __builtin_amdgcn_sched_barrier(0);
#pragma unroll
    for (int n = 0; n < 4; ++n) bfc[n] = bfn[n];
    sc = sn;
    __builtin_amdgcn_s_waitcnt(0xC07F);
  }
  int fr_e = fr;
  asm volatile("" : "+v"(fr_e));
  if (MODE == 0) {
    const int hs = tn * 2 + wc;
    if (hs > 40) return;
    const bool isq = (hs >= 30 && hs < 36), isk = (hs == 36 || hs == 37);
    if (isq || isk) {
      const float* nw = (isq ? p.qnorm_w : p.knorm_w) + l * 64;
      const float* rc = (const float*)(p.ws + OFF_ROPE);
      float w_[4][4];
#pragma unroll
      for (int n = 0; n < 4; ++n)
#pragma unroll
        for (int j = 0; j < 4; ++j) w_[n][j] = nw[n * 16 + fq * 4 + j];
#pragma unroll
      for (int m = 0; m < 8; ++m) {
        float ss = 0.f;
#pragma unroll
        for (int n = 0; n < 4; ++n)
#pragma unroll
          for (int j = 0; j < 4; ++j) ss += acc[m][n][j] * acc[m][n][j];
        ss += shx(ss, 16); ss += shx(ss, 32);
        float inv = rsqrtf(ss * (1.f / 64.f) + 1e-6f);
#pragma unroll
        for (int n = 0; n < 4; ++n)
#pragma unroll
          for (int j = 0; j < 4; ++j) acc[m][n][j] *= inv * w_[n][j];
        if (lat) {
          int t = (row0 + wr * 128 + m * 16 + fr_e) & (NSEQ - 1);
          int gr = t >> 6, gc = t & 63;
#pragma unroll
          for (int j = 0; j < 4; ++j) {
            float cr = rc[gr * 16 + fq * 4 + j], sr = rc[1024 + gr * 16 + fq * 4 + j];
            float cc = rc[gc * 16 + fq * 4 + j], sn = rc[1024 + gc * 16 + fq * 4 + j];
            float x1 = acc[m][0][j], x2 = acc[m][1][j], x3 = acc[m][2][j], x4 = acc[m][3][j];
            acc[m][0][j] = x1 * cr - x2 * sr; acc[m][1][j] = x2 * cr + x1 * sr;
            acc[m][2][j] = x3 * cc - x4 * sn; acc[m][3][j] = x4 * cc + x3 * sn;
          }
        }
      }
    }
    float scl = 1.f;
    if (hs < 6 || isq) scl = QSCALE;
    else if (hs == 18 || hs == 19) scl = 0.17677669529663687f;
    const int nmax = (hs == 40) ? 2 : 4;
#pragma unroll
    for (int m = 0; m < 8; ++m) {
      bf16_t* pr = P + (size_t)(row0 + wr * 128 + m * 16 + fr_e) * PC + hs * 64 + fq * 4;
#pragma unroll
      for (int n = 0; n < 4; ++n) {
        if (n < nmax) {
          u32x2 u; u.x = pack2(acc[m][n][0] * scl, acc[m][n][1] * scl); u.y = pack2(acc[m][n][2] * scl, acc[m][n][3] * scl);
          *(u32x2*)(pr + n * 16) = u;
        }
      }
    }
  } else if (MODE == 2) {
    bf16_t* H = P;
#pragma unroll
    for (int m = 0; m < 8; ++m) {
      bf16_t* hr = H + ((size_t)(tn * 2 + wc) * NROWS + row0 + wr * 128 + m * 16 + fr_e) * 32 + fq * 4;
#pragma unroll
      for (int n = 0; n < 2; ++n) {
        float h0 = siluf(acc[m][n][0]) * acc[m][n + 2][0], h1 = siluf(acc[m][n][1]) * acc[m][n + 2][1];
        float h2 = siluf(acc[m][n][2]) * acc[m][n + 2][2], h3 = siluf(acc[m][n][3]) * acc[m][n + 2][3];
        u32x2 u; u.x = pack2(h0, h1); u.y = pack2(h2, h3);
        *(u32x2*)(hr + n * 16) = u;
      }
    }
  } else {
    const float* gate = MOD + (MODE == 1 ? 2048 : 5120) + tn * 128 + wc * 64 + fq * 4;
    const float* lng = nullptr; const float* lnb = nullptr; const float* xs; const float* st = nullptr;
    float* dst; float* stout;
    bool doln;
    if (MODE == 1) {
      doln = (l == 1);
      if (l == 0) xs = lat ? p.x + (size_t)row0 * 1024 : p.ctx + (size_t)(row0 - NLAT) * 1024;
      else { xs = p.out + (size_t)row0 * 1024; st = ST2 + (size_t)row0 * 16; lng = p.ln2_g; lnb = p.ln2_b; }
      dst = Y1 + (size_t)row0 * 1024;
      stout = (float*)(p.ws + OFF_ST1) + (size_t)row0 * 16;
    } else {
      doln = true;
      xs = Y1 + (size_t)row0 * 1024; st = ST1 + (size_t)row0 * 16; lng = p.ln1_g + l * 1024; lnb = p.ln1_b + l * 1024;
      dst = lat ? p.out + (size_t)row0 * 1024 : CTXY2 + (size_t)(row0 - NLAT) * 1024;
      stout = (float*)(p.ws + OFF_ST2) + (size_t)row0 * 16;
    }
    const int cb = tn * 128 + wc * 64 + fq * 4;
    float* rst = red + 1024;
    if (doln) { float m_, r_; row_stats(st + (size_t)tid * 16, m_, r_); rst[tid * 2] = m_; rst[tid * 2 + 1] = r_; }
    __syncthreads();
#pragma unroll
    for (int m = 0; m < 8; ++m) {
      const int rl = wr * 128 + m * 16 + fr_e;
      float rmu = 0.f, rrs = 1.f;
      if (doln) { rmu = rst[rl * 2]; rrs = rst[rl * 2 + 1]; }
      float s_ = 0.f, ss = 0.f;
      const float* xr = xs + (size_t)rl * 1024 + cb;
      float* dr = dst + (size_t)rl * 1024 + cb;
#pragma unroll
      for (int n = 0; n < 4; ++n) {
        const f32x4 gv = *(const f32x4*)(gate + n * 16);
        f32x4 xv = *(const f32x4*)(xr + n * 16);
        if (doln) {
          const f32x4 lg = *(const f32x4*)(lng + cb + n * 16), lb = *(const f32x4*)(lnb + cb + n * 16);
          xv.x = (xv.x - rmu) * rrs * lg.x + lb.x; xv.y = (xv.y - rmu) * rrs * lg.y + lb.y;
          xv.z = (xv.z - rmu) * rrs * lg.z + lb.z; xv.w = (xv.w - rmu) * rrs * lg.w + lb.w;
        }
        f32x4 o;
        o.x = ALPHA * xv.x + gv.x * acc[m][n][0]; o.y = ALPHA * xv.y + gv.y * acc[m][n][1];
        o.z = ALPHA * xv.z + gv.z * acc[m][n][2]; o.w = ALPHA * xv.w + gv.w * acc[m][n][3];
        *(f32x4*)(dr + n * 16) = o;
        s_ += o.x + o.y + o.z + o.w;
        ss += o.x * o.x + o.y * o.y + o.z * o.z + o.w * o.w;
      }
      s_ += shx(s_, 16); s_ += shx(s_, 32);
      ss += shx(ss, 16); ss += shx(ss, 32);
      if (fq == 0) { red[((wr * 2 + wc) * 128 + m * 16 + fr_e) * 2] = s_; red[((wr * 2 + wc) * 128 + m * 16 + fr_e) * 2 + 1] = ss; }
      if (m & 1) __builtin_amdgcn_sched_barrier(0);
    }
    __syncthreads();
    {
      int r = tid, w_ = r >> 7, rr = r & 127;
      float s = red[((w_ * 2 + 0) * 128 + rr) * 2] + red[((w_ * 2 + 1) * 128 + rr) * 2];
      float ss = red[((w_ * 2 + 0) * 128 + rr) * 2 + 1] + red[((w_ * 2 + 1) * 128 + rr) * 2 + 1];
      *(f32x2*)(stout + (size_t)r * 16 + tn * 2) = (f32x2){s, ss};
    }
  }
}

template <int MODE, int VAR = 0>
DI void phase_gemm(const Params& p, int l, char* smem) {
  const int NT = (MODE == 0) ? 21 : (MODE == 2 ? 44 : 8);
  const int MT = (l == 0 || MODE == 0) ? 144 : 128;
  const int vb = (blockIdx.x & 7) * (gridDim.x >> 3) + (blockIdx.x >> 3);
  for (int t = vb; t < MT * NT; t += gridDim.x) {
    const int g = t / (8 * NT), r = t - g * 8 * NT;
    gemm_tile<MODE, VAR>(p, l, g * 8 + (r & 7), r >> 3, smem);
  }
}

typedef __attribute__((address_space(3))) s16x4 lds_s16x4;
template <int NH>
DI void attn_item(const Params& p, int qrow0, int qcol, int kcol, int vcol, int lat_row0, int nb_lat, int ctx_row0, int nb_ctx,
                  bool na, int dr0, const float* rpb_h, char* smem, bool dry = false) {
  bf16_t* KV = (bf16_t*)smem;
  float* rpbs = (float*)(KV + 4 * 64 * 72);
  const int tid = tidx(p), lane = tid & 63, w = tid >> 6, fr = lane & 15, fq = lane >> 4;
  bf16_t* P = (bf16_t*)(p.ws + OFF_P);
  __syncthreads();
  if (na) for (int i = tid; i < 465; i += 256) rpbs[i] = rpb_h[i] * LOG2E;
  bf16x8 qf[NH][2];
  f32x4 o[NH][4];
  float mrun[NH], lrun[NH];
#pragma unroll
  for (int hh = 0; hh < NH; ++hh) {
    const bf16_t* qp = P + (size_t)(qrow0 + w * 16 + fr) * PC + qcol + hh * 64 + fq * 8;
    qf[hh][0] = *(const bf16x8*)qp; qf[hh][1] = *(const bf16x8*)(qp + 32);
#pragma unroll
    for (int i = 0; i < 4; ++i) o[hh][i] = (f32x4){0.f, 0.f, 0.f, 0.f};
    mrun[hh] = -1e30f; lrun[hh] = 0.f;
  }
  const int nb = nb_lat + nb_ctx;
  u32x4 rk[2], rv[2];
  const int lkey = tid >> 3, ldc = (tid & 7) * 8;
  auto gload = [&](int kb) __attribute__((always_inline)) {
    int rb = kb < nb_lat ? lat_row0 + kb * 64 : ctx_row0 + (kb - nb_lat) * 64;
#pragma unroll
    for (int i = 0; i < 2; ++i) {
      const bf16_t* rp = P + (size_t)(rb + lkey + i * 32) * PC + ldc;
      rk[i] = *(const u32x4*)(rp + kcol);
      rv[i] = *(const u32x4*)(rp + vcol);
    }
  };
  auto lstore = [&](int buf) __attribute__((always_inline)) {
#pragma unroll
    for (int i = 0; i < 2; ++i) {
      bf16_t* d = KV + buf * 2 * 64 * 72 + (lkey + i * 32) * 72 + ldc;
      *(u32x4*)d = rk[i];
      *(u32x4*)(d + 64 * 72) = rv[i];
    }
  };
  const int qj = w * 16 + fr;
  const int cs = min(max(qj - 8, 0), 48);
  gload(0);
  lstore(0);
  __syncthreads();
  for (int kb = 0; kb < nb; ++kb) {
    const bf16_t* Kb = KV + (kb & 1) * 2 * 64 * 72;
    const bf16_t* Vb = Kb + 64 * 72;
    if (kb + 1 < nb) gload(kb + 1);
    const bool msk = na && kb < nb_lat;
    int mt_lo = 0, mt_hi = 3;
    if (msk) { mt_lo = (w >= 2) ? w - 1 : 0; mt_hi = (w <= 1) ? w + 1 : 3; }
    bf16x8 kf[4][2];
#pragma unroll
    for (int mt = 0; mt < 4; ++mt)
      if (mt >= mt_lo && mt <= mt_hi) {
        kf[mt][0] = *(const bf16x8*)(Kb + (mt * 16 + fr) * 72 + fq * 8);
        kf[mt][1] = *(const bf16x8*)(Kb + (mt * 16 + fr) * 72 + 32 + fq * 8);
      }
    bf16x8 pf[NH][2];
#pragma unroll
    for (int hh = 0; hh < NH; ++hh) {
      f32x4 s[4];
#pragma unroll
      for (int mt = 0; mt < 4; ++mt) {
        if (mt >= mt_lo && mt <= mt_hi) {
          s[mt] = mfma16(kf[mt][0], qf[hh][0], (f32x4){0.f, 0.f, 0.f, 0.f});
          s[mt] = mfma16(kf[mt][1], qf[hh][1], s[mt]);
          if (msk) {
#pragma unroll
            for (int j = 0; j < 4; ++j) {
              int kc = mt * 16 + fq * 4 + j;
              bool valid = (kc >= cs) && (kc < cs + 16);
              int bi = min(max(kc - qj, -15), 15);
              s[mt][j] = valid ? s[mt][j] + rpbs[(dr0 + kb) * 31 + bi + 15] : -1e30f;
            }
          }
        } else s[mt] = (f32x4){-1e30f, -1e30f, -1e30f, -1e30f};
      }
      float mx = fmaxf(fmaxf(fmaxf(s[0][0], s[0][1]), fmaxf(s[0][2], s[0][3])), fmaxf(fmaxf(s[1][0], s[1][1]), fmaxf(s[1][2], s[1][3])));
      mx = fmaxf(mx, fmaxf(fmaxf(fmaxf(s[2][0], s[2][1]), fmaxf(s[2][2], s[2][3])), fmaxf(fmaxf(s[3][0], s[3][1]), fmaxf(s[3][2], s[3][3]))));
      mx = fmaxf(mx, shx(mx, 16)); mx = fmaxf(mx, shx(mx, 32));
      const float mnew = fmaxf(mrun[hh], mx);
      if (__builtin_amdgcn_ballot_w64(mnew > mrun[hh]) != 0) {
        const float alpha = __builtin_amdgcn_exp2f(mrun[hh] - mnew);
        mrun[hh] = mnew;
        lrun[hh] *= alpha;
#pragma unroll
        for (int i = 0; i < 4; ++i) { o[hh][i][0] *= alpha; o[hh][i][1] *= alpha; o[hh][i][2] *= alpha; o[hh][i][3] *= alpha; }
      }
      float ps = 0.f;
#pragma unroll
      for (int mt = 0; mt < 4; ++mt)
#pragma unroll
        for (int j = 0; j < 4; ++j) { float e = __builtin_amdgcn_exp2f(s[mt][j] - mnew); s[mt][j] = e; ps += e; }
      lrun[hh] += ps;
#pragma unroll
      for (int kp = 0; kp < 2; ++kp) {
        u32x4 pk;
        pk.x = pack2(s[2 * kp][0], s[2 * kp][1]); pk.y = pack2(s[2 * kp][2], s[2 * kp][3]);
        pk.z = pack2(s[2 * kp + 1][0], s[2 * kp + 1][1]); pk.w = pack2(s[2 * kp + 1][2], s[2 * kp + 1][3]);
        pf[hh][kp] = __builtin_bit_cast(bf16x8, pk);
      }
    }
#pragma unroll
    for (int kp = 0; kp < 2; ++kp) {
      if ((kp == 0 && mt_lo <= 1) || (kp == 1 && mt_hi >= 2)) {
#pragma unroll
        for (int dt = 0; dt < 4; ++dt) {
          const bf16_t* vp = Vb + (kp * 32 + fq * 4 + (fr >> 2)) * 72 + dt * 16 + (fr & 3) * 4;
          s16x4 lo = __builtin_amdgcn_ds_read_tr16_b64_v4i16((lds_s16x4*)vp);
          s16x4 hi = __builtin_amdgcn_ds_read_tr16_b64_v4i16((lds_s16x4*)(vp + 16 * 72));
          bf16x8 vf = __builtin_shufflevector(lo, hi, 0, 1, 2, 3, 4, 5, 6, 7);
#pragma unroll
          for (int hh = 0; hh < NH; ++hh) o[hh][dt] = mfma16(vf, pf[hh][kp], o[hh][dt]);
        }
      }
    }
    if (kb + 1 < nb) lstore((kb + 1) & 1);
    __syncthreads();
  }
#pragma unroll
  for (int hh = 0; hh < NH; ++hh) {
    float lt = lrun[hh];
    lt += shx(lt, 16); lt += shx(lt, 32);
    const float inv = 1.f / lt;
    bf16_t* op = dry ? (bf16_t*)(p.ws + OFF_Y1) + (size_t)((qrow0 + w * 16 + fr) & 16383) * PC + qcol + hh * 64 + fq * 4
                     : P + (size_t)(qrow0 + w * 16 + fr) * PC + qcol + hh * 64 + fq * 4;
#pragma unroll
    for (int dt = 0; dt < 4; ++dt) {
      u32x2 u; u.x = pack2(o[hh][dt][0] * inv, o[hh][dt][1] * inv); u.y = pack2(o[hh][dt][2] * inv, o[hh][dt][3] * inv);
      *(u32x2*)(op + dt * 16) = u;
    }
  }
}

DI float logsig(float z) { return fminf(z, 0.f) - __logf(1.f + __expf(-fabsf(z))); }
DI int chunk_row0(int b, int cidx) { return cidx < 4 ? NLAT + b * LC + cidx * 64 : b * NSEQ + (cidx - 4) * 64; }
DI int chain_pos(int cidx, int dir) { return dir == 0 ? cidx : (cidx < 4 ? 3 - cidx : 39 - cidx); }

DI void gla_gates(const Params& p, int l, int h, int dir, int row0, float* bs, float* lrs, float* was, float* segt) {
  const int tid = tidx(p);
  const bf16_t* P = (const bf16_t*)(p.ws + OFF_P);
  {
    int s = tid >> 2, r4 = (tid & 3) * 4;
    u32x2 u = *(const u32x2*)(P + (size_t)(row0 + s) * PC + C_GLR + dir * 16 + r4);
    lrs[s * 17 + r4] = bflo(u.x); lrs[s * 17 + r4 + 1] = bfhi(u.x); lrs[s * 17 + r4 + 2] = bflo(u.y); lrs[s * 17 + r4 + 3] = bfhi(u.y);
    for (int i = tid; i < 512; i += 256) was[i] = p.gla_wa2[(((size_t)l * 2 + dir) * 16 + (i >> 5)) * 128 + h * 32 + (i & 31)];
  }
  __syncthreads();
  const int d = tid & 31, sg = tid >> 5;
  const float ba = p.gla_ba[(l * 2 + dir) * 128 + h * 32 + d];
  float la[8];
#pragma unroll
  for (int i = 0; i < 8; ++i) {
    int s = sg * 8 + i;
    float z = ba;
#pragma unroll
    for (int r = 0; r < 16; ++r) z += lrs[s * 17 + r] * was[r * 32 + d];
    la[i] = logsig(z) * (1.f / 16.f);
  }
  if (dir == 0) {
#pragma unroll
    for (int i = 1; i < 8; ++i) la[i] += la[i - 1];
    segt[sg * 32 + d] = la[7];
  } else {
#pragma unroll
    for (int i = 6; i >= 0; --i) la[i] += la[i + 1];
    segt[sg * 32 + d] = la[0];
  }
  __syncthreads();
  float pre = 0.f;
#pragma unroll
  for (int g = 0; g < 8; ++g) {
    float v = segt[g * 32 + d];
    if (dir == 0 ? (g < sg) : (g > sg)) pre += v;
  }
#pragma unroll
  for (int i = 0; i < 8; ++i) bs[(sg * 8 + i) * 33 + d] = la[i] + pre;
  __syncthreads();
}

DI void gla_passA(const Params& p, int l, int item, char* smem) {
  float* bs = (float*)smem;
  float* kw = bs + 64 * 33;
  float* vs = kw + 64 * 32;
  float* lrs = vs + 64 * 64;
  float* was = lrs + 64 * 17;
  float* segt = was + 512;
  const int tid = tidx(p);
  int dir = item & 1, cidx = (item >> 1) % 36, bh = item / 72, h = bh & 3, b = bh >> 2;
  const int row0 = chunk_row0(b, cidx);
  const bf16_t* P = (const bf16_t*)(p.ws + OFF_P);
  __syncthreads();
  gla_gates(p, l, h, dir, row0, bs, lrs, was, segt);
  {
    int s = tid >> 2, d8 = (tid & 3) * 8;
    u32x4 u = *(const u32x4*)(P + (size_t)(row0 + s) * PC + C_GLK + h * 32 + d8);
    unsigned uu[4] = {u.x, u.y, u.z, u.w};
    const int slast = dir == 0 ? 63 : 0;
#pragma unroll
    for (int e = 0; e < 4; ++e) {
      int d0 = d8 + 2 * e;
      kw[s * 32 + d0] = bflo(uu[e]) * __expf(bs[slast * 33 + d0] - bs[s * 33 + d0]);
      kw[s * 32 + d0 + 1] = bfhi(uu[e]) * __expf(bs[slast * 33 + d0 + 1] - bs[s * 33 + d0 + 1]);
    }
    int v16 = (tid & 3) * 16;
#pragma unroll
    for (int q = 0; q < 2; ++q) {
      u32x4 w = *(const u32x4*)(P + (size_t)(row0 + s) * PC + C_GLV + h * 64 + v16 + q * 8);
      unsigned ww[4] = {w.x, w.y, w.z, w.w};
#pragma unroll
      for (int e = 0; e < 4; ++e) { vs[s * 64 + v16 + q * 8 + 2 * e] = bflo(ww[e]); vs[s * 64 + v16 + q * 8 + 2 * e + 1] = bfhi(ww[e]); }
    }
  }
  __syncthreads();
  const int v = tid & 63, dg = (tid >> 6) * 8;
  float acc[8];
#pragma unroll
  for (int i = 0; i < 8; ++i) acc[i] = 0.f;
  for (int s = 0; s < 64; ++s) {
    float vv = vs[s * 64 + v];
    f32x4 k0 = *(const f32x4*)(kw + s * 32 + dg), k1 = *(const f32x4*)(kw + s * 32 + dg + 4);
    acc[0] += k0.x * vv; acc[1] += k0.y * vv; acc[2] += k0.z * vv; acc[3] += k0.w * vv;
    acc[4] += k1.x * vv; acc[5] += k1.y * vv; acc[6] += k1.z * vv; acc[7] += k1.w * vv;
  }
  const int pos = chain_pos(cidx, dir);
  float* LS = (float*)(p.ws + OFF_LS) + ((size_t)((b * 4 + h) * 2 + dir) * 36 + pos) * 2048;
#pragma unroll
  for (int i = 0; i < 8; ++i) LS[(dg + i) * 64 + v] = acc[i];
  if (tid < 32) {
    float* BL = (float*)(p.ws + OFF_BL) + ((size_t)((b * 4 + h) * 2 + dir) * 36 + pos) * 32;
    BL[tid] = bs[(dir == 0 ? 63 : 0) * 33 + tid];
  }
}

DI void gla_scan(const Params& p, int item) {
  const int tid = tidx(p);
  const int chain = item >> 3, e = (item & 7) * 256 + tid, d = e >> 6;
  float* LS = (float*)(p.ws + OFF_LS) + (size_t)chain * 36 * 2048 + e;
  const float* BL = (const float*)(p.ws + OFF_BL) + (size_t)chain * 36 * 32 + d;
  float S = 0.f;
#pragma unroll 6
  for (int pos = 0; pos < 36; ++pos) {
    float x = LS[(size_t)pos * 2048], bl = BL[pos * 32];
    LS[(size_t)pos * 2048] = S;
    S = __expf(bl) * S + x;
  }
}

DI void gla_passB(const Params& p, int l, int b, int h, int cidx, char* smem, bool dry = false) {
  float* bs = (float*)smem;
  bf16_t* Qe = (bf16_t*)(bs + 64 * 33);
  bf16_t* Ke = Qe + 64 * 40;
  bf16_t* Vs = Ke + 64 * 40;
  bf16_t* S0 = Vs + 64 * 72;
  float* lrs = (float*)(S0 + 32 * 72);
  float* was = lrs + 64 * 17;
  float* segt = was + 512;
  const int tid = tidx(p), lane = tid & 63, w = tid >> 6, fr = lane & 15, fq = lane >> 4;
  const int row0 = chunk_row0(b, cidx);
  bf16_t* P = (bf16_t*)(p.ws + OFF_P);
  f32x4 o[4];
#pragma unroll
  for (int i = 0; i < 4; ++i) o[i] = (f32x4){0.f, 0.f, 0.f, 0.f};
  __syncthreads();
  {
    int s = tid >> 2, v16 = (tid & 3) * 16;
    const bf16_t* vp = P + (size_t)(row0 + s) * PC + C_GLV + h * 64 + v16;
    *(u32x4*)(Vs + s * 72 + v16) = *(const u32x4*)vp;
    *(u32x4*)(Vs + s * 72 + v16 + 8) = *(const u32x4*)(vp + 8);
  }
  for (int dir = 0; dir < 2; ++dir) {
    gla_gates(p, l, h, dir, row0, bs, lrs, was, segt);
    {
      int s = tid >> 2, d8 = (tid & 3) * 8;
      u32x4 uq = *(const u32x4*)(P + (size_t)(row0 + s) * PC + C_GLQ + h * 32 + d8);
      u32x4 uk = *(const u32x4*)(P + (size_t)(row0 + s) * PC + C_GLK + h * 32 + d8);
      u32x4 oq, ok;
#pragma unroll
      for (int e = 0; e < 4; ++e) {
        int d0 = d8 + 2 * e;
        float b0 = bs[s * 33 + d0], b1 = bs[s * 33 + d0 + 1];
        oq[e] = pack2(bflo(uq[e]) * __expf(b0), bfhi(uq[e]) * __expf(b1));
        ok[e] = pack2(bflo(uk[e]) * __expf(-b0), bfhi(uk[e]) * __expf(-b1));
      }
      *(u32x4*)(Qe + s * 40 + d8) = oq;
      *(u32x4*)(Ke + s * 40 + d8) = ok;
      const int pos = chain_pos(cidx, dir);
      const float* LS = (const float*)(p.ws + OFF_LS) + ((size_t)((b * 4 + h) * 2 + dir) * 36 + pos) * 2048;
      int d = tid >> 3, v8 = (tid & 7) * 8;
      f32x4 s0 = *(const f32x4*)(LS + d * 64 + v8), s1 = *(const f32x4*)(LS + d * 64 + v8 + 4);
      u32x4 os;
      os.x = pack2(s0.x, s0.y); os.y = pack2(s0.z, s0.w); os.z = pack2(s1.x, s1.y); os.w = pack2(s1.z, s1.w);
      *(u32x4*)(S0 + d * 72 + v8) = os;
    }
    __syncthreads();
    {
      const bf16x8 qf = *(const bf16x8*)(Qe + (w * 16 + fr) * 40 + fq * 8);
      f32x4 at[4];
#pragma unroll
      for (int mt = 0; mt < 4; ++mt) {
        const bool need = dir == 0 ? (mt <= w) : (mt >= w);
        if (need) {
          const bf16x8 kf = *(const bf16x8*)(Ke + (mt * 16 + fr) * 40 + fq * 8);
          at[mt] = mfma16(kf, qf, (f32x4){0.f, 0.f, 0.f, 0.f});
          if (mt == w) {
#pragma unroll
            for (int j = 0; j < 4; ++j) {
              const int sI = fq * 4 + j;
              const bool keep = dir == 0 ? (sI <= fr) : (sI >= fr);
              at[mt][j] = keep ? at[mt][j] : 0.f;
            }
          }
        } else at[mt] = (f32x4){0.f, 0.f, 0.f, 0.f};
      }
#pragma unroll
      for (int kp = 0; kp < 2; ++kp) {
        const bool needp = dir == 0 ? (2 * kp <= w) : (2 * kp + 1 >= w);
        if (needp) {
          u32x4 pk;
          pk.x = pack2(at[2 * kp][0], at[2 * kp][1]); pk.y = pack2(at[2 * kp][2], at[2 * kp][3]);
          pk.z = pack2(at[2 * kp + 1][0], at[2 * kp + 1][1]); pk.w = pack2(at[2 * kp + 1][2], at[2 * kp + 1][3]);
          const bf16x8 pf = __builtin_bit_cast(bf16x8, pk);
#pragma unroll
          for (int dt = 0; dt < 4; ++dt) {
            const bf16_t* vp = Vs + (kp * 32 + fq * 4 + (fr >> 2)) * 72 + dt * 16 + (fr & 3) * 4;
            s16x4 lo = __builtin_amdgcn_ds_read_tr16_b64_v4i16((lds_s16x4*)vp);
            s16x4 hi = __builtin_amdgcn_ds_read_tr16_b64_v4i16((lds_s16x4*)(vp + 16 * 72));
            bf16x8 vf = __builtin_shufflevector(lo, hi, 0, 1, 2, 3, 4, 5, 6, 7);
            o[dt] = mfma16(vf, pf, o[dt]);
          }
        }
      }
#pragma unroll
      for (int dt = 0; dt < 4; ++dt) {
        const bf16_t* sp = S0 + (fq * 8 + (fr >> 2)) * 72 + dt * 16 + (fr & 3) * 4;
        s16x4 lo = __builtin_amdgcn_ds_read_tr16_b64_v4i16((lds_s16x4*)sp);
        s16x4 hi = __builtin_amdgcn_ds_read_tr16_b64_v4i16((lds_s16x4*)(sp + 4 * 72));
        bf16x8 sf = __builtin_shufflevector(lo, hi, 0, 1, 2, 3, 4, 5, 6, 7);
        o[dt] = mfma16(sf, qf, o[dt]);
      }
    }
    __syncthreads();
  }
  float ss = 0.f;
#pragma unroll
  for (int dt = 0; dt < 4; ++dt) ss += o[dt][0] * o[dt][0] + o[dt][1] * o[dt][1] + o[dt][2] * o[dt][2] + o[dt][3] * o[dt][3];
  ss += shx(ss, 16); ss += shx(ss, 32);
  const float inv = rsqrtf(ss * (1.f / 64.f) + 1e-6f);
#pragma unroll
  for (int dt = 0; dt < 4; ++dt) {
    const f32x4 nw = *(const f32x4*)(p.gla_norm_w + l * 64 + dt * 16 + fq * 4);
    bf16_t* gp = P + (size_t)(row0 + w * 16 + fr) * PC + C_GLG + h * 64 + dt * 16 + fq * 4;
    u32x2 g = *(const u32x2*)gp;
    u32x2 u;
    u.x = pack2(o[dt][0] * inv * nw.x * siluf(bflo(g.x)), o[dt][1] * inv * nw.y * siluf(bfhi(g.x)));
    u.y = pack2(o[dt][2] * inv * nw.z * siluf(bflo(g.y)), o[dt][3] * inv * nw.w * siluf(bfhi(g.y)));
    if (dry) gp = (bf16_t*)(p.ws + OFF_Y1) + (size_t)((row0 + w * 16 + fr) & 16383) * PC + C_GLG + h * 64 + dt * 16 + fq * 4;
    *(u32x2*)gp = u;
  }
}

DI void phase_mixA(const Params& p, int l, char* smem, bool dry = false, int only = 3) {
  const int NGQA = NB * 2 * 32, NGLA = NB * 4 * 36 * 2;
  for (int it = blockIdx.x; it < NGQA + NGLA; it += gridDim.x) {
    if (it < NGQA) {
      if (!(only & 1)) continue;
      int b = it >> 6, rem = it & 63, g = rem >> 5, qt = rem & 31;
      attn_item<3>(p, b * NSEQ + qt * 64, C_GAQ + g * 192, C_GAK + g * 64, C_GAV + g * 64, b * NSEQ, 32, NLAT + b * LC, 4, false, 0, nullptr, smem, dry);
    } else if (only & 2) gla_passA(p, l, it - NGQA, smem);
  }
}
DI void phase_mixS(const Params& p, int l, char* smem, bool dry = false) {
  const int NSC = NB * 4 * 2 * 8, NNA = NB * 6 * 32, NCG = (l == 0) ? NB * 2 * 4 : 0, NCN = (l == 0) ? NB * 6 * 4 : 0;
  for (int it = blockIdx.x; it < NSC + NNA + NCG + NCN; it += gridDim.x) {
    if (it < NSC) {
      if (!dry) gla_scan(p, it);
    } else if (it < NSC + NNA) {
      int i = it - NSC, b = i / 192, rem = i % 192, h = rem >> 5, r = rem & 31;
      int rs = min(max(r - 4, 0), 24);
      attn_item<1>(p, b * NSEQ + r * 64, C_NAQ + h * 64, C_NAK + h * 64, C_NAV + h * 64, b * NSEQ + rs * 64, 8, NLAT + b * LC, 4, true, rs - r + 7,
                   p.na_rpb + ((size_t)l * 6 + h) * 465, smem, dry);
    } else if (it < NSC + NNA + NCG) {
      int i = it - NSC - NNA, b = i >> 3, g = (i >> 2) & 1, qt = i & 3;
      attn_item<3>(p, NLAT + b * LC + qt * 64, C_GAQ + g * 192, C_GAK + g * 64, C_GAV + g * 64, 0, 0, NLAT + b * LC, 4, false, 0, nullptr, smem, dry);
    } else {
      int i = it - NSC - NNA - NCG, b = i / 24, rem = i % 24, h = rem >> 2, qt = rem & 3;
      attn_item<1>(p, NLAT + b * LC + qt * 64, C_NAQ + h * 64, C_NAK + h * 64, C_NAV + h * 64, 0, 0, NLAT + b * LC, 4, false, 0, nullptr, smem, dry);
    }
  }
}
DI void phase_mixB(const Params& p, int l, char* smem, bool dry = false) {
  const int cpl = (l == 0) ? 36 : 32;
  const int NGLB = NB * 4 * cpl;
  for (int it = blockIdx.x; it < NGLB; it += gridDim.x) {
    int cc = it % cpl, bh = it / cpl;
    gla_passB(p, l, bh >> 2, bh & 3, cc + (36 - cpl), smem, dry);
  }
}

DI void phase_final(const Params& p) {
  const int lane = tidx(p) & 63, w = tidx(p) >> 6;
  const float* g = p.ln2_g + 1024; const float* bb = p.ln2_b + 1024;
  for (int r = blockIdx.x * 4 + w; r < NLAT; r += gridDim.x * 4) {
    float* row = p.out + (size_t)r * 1024;
    f32x4 v[4];
    float s = 0.f;
#pragma unroll
    for (int i = 0; i < 4; ++i) { v[i] = *(const f32x4*)(row + i * 256 + lane * 4); s += v[i].x + v[i].y + v[i].z + v[i].w; }
#pragma unroll
    for (int m = 1; m < 64; m <<= 1) s += shx(s, m);
    float mu = s * (1.f / 1024.f), ss = 0.f;
#pragma unroll
    for (int i = 0; i < 4; ++i) { float a = v[i].x - mu, b = v[i].y - mu, c = v[i].z - mu, d = v[i].w - mu; ss += a * a + b * b + c * c + d * d; }
#pragma unroll
    for (int m = 1; m < 64; m <<= 1) ss += shx(ss, m);
    float rs = rsqrtf(ss * (1.f / 1024.f) + 1e-5f);
#pragma unroll
    for (int i = 0; i < 4; ++i) {
      f32x4 gg = *(const f32x4*)(g + i * 256 + lane * 4), be = *(const f32x4*)(bb + i * 256 + lane * 4), o;
      o.x = (v[i].x - mu) * rs * gg.x + be.x; o.y = (v[i].y - mu) * rs * gg.y + be.y;
      o.z = (v[i].z - mu) * rs * gg.z + be.z; o.w = (v[i].w - mu) * rs * gg.w + be.w;
      *(f32x4*)(row + i * 256 + lane * 4) = o;
    }
  }
}

DI void phase_uconv(const Params& p, int kind, int l) {
  const int tid = tidx(p), lane = tid & 63, w = tid >> 6;
  const int nrows = (kind == 1 && l == 1) ? NLAT : NROWS;
  const float* MODb = (const float*)(p.ws + OFF_MOD);
  const float* TABb = (const float*)(p.ws + OFF_TAB) + (size_t)l * 4 * 17 * 1024;
  for (int r = blockIdx.x * 4 + w; r < nrows; r += gridDim.x * 4) {
    const bool lat = r < NLAT;
    const int b = lat ? r / NSEQ : 16;
    const float* src; const float* st = nullptr; bf16_t* dstb;
    if (kind == 0) {
      if (l == 0) src = lat ? p.x + (size_t)r * 1024 : p.ctx + (size_t)(r - NLAT) * 1024;
      else { src = lat ? p.out + (size_t)r * 1024 : (const float*)(p.ws + OFF_CTXY2) + (size_t)(r - NLAT) * 1024; st = (const float*)(p.ws + OFF_ST2) + (size_t)r * 16; }
      dstb = (bf16_t*)(p.ws + OFF_Y1);
    } else {
      src = (const float*)(p.ws + OFF_Y1) + (size_t)r * 1024; st = (const float*)(p.ws + OFF_ST1) + (size_t)r * 16;
      dstb = (bf16_t*)(p.ws + OFF_UF);
    }
    float mu = 0.f, rs = 1.f;
    if (st) row_stats(st, mu, rs);
    const bool raw = (kind == 0 && l == 0);
    const float* t1 = raw ? MODb + (size_t)b * 6144 + 1024 : TABb + (size_t)(kind * 2) * 17 * 1024 + b * 1024;
    const float* t2 = raw ? MODb + (size_t)b * 6144 : TABb + (size_t)(kind * 2 + 1) * 17 * 1024 + b * 1024;
#pragma unroll
    for (int i = 0; i < 4; ++i) {
      const int k = i * 256 + lane * 4;
      f32x4 v = *(const f32x4*)(src + k), a = *(const f32x4*)(t1 + k), c = *(const f32x4*)(t2 + k);
      if (raw) { a.x += 1.f; a.y += 1.f; a.z += 1.f; a.w += 1.f; }
      u32x2 u;
      u.x = pack2((v.x - mu) * rs * a.x + c.x, (v.y - mu) * rs * a.y + c.y);
      u.y = pack2((v.z - mu) * rs * a.z + c.z, (v.w - mu) * rs * a.w + c.w);
      *(u32x2*)(dstb + ((size_t)(k >> 5) * NROWS + r) * 32 + (k & 31)) = u;
    }
  }
}

#define XB_TMO      128
#define XB_XCNT(j)  (256  + 64 * (j))
#define XB_XSUB(j)  (1280 + 64 * (j))
#define XB_XGEN(j)  (2304 + 64 * (j))
#define XB_TOP      3328
#define XB_TOPGEN   3392
#define XCD_BAR_WORDS 3456
#define XB_SPIN_CAP (1u << 18)
#define LAS __attribute__((address_space(3)))

__device__ __forceinline__ unsigned xb_ld(unsigned* p)              { return __hip_atomic_load(p, __ATOMIC_RELAXED, __HIP_MEMORY_SCOPE_AGENT); }
__device__ __forceinline__ unsigned xb_add(unsigned* p, unsigned v) { return __hip_atomic_fetch_add(p, v, __ATOMIC_RELAXED, __HIP_MEMORY_SCOPE_AGENT); }
__device__ __forceinline__ unsigned xb_xcc_id() { return (unsigned)__builtin_amdgcn_s_getreg((3 << 11) | 20) & 0xFu; }
#define XB_SPIN(cond, bar) do { unsigned _sp = 0; while (cond) { __builtin_amdgcn_s_sleep(1); \
    if ((++_sp & 255u) == 0u) { if (xb_ld(&(bar)[XB_TMO])) break; if (_sp > XB_SPIN_CAP) { atomicAdd(&(bar)[XB_TMO], 1u); break; } } } } while (0)

struct XcdBarrier {
    unsigned* bar; unsigned x;
    volatile LAS unsigned* st;
};

__device__ __forceinline__ XcdBarrier xcd_barrier_post(unsigned* bar, volatile LAS unsigned* st) {
    XcdBarrier b; b.bar = bar; b.x = xb_xcc_id(); b.st = st;
    if (threadIdx.x == 0) (void)xb_add(&bar[XB_XCNT(b.x)], 1u);
    return b;
}
__device__ __forceinline__ void xcd_barrier_complete(unsigned* bar, unsigned x, unsigned& nloc, unsigned& nx) {
    const unsigned G = gridDim.x * gridDim.y * gridDim.z;
    unsigned sum, cnt, mine, sp = 0u;
    for (;;) {
        sum = 0u; cnt = 0u; mine = 0u;
#pragma unroll
        for (unsigned j = 0; j < 16; ++j) { const unsigned c = xb_ld(&bar[XB_XCNT(j)]); sum += c; cnt += (c > 0u) ? 1u : 0u; mine = (j == x) ? c : mine; }
        if (sum == G) break;
        __builtin_amdgcn_s_sleep(1);
        if ((++sp & 255u) == 0u) { if (xb_ld(&bar[XB_TMO])) break; if (sp > XB_SPIN_CAP) { atomicAdd(&bar[XB_TMO], 1u); break; } }
    }
    nloc = mine > 0u ? mine : 1u; nx = cnt > 0u ? cnt : 1u;
}

__device__ __forceinline__ void xcd_barrier(const XcdBarrier& b) {
    asm volatile("s_waitcnt vmcnt(0)" ::: "memory");
    __syncthreads();
    if (threadIdx.x == 0) {
        unsigned* bar = b.bar;
        __builtin_amdgcn_s_waitcnt(0);
        unsigned nloc = b.st[0], nx = b.st[1];
        if (nloc == 0u) { xcd_barrier_complete(bar, b.x, nloc, nx); b.st[0] = nloc; b.st[1] = nx; }
        const unsigned old = xb_add(&bar[XB_XSUB(b.x)], 1u);
        const unsigned gen = old / nloc;
        if (old + 1u == (gen + 1u) * nloc) {
            __builtin_amdgcn_fence(__ATOMIC_RELEASE, "agent");
            asm volatile("s_waitcnt vmcnt(0)" ::: "memory");
            const unsigned og = xb_add(&bar[XB_TOP], 1u);
            const unsigned tg = og / nx;
            if (og + 1u == (tg + 1u) * nx) xb_add(&bar[XB_TOPGEN], 1u);
            else XB_SPIN(xb_ld(&bar[XB_TOPGEN]) == tg, bar);
            __builtin_amdgcn_fence(__ATOMIC_ACQUIRE, "agent");
            xb_add(&bar[XB_XGEN(b.x)], 1u);
            asm volatile("s_waitcnt vmcnt(0)" ::: "memory");
        } else {
            XB_SPIN(xb_ld(&bar[XB_XGEN(b.x)]) == gen, bar);
            __builtin_amdgcn_fence(__ATOMIC_ACQUIRE, "agent");
            asm volatile("s_waitcnt vmcnt(0)" ::: "memory");
        }
    }
    __syncthreads();
}


__global__ void __launch_bounds__(256, 2) mega(Params p_in) {
  Params p = p_in;
  p.wave_id = __builtin_amdgcn_readfirstlane((int)(threadIdx.x >> 6));
  extern __shared__ __attribute__((aligned(16))) char smem[];
  __shared__ uint4 xb_words;
  cg::grid_group grid = cg::this_grid();
  if (p.ph_lo < 0) grid.sync();
  if (threadIdx.x == 0) xb_words = make_uint4(0u, 0u, 0u, 0u);
  __syncthreads();
  XcdBarrier xb = xcd_barrier_post((unsigned*)(p.ws + OFF_BAR), (volatile LAS unsigned*)&xb_words);
  if (DUP & 32) { for (int i = 0; i < 16; ++i) xcd_barrier(xb); }
  for (int ph = p.ph_lo; ph < p.ph_hi; ++ph) {
    if (ph > p.ph_lo) xcd_barrier(xb);
    if (ph == 0) { phase_prepA(p, smem); if (DUP & 8) phase_prepA(p, smem); }
    else if (ph == 1) { phase_prepB(p); phase_uconv(p, 0, 0); }
    else {
      const int l = (ph - 2) / 9, s = (ph - 2) % 9;
      if (s == 0) { if (DUP & 1) phase_gemm<0, GV>(p, l, smem); phase_gemm<0>(p, l, smem); }
      else if (s == 1) { if (DUP & 2) phase_mixA(p, l, smem, true); if (DUP & 64) phase_mixA(p, l, smem, true, 2); phase_mixA(p, l, smem); }
      else if (s == 2) { if (DUP & 4) phase_mixS(p, l, smem, true); phase_mixS(p, l, smem); }
      else if (s == 3) { if (DUP & 128) phase_mixB(p, l, smem, true); phase_mixB(p, l, smem); }
      else if (s == 4) { if (DUP & 1) phase_gemm<1, GV>(p, l, smem); phase_gemm<1>(p, l, smem); }
      else if (s == 5) { phase_uconv(p, 1, l); if (DUP & 16) phase_uconv(p, 1, l); }
      else if (s == 6) { if (DUP & 1) phase_gemm<2, GV>(p, l, smem); phase_gemm<2>(p, l, smem); }
      else if (s == 7) { if (DUP & 1) phase_gemm<3, GV>(p, l, smem); phase_gemm<3>(p, l, smem); }
      else if (l == 0) phase_uconv(p, 0, 1);
      else phase_final(p);
    }
  }
}

extern "C" void kernel_launch(void* const* d_in, const int* in_sizes, int n_in, void* d_out, int out_size, void* d_ws, size_t ws_size,
                              hipStream_t stream) {
  static int grid = 0;
  if (grid == 0) {
    if (n_in != 20 || out_size != NLAT * 1024 || ws_size < WS_END) {
      fprintf(stderr, "kernel_launch: unexpected shapes (n_in %d out %d ws %zu need %zu)\n", n_in, out_size, ws_size, (size_t)WS_END);
      grid = -1; return;
    }
    int dev = 0, cus = 0, per = 0;
    hipGetDevice(&dev);
    hipDeviceGetAttribute(&cus, hipDeviceAttributeMultiprocessorCount, dev);
    hipFuncSetAttribute((const void*)mega, hipFuncAttributeMaxDynamicSharedMemorySize, SMEM_BYTES);
    hipOccupancyMaxActiveBlocksPerMultiprocessor(&per, (const void*)mega, 256, SMEM_BYTES);
    if (per < 1) per = 1;
    if (per > 2) per = 2;
    grid = cus * per;
  }
  if (grid < 0) return;
  if (hipMemsetAsync((char*)d_ws + OFF_BAR, 0, BAR_BYTES, stream) != hipSuccess) { fprintf(stderr, "kernel_launch: memset failed\n"); return; }
  Params p{};
  const float** pp = (const float**)&p;
  for (int i = 0; i < 20; ++i) pp[i] = (const float*)d_in[i];
  p.out = (float*)d_out; p.ws = (char*)d_ws;
#if ONE_LAUNCH
  p.ph_lo = 0; p.ph_hi = NPHASE;
  void* args[] = {&p};
  hipError_t e = hipLaunchCooperativeKernel((const void*)mega, dim3(grid), dim3(256), args, SMEM_BYTES, stream);
  if (e != hipSuccess) fprintf(stderr, "cooperative launch failed: %s (grid %d)\n", hipGetErrorString(e), grid);
#else
  for (int ph = 0; ph < NPHASE; ++ph) {
    p.ph_lo = ph; p.ph_hi = ph + 1;
    hipLaunchKernelGGL(mega, dim3(grid), dim3(256), SMEM_BYTES, stream, p);
  }
#endif
}
```

```cpp
#include <hip/hip_runtime.h>
#include <hip/hip_cooperative_groups.h>
#include <cstdio>
#include <cstdint>
namespace cg = cooperative_groups;

#ifndef PM
#define PM 0x1ff
#endif
#ifndef GV
#define GV 0
#endif
#ifndef DUP
#define DUP 0
#endif
#ifndef ONE_LAUNCH
#define ONE_LAUNCH 1
#endif

typedef unsigned short bf16_t;
typedef short bf16x8 __attribute__((ext_vector_type(8)));
typedef short s16x4 __attribute__((ext_vector_type(4)));
typedef float f32x4 __attribute__((ext_vector_type(4)));
typedef float f32x2 __attribute__((ext_vector_type(2)));
typedef unsigned u32x4 __attribute__((ext_vector_type(4)));
typedef unsigned u32x2 __attribute__((ext_vector_type(2)));
#define DI __device__ __forceinline__

constexpr int NB = 16, NSEQ = 2048, LC = 256, DM = 1024;
constexpr int NLAT = NB * NSEQ;
constexpr int NCTX = NB * LC;
constexpr int NROWS = NLAT + NCTX;
constexpr int PC = 2592;
constexpr int NPAD_IN = 2688;
constexpr int FH = 2816;
constexpr int C_NAQ = 0, C_NAK = 384, C_NAV = 768, C_GLQ = 1152, C_GLK = 1280, C_GLV = 1408, C_GLG = 1664,
              C_GAQ = 1920, C_GAK = 2304, C_GAV = 2432, C_GLR = 2560;
constexpr float ALPHA = 1.41421356237f;
constexpr float LOG2E = 1.44269504089f;
constexpr float QSCALE = 0.125f * LOG2E;

constexpr size_t al256(size_t x) { return (x + 255) & ~(size_t)255; }
constexpr size_t OFF_WTIN = 0;
constexpr size_t OFF_WTOUT = OFF_WTIN + al256((size_t)2 * NPAD_IN * 1024 * 2);
constexpr size_t OFF_WTFI = OFF_WTOUT + al256((size_t)2 * 1024 * 1024 * 2);
constexpr size_t OFF_WTFO = OFF_WTFI + al256((size_t)2 * 5632 * 1024 * 2);
constexpr size_t OFF_MOD = OFF_WTFO + al256((size_t)2 * 1024 * FH * 2);
constexpr size_t OFF_TAB = OFF_MOD + al256((size_t)2 * 17 * 6144 * 4);
constexpr size_t OFF_ROPE = OFF_TAB + al256((size_t)2 * 4 * 17 * 1024 * 4);
constexpr size_t OFF_ST1 = OFF_ROPE + al256((size_t)2 * 64 * 16 * 4);
constexpr size_t OFF_ST2 = OFF_ST1 + al256((size_t)NROWS * 16 * 4);
constexpr size_t OFF_LS = OFF_ST2 + al256((size_t)NROWS * 16 * 4);
constexpr size_t OFF_BL = OFF_LS + al256((size_t)NB * 4 * 2 * 36 * 2048 * 4);
constexpr size_t OFF_CTXY2 = OFF_BL + al256((size_t)NB * 4 * 2 * 36 * 32 * 4);
constexpr size_t OFF_UF = OFF_LS;
constexpr size_t OFF_Y1 = OFF_UF + al256((size_t)NROWS * 1024 * 2);
constexpr size_t OFF_P = OFF_Y1 + al256((size_t)NROWS * 1024 * 4);
constexpr size_t OFF_BAR = OFF_P + al256((size_t)NROWS * FH * 2);
constexpr size_t BAR_BYTES = 16384;
constexpr size_t WS_END = OFF_BAR + BAR_BYTES;

constexpr int SMEM_BYTES = 73728 + 6144;
constexpr int NPHASE = 20;

struct Params {
  const float *x, *c, *ctx, *c_ctx, *w_ada, *b_ada, *w_in, *na_rpb, *gla_wa2, *gla_ba, *gla_norm_w, *qnorm_w, *knorm_w,
      *w_out, *ln1_g, *ln1_b, *w_ffn_in, *w_ffn_out, *ln2_g, *ln2_b;
  float* out;
  char* ws;
  int ph_lo, ph_hi;
  int wave_id, pad_;
};

typedef __bf16 bf16x2_t __attribute__((ext_vector_type(2)));
DI unsigned pack2(float lo, float hi) {
  bf16x2_t v = {(__bf16)lo, (__bf16)hi};
  return __builtin_bit_cast(unsigned, v);
}
DI bf16_t f2bf(float f) { return (bf16_t)(pack2(f, 0.f) & 0xffffu); }
DI float bf2f(unsigned h) { return __uint_as_float(h << 16); }
DI float bflo(unsigned u) { return __uint_as_float(u << 16); }
DI float bfhi(unsigned u) { return __uint_as_float(u & 0xffff0000u); }
DI f32x4 mfma16(bf16x8 a, bf16x8 b, f32x4 c) { return __builtin_amdgcn_mfma_f32_16x16x32_bf16(a, b, c, 0, 0, 0); }
DI float siluf(float x) { return x / (1.f + __expf(-x)); }
DI int tidx(const Params& p) {
  int t = (p.wave_id << 6) | (int)__builtin_amdgcn_mbcnt_hi(~0u, __builtin_amdgcn_mbcnt_lo(~0u, 0u));
  asm volatile("" : "+v"(t));
  return t;
}
DI float shx(float v, int m) { return __shfl_xor(v, m, 64); }

DI int dest_row(int kind, int n) {
  if (kind == 0) return n < 1920 ? n : (n < 1952 ? n + 640 : n - 32);
  if (kind == 2) { int q = n / FH, hd = n - q * FH; return (hd >> 6) * 128 + ((hd >> 5) & 1) * 64 + q * 32 + (hd & 31); }
  return n;
}

DI void wt_tile(const Params& p, const float* __restrict__ src, int K, int N, int kt, int nt, bf16_t* __restrict__ dst, int dstStride, int kind, char* smem) {
  float* tile = (float*)smem;
  const int tid = tidx(p), k0 = kt * 64, n0 = nt * 64;
#pragma unroll 4
  for (int ii = 0; ii < 16; ++ii) {
    int i = (tid >> 6) + 4 * ii, j = tid & 63, n = n0 + j;
    tile[i * 65 + j] = (n < N) ? src[(size_t)(k0 + i) * N + n] : 0.f;
  }
  __syncthreads();
#pragma unroll 4
  for (int ii = 0; ii < 16; ++ii) {
    int jj = (tid >> 6) + 4 * ii, kk = tid & 63, n = n0 + jj;
    if (n < N) dst[((size_t)((k0 + kk) >> 5) * dstStride + dest_row(kind, n)) * 32 + ((k0 + kk) & 31)] = f2bf(tile[kk * 65 + jj]);
  }
}

DI void mod_item(const Params& p, int l, int cgi, char* smem) {
  float* sc = (float*)smem;
  float* red = sc + 17 * 256;
  const int tid = tidx(p), col = tid & 31, kg = tid >> 5, n = cgi * 32 + col;
  float acc[17];
#pragma unroll
  for (int r = 0; r < 17; ++r) acc[r] = 0.f;
  const float* w = p.w_ada + (size_t)l * 1024 * 6144 + n;
  for (int kc = 0; kc < 4; ++kc) {
    __syncthreads();
#pragma unroll
    for (int r = 0; r < 17; ++r) {
      float v = (r < 16) ? p.c[r * 1024 + kc * 256 + tid] : p.c_ctx[kc * 256 + tid];
      sc[r * 256 + tid] = siluf(v);
    }
    __syncthreads();
#pragma unroll 4
    for (int kk = 0; kk < 32; ++kk) {
      int kl = kg * 32 + kk;
      float wv = w[(size_t)(kc * 256 + kl) * 6144];
#pragma unroll
      for (int r = 0; r < 17; ++r) acc[r] += sc[r * 256 + kl] * wv;
    }
  }
#pragma unroll
  for (int r = 0; r < 17; ++r) red[(kg * 17 + r) * 32 + col] = acc[r];
  __syncthreads();
  float* MOD = (float*)(p.ws + OFF_MOD);
  for (int o = tid; o < 17 * 32; o += 256) {
    int r = o >> 5, cc = o & 31;
    float s = p.b_ada[l * 6144 + cgi * 32 + cc];
#pragma unroll
    for (int g = 0; g < 8; ++g) s += red[(g * 17 + r) * 32 + cc];
    MOD[((size_t)l * 17 + r) * 6144 + cgi * 32 + cc] = s;
  }
}

DI void phase_prepA(const Params& p, char* smem) {
  const int tid = tidx(p);
  for (int it = blockIdx.x; it < 6435; it += gridDim.x) {
    __syncthreads();
    if (it < 6048) {
      int l = it / 3024, r = it % 3024;
      if (r < 656) wt_tile(p, p.w_in + (size_t)l * 1024 * 2592, 1024, 2592, r / 41, r % 41, (bf16_t*)(p.ws + OFF_WTIN) + (size_t)l * NPAD_IN * 1024, NPAD_IN, 0, smem);
      else if (r < 912) { r -= 656; wt_tile(p, p.w_out + (size_t)l * 1024 * 1024, 1024, 1024, r / 16, r % 16, (bf16_t*)(p.ws + OFF_WTOUT) + (size_t)l * 1024 * 1024, 1024, 1, smem); }
      else if (r < 2320) { r -= 912; wt_tile(p, p.w_ffn_in + (size_t)l * 1024 * 5632, 1024, 5632, r / 88, r % 88, (bf16_t*)(p.ws + OFF_WTFI) + (size_t)l * 5632 * 1024, 5632, 2, smem); }
      else { r -= 2320; wt_tile(p, p.w_ffn_out + (size_t)l * FH * 1024, FH, 1024, r / 16, r % 16, (bf16_t*)(p.ws + OFF_WTFO) + (size_t)l * 1024 * FH, 1024, 1, smem); }
    } else if (it < 6050) {
      int l = it - 6048;
      for (int i = tid; i < 32 * 384; i += 256) {
        u32x4* d = (u32x4*)((bf16_t*)(p.ws + OFF_WTIN) + (size_t)l * NPAD_IN * 1024 + ((size_t)(i / 384) * NPAD_IN + 2592) * 32);
        d[i % 384] = (u32x4){0u, 0u, 0u, 0u};
      }
    } else if (it < 6434) {
      int r = it - 6050;
      mod_item(p, r / 192, r % 192, smem);
    } else {
      float* rc = (float*)(p.ws + OFF_ROPE);
      for (int i = tid; i < 1024; i += 256) {
        int pos = i >> 4, f = i & 15;
        float invf = powf(10000.f, -(float)f / 16.f);
        float ang = (float)pos * invf;
        rc[i] = cosf(ang);
        rc[1024 + i] = sinf(ang);
      }
    }
  }
}

DI void phase_prepB(const Params& p) {
  const float* MOD = (const float*)(p.ws + OFF_MOD);
  float* TAB = (float*)(p.ws + OFF_TAB);
  for (int i = blockIdx.x * 256 + tidx(p); i < 2 * 17 * 1024; i += gridDim.x * 256) {
    int k = i & 1023, b = (i >> 10) % 17, l = i / (17 * 1024);
    const float* m = MOD + ((size_t)l * 17 + b) * 6144;
    float sh1 = m[k], sc1 = m[1024 + k], sh2 = m[3072 + k], sc2 = m[4096 + k];
    float g0 = (l == 0) ? 1.f : p.ln2_g[k], b0 = (l == 0) ? 0.f : p.ln2_b[k];
    float* t = TAB + (size_t)l * 4 * 17 * 1024 + b * 1024 + k;
    t[0 * 17 * 1024] = g0 * (1.f + sc1);
    t[1 * 17 * 1024] = b0 * (1.f + sc1) + sh1;
    t[2 * 17 * 1024] = p.ln1_g[l * 1024 + k] * (1.f + sc2);
    t[3 * 17 * 1024] = p.ln1_b[l * 1024 + k] * (1.f + sc2) + sh2;
  }
}

DI void row_stats(const float* st, float& mu, float& rs) {
  const f32x4* s4 = (const f32x4*)st;
  f32x4 a = s4[0], b = s4[1], c = s4[2], d = s4[3];
  float S = a.x + a.z + b.x + b.z + c.x + c.z + d.x + d.z;
  float SS = a.y + a.w + b.y + b.w + c.y + c.w + d.y + d.w;
  mu = S * (1.f / 1024.f);
  float var = fmaxf(SS * (1.f / 1024.f) - mu * mu, 0.f);
  rs = rsqrtf(var + 1e-5f);
}

template <int MODE, int VAR = 0>
DI void gemm_tile(const Params& p, int l, int tm, int tn, char* smem) {
  constexpr int K = (MODE == 3) ? FH : 1024;
  constexpr int NK = K / 32;
  char* As = smem;
  char* Bs = smem + 16384;
  float* red = (float*)(smem + 73728);
  const int tid = tidx(p), lane = tid & 63, wid = tid >> 6, wr = wid >> 1, wc = wid & 1, fr = lane & 15, fq = lane >> 4;
  const int row0 = tm * 256;
  const bool lat = row0 < NLAT;
  const int bidx = lat ? row0 / NSEQ : 16;
  float* Y1 = (float*)(p.ws + OFF_Y1);
  float* CTXY2 = (float*)(p.ws + OFF_CTXY2);
  const float* ST1 = (const float*)(p.ws + OFF_ST1);
  const float* ST2 = (const float*)(p.ws + OFF_ST2);
  bf16_t* P = (bf16_t*)(p.ws + OFF_P);
  const float* MOD = (const float*)(p.ws + OFF_MOD) + ((size_t)l * 17 + bidx) * 6144;

  const bf16_t* absrc; int astride;
  if (MODE == 0) { absrc = (const bf16_t*)(p.ws + OFF_Y1) + (size_t)row0 * 32; astride = 32; }
  else if (MODE == 1) { absrc = P + (size_t)row0 * PC; astride = PC; }
  else if (MODE == 2) { absrc = (const bf16_t*)(p.ws + OFF_UF) + (size_t)row0 * 32; astride = 32; }
  else { absrc = P + (size_t)row0 * 32; astride = 32; }
  constexpr int NPADB = (MODE == 0) ? NPAD_IN : (MODE == 2 ? 5632 : 1024);
  const bf16_t* wt;
  if (MODE == 0) wt = (const bf16_t*)(p.ws + OFF_WTIN) + (size_t)l * NPAD_IN * 1024;
  else if (MODE == 1) wt = (const bf16_t*)(p.ws + OFF_WTOUT) + (size_t)l * 1024 * 1024;
  else if (MODE == 2) wt = (const bf16_t*)(p.ws + OFF_WTFI) + (size_t)l * 5632 * 1024;
  else wt = (const bf16_t*)(p.ws + OFF_WTFO) + (size_t)l * 1024 * FH;
  const int prow = lane >> 2, pch = (lane & 3) ^ ((-(prow >> 2)) & 3);
  const unsigned aoff = (unsigned)(((wid * 64 + prow) * astride + pch * 8) * 2);
  const unsigned apiece = (unsigned)(16 * astride * 2);
  const unsigned boff = (unsigned)(((tn * 128 + wid * 32 + prow) * 32 + pch * 8) * 2);
  const char* abase0 = (const char*)absrc;
  const char* bbase0 = (const char*)wt;
  char* adst_t = As + wid * 4096 + lane * 16;
  char* bdst_t = Bs + wid * 2048 + lane * 16;
  auto dma_a = [&](int kt, int buf, int i) __attribute__((always_inline)) {
    size_t kk;
    if (MODE == 1) { kk = kt * 64; if (kk >= 768) kk += 2560; }
    else kk = (size_t)kt * NROWS * 64;
    const char* ub = abase0 + kk;
    __builtin_amdgcn_global_load_lds((const unsigned*)(ub + (aoff + (unsigned)i * apiece)), (unsigned*)(adst_t + buf * 24576 + i * 1024), 16, 0, 0);
  };
  auto dma_b = [&](int kt, int buf, int i) __attribute__((always_inline)) {
    const char* ub = bbase0 + (size_t)kt * NPADB * 64;
    __builtin_amdgcn_global_load_lds((const unsigned*)(ub + (boff + (unsigned)i * 1024u)), (unsigned*)(bdst_t + buf * 24576 + i * 1024), 16, 0, 0);
  };
  auto dma = [&](int kt, int buf) __attribute__((always_inline)) {
#pragma unroll
    for (int i = 0; i < 4; ++i) dma_a(kt, buf, i);
#pragma unroll
    for (int i = 0; i < 2; ++i) dma_b(kt, buf, i);
  };
  const int fpos = (fq ^ ((-(fr >> 2)) & 3)) * 16;

  f32x4 acc[8][4];
#pragma unroll
  for (int m = 0; m < 8; ++m)
#pragma unroll
    for (int n = 0; n < 4; ++n) acc[m][n] = (f32x4){0.f, 0.f, 0.f, 0.f};

  __syncthreads();
  dma(0, 0);
  dma(1, 1);
  dma(2, 2);
  asm volatile("s_waitcnt vmcnt(12)" ::: "memory");
  __syncthreads();
  bf16x8 af[8], bfc[4], bfn[4];
  {
    const char* ab = As + (wr * 128 + fr) * 64 + fpos;
    const char* bb = Bs + (wc * 64 + fr) * 64 + fpos;
#pragma unroll
    for (int n = 0; n < 4; ++n) bfc[n] = *(const bf16x8*)(bb + n * 1024);
#pragma unroll
    for (int m = 0; m < 4; ++m) af[m] = *(const bf16x8*)(ab + m * 1024);
#pragma unroll
    for (int n = 0; n < 4; ++n) bfn[n] = bfc[n];
    __builtin_amdgcn_s_waitcnt(0xC07F);
  }
  int sc = 0;
#pragma unroll 1
  for (int kt = 0; kt < NK; ++kt) {
    const int sn = (sc == 2) ? 0 : sc + 1;
    {
      const char* ab = As + sc * 24576 + (wr * 128 + fr) * 64 + fpos;
#pragma unroll
      for (int m = 4; m < 8; ++m) af[m] = *(const bf16x8*)(ab + m * 1024);
    }
    __builtin_amdgcn_sched_barrier(0);
#pragma unroll
    for (int m = 0; m < 4; ++m)
#pragma unroll
      for (int n = 0; n < 4; ++n) { if (VAR != 2 && VAR != 3) acc[m][n] = mfma16(bfc[n], af[m], acc[m][n]); else asm volatile("" :: "v"(bfc[n]), "v"(af[m])); }
    __builtin_amdgcn_sched_barrier(0);
    if (kt + 2 < NK) asm volatile("s_waitcnt vmcnt(6) lgkmcnt(0)" ::: "memory");
    else asm volatile("s_waitcnt vmcnt(0) lgkmcnt(0)" ::: "memory");
    __syncthreads();
#pragma unroll
    for (int m = 4; m < 8; ++m)
#pragma unroll
      for (int n = 0; n < 4; ++n) { if (VAR != 2 && VAR != 3) acc[m][n] = mfma16(bfc[n], af[m], acc[m][n]); else asm volatile("" :: "v"(bfc[n]), "v"(af[m])); }
    __builtin_amdgcn_sched_barrier(0);
    if (kt + 1 < NK) {
      const char* ab = As + sn * 24576 + (wr * 128 + fr) * 64 + fpos;
      const char* bb = Bs + sn * 24576 + (wc * 64 + fr) * 64 + fpos;
#pragma unroll
      for (int n = 0; n < 4; ++n) bfn[n] = *(const bf16x8*)(bb + n * 1024);
#pragma unroll
      for (int m = 0; m < 4; ++m) af[m] = *(const bf16x8*)(ab + m * 1024);
    }
    __builtin_amdgcn_sched_barrier(0);
    if (VAR != 1 && VAR != 3 && kt + 3 < NK) dma(kt + 3, sc);
    __builtin_amdgcn_sched_barrier(0);
#pragma unroll
    for (int n = 0; n < 4; ++n) bfc[n] = bfn[n];
    sc = sn;
    __builtin_amdgcn_s_waitcnt(0xC07F);
  }
  int fr_e = fr;
  asm volatile("" : "+v"(fr_e));
  if (MODE == 0) {
    const int hs = tn * 2 + wc;
    if (hs > 40) return;
    const bool isq = (hs >= 30 && hs < 36), isk = (hs == 36 || hs == 37);
    if (isq || isk) {
      const float* nw = (isq ? p.qnorm_w : p.knorm_w) + l * 64;
      const float* rc = (const float*)(p.ws + OFF_ROPE);
      float w_[4][4];
#pragma unroll
      for (int n = 0; n < 4; ++n)
#pragma unroll
        for (int j = 0; j < 4; ++j) w_[n][j] = nw[n * 16 + fq * 4 + j];
#pragma unroll
      for (int m = 0; m < 8; ++m) {
        float ss = 0.f;
#pragma unroll
        for (int n = 0; n < 4; ++n)
#pragma unroll
          for (int j = 0; j < 4; ++j) ss += acc[m][n][j] * acc[m][n][j];
        ss += shx(ss, 16); ss += shx(ss, 32);
        float inv = rsqrtf(ss * (1.f / 64.f) + 1e-6f);
#pragma unroll
        for (int n = 0; n < 4; ++n)
#pragma unroll
          for (int j = 0; j < 4; ++j) acc[m][n][j] *= inv * w_[n][j];
        if (lat) {
          int t = (row0 + wr * 128 + m * 16 + fr_e) & (NSEQ - 1);
          int gr = t >> 6, gc = t & 63;
#pragma unroll
          for (int j = 0; j < 4; ++j) {
            float cr = rc[gr * 16 + fq * 4 + j], sr = rc[1024 + gr * 16 + fq * 4 + j];
            float cc = rc[gc * 16 + fq * 4 + j], sn = rc[1024 + gc * 16 + fq * 4 + j];
            float x1 = acc[m][0][j], x2 = acc[m][1][j], x3 = acc[m][2][j], x4 = acc[m][3][j];
            acc[m][0][j] = x1 * cr - x2 * sr; acc[m][1][j] = x2 * cr + x1 * sr;
            acc[m][2][j] = x3 * cc - x4 * sn; acc[m][3][j] = x4 * cc + x3 * sn;
          }
        }
      }
    }
    float scl = 1.f;
    if (hs < 6 || isq) scl = QSCALE;
    else if (hs == 18 || hs == 19) scl = 0.17677669529663687f;
    const int nmax = (hs == 40) ? 2 : 4;
#pragma unroll
    for (int m = 0; m < 8; ++m) {
      bf16_t* pr = P + (size_t)(row0 + wr * 128 + m * 16 + fr_e) * PC + hs * 64 + fq * 4;
#pragma unroll
      for (int n = 0; n < 4; ++n) {
        if (n < nmax) {
          u32x2 u; u.x = pack2(acc[m][n][0] * scl, acc[m][n][1] * scl); u.y = pack2(acc[m][n][2] * scl, acc[m][n][3] * scl);
          *(u32x2*)(pr + n * 16) = u;
        }
      }
    }
  } else if (MODE == 2) {
    bf16_t* H = P;
#pragma unroll
    for (int m = 0; m < 8; ++m) {
      bf16_t* hr = H + ((size_t)(tn * 2 + wc) * NROWS + row0 + wr * 128 + m * 16 + fr_e) * 32 + fq * 4;
#pragma unroll
      for (int n = 0; n < 2; ++n) {
        float h0 = siluf(acc[m][n][0]) * acc[m][n + 2][0], h1 = siluf(acc[m][n][1]) * acc[m][n + 2][1];
        float h2 = siluf(acc[m][n][2]) * acc[m][n + 2][2], h3 = siluf(acc[m][n][3]) * acc[m][n + 2][3];
        u32x2 u; u.x = pack2(h0, h1); u.y = pack2(h2, h3);
        *(u32x2*)(hr + n * 16) = u;
      }
    }
  } else {
    const float* gate = MOD + (MODE == 1 ? 2048 : 5120) + tn * 128 + wc * 64 + fq * 4;
    const float* lng = nullptr; const float* lnb = nullptr; const float* xs; const float* st = nullptr;
    float* dst; float* stout;
    bool doln;
    if (MODE == 1) {
      doln = (l == 1);
      if (l == 0) xs = lat ? p.x + (size_t)row0 * 1024 : p.ctx + (size_t)(row0 - NLAT) * 1024;
      else { xs = p.out + (size_t)row0 * 1024; st = ST2 + (size_t)row0 * 16; lng = p.ln2_g; lnb = p.ln2_b; }
      dst = Y1 + (size_t)row0 * 1024;
      stout = (float*)(p.ws + OFF_ST1) + (size_t)row0 * 16;
    } else {
      doln = true;
      xs = Y1 + (size_t)row0 * 1024; st = ST1 + (size_t)row0 * 16; lng = p.ln1_g + l * 1024; lnb = p.ln1_b + l * 1024;
      dst = lat ? p.out + (size_t)row0 * 1024 : CTXY2 + (size_t)(row0 - NLAT) * 1024;
      stout = (float*)(p.ws + OFF_ST2) + (size_t)row0 * 16;
    }
    const int cb = tn * 128 + wc * 64 + fq * 4;
    float* rst = red + 1024;
    if (doln) { float m_, r_; row_stats(st + (size_t)tid * 16, m_, r_); rst[tid * 2] = m_; rst[tid * 2 + 1] = r_; }
    __syncthreads();
#pragma unroll
    for (int m = 0; m < 8; ++m) {
      const int rl = wr * 128 + m * 16 + fr_e;
      float rmu = 0.f, rrs = 1.f;
      if (doln) { rmu = rst[rl * 2]; rrs = rst[rl * 2 + 1]; }
      float s_ = 0.f, ss = 0.f;
      const float* xr = xs + (size_t)rl * 1024 + cb;
      float* dr = dst + (size_t)rl * 1024 + cb;
#pragma unroll
      for (int n = 0; n < 4; ++n) {
        const f32x4 gv = *(const f32x4*)(gate + n * 16);
        f32x4 xv = *(const f32x4*)(xr + n * 16);
        if (doln) {
          const f32x4 lg = *(const f32x4*)(lng + cb + n * 16), lb = *(const f32x4*)(lnb + cb + n * 16);
          xv.x = (xv.x - rmu) * rrs * lg.x + lb.x; xv.y = (xv.y - rmu) * rrs * lg.y + lb.y;
          xv.z = (xv.z - rmu) * rrs * lg.z + lb.z; xv.w = (xv.w - rmu) * rrs * lg.w + lb.w;
        }
        f32x4 o;
        o.x = ALPHA * xv.x + gv.x * acc[m][n][0]; o.y = ALPHA * xv.y + gv.y * acc[m][n][1];
        o.z = ALPHA * xv.z + gv.z * acc[m][n][2]; o.w = ALPHA * xv.w + gv.w * acc[m][n][3];
        *(f32x4*)(dr + n * 16) = o;
        s_ += o.x + o.y + o.z + o.w;
        ss += o.x * o.x + o.y * o.y + o.z * o.z + o.w * o.w;
      }
      s_ += shx(s_, 16); s_ += shx(s_, 32);
      ss += shx(ss, 16); ss += shx(ss, 32);
      if (fq == 0) { red[((wr * 2 + wc) * 128 + m * 16 + fr_e) * 2] = s_; red[((wr * 2 + wc) * 128 + m * 16 + fr_e) * 2 + 1] = ss; }
      if (m & 1) __builtin_amdgcn_sched_barrier(0);
    }
    __syncthreads();
    {
      int r = tid, w_ = r >> 7, rr = r & 127;
      float s = red[((w_ * 2 + 0) * 128 + rr) * 2] + red[((w_ * 2 + 1) * 128 + rr) * 2];
      float ss = red[((w_ * 2 + 0) * 128 + rr) * 2 + 1] + red[((w_ * 2 + 1) * 128 + rr) * 2 + 1];
      *(f32x2*)(stout + (size_t)r * 16 + tn * 2) = (f32x2){s, ss};
    }
  }
}

template <int MODE, int VAR = 0>
DI void phase_gemm(const Params& p, int l, char* smem) {
  const int NT = (MODE == 0) ? 21 : (MODE == 2 ? 44 : 8);
  const int MT = (l == 0 || MODE == 0) ? 144 : 128;
  const int vb = (blockIdx.x & 7) * (gridDim.x >> 3) + (blockIdx.x >> 3);
  for (int t = vb; t < MT * NT; t += gridDim.x) {
    const int g = t / (8 * NT), r = t - g * 8 * NT;
    gemm_tile<MODE, VAR>(p, l, g * 8 + (r & 7), r >> 3, smem);
  }
}

typedef __attribute__((address_space(3))) s16x4 lds_s16x4;
template <int NH>
DI void attn_item(const Params& p, int qrow0, int qcol, int kcol, int vcol, int lat_row0, int nb_lat, int ctx_row0, int nb_ctx,
                  bool na, int dr0, const float* rpb_h, char* smem, bool dry = false) {
  char* KV = smem;
  float* rpbs = (float*)(smem + 3 * 16384);
  const int tid = tidx(p), lane = tid & 63, w = tid >> 6, fr = lane & 15, fq = lane >> 4;
  bf16_t* P = (bf16_t*)(p.ws + OFF_P);
  __syncthreads();
  if (na) for (int i = tid; i < 465; i += 256) rpbs[i] = rpb_h[i] * LOG2E;
  bf16x8 qf[NH][2];
  f32x4 o[NH][4], lsum[NH];
  float mrun[NH];
  const bf16x8 ones = (bf16x8){0x3F80, 0x3F80, 0x3F80, 0x3F80, 0x3F80, 0x3F80, 0x3F80, 0x3F80};
#pragma unroll
  for (int hh = 0; hh < NH; ++hh) {
    const bf16_t* qp = P + (size_t)(qrow0 + w * 16 + fr) * PC + qcol + hh * 64 + fq * 8;
    qf[hh][0] = *(const bf16x8*)qp; qf[hh][1] = *(const bf16x8*)(qp + 32);
#pragma unroll
    for (int i = 0; i < 4; ++i) o[hh][i] = (f32x4){0.f, 0.f, 0.f, 0.f};
    mrun[hh] = -1e30f; lsum[hh] = (f32x4){0.f, 0.f, 0.f, 0.f};
  }
  const int nb = nb_lat + nb_ctx;
  const unsigned goff = (unsigned)(((w * 16 + (lane >> 3)) * PC + (((lane & 7) ^ (lane >> 3)) * 8)) * 2);
  char* dstk = KV + w * 2048 + lane * 16;
  auto dma = [&](int kb, int st) __attribute__((always_inline)) {
    const int rb = kb < nb_lat ? lat_row0 + kb * 64 : ctx_row0 + (kb - nb_lat) * 64;
    const char* ub = (const char*)(P + (size_t)rb * PC);
#pragma unroll
    for (int i = 0; i < 2; ++i) {
      __builtin_amdgcn_global_load_lds((const unsigned*)(ub + kcol * 2 + (goff + (unsigned)(i * 8 * PC * 2))), (unsigned*)(dstk + st * 16384 + i * 1024), 16, 0, 0);
      __builtin_amdgcn_global_load_lds((const unsigned*)(ub + vcol * 2 + (goff + (unsigned)(i * 8 * PC * 2))), (unsigned*)(dstk + st * 16384 + 8192 + i * 1024), 16, 0, 0);
    }
  };
  const int qj = w * 16 + fr;
  const int cs = min(max(qj - 8, 0), 48);
  const int koff = fr * 128;
  const int kx0 = ((fq) ^ (fr & 7)) * 16, kx1 = ((4 + fq) ^ (fr & 7)) * 16;
  const int vr7 = ((fq & 1) * 4 + (fr >> 2));
  const int voff = (fq * 4 + (fr >> 2)) * 128 + (fr & 1) * 8;
  dma(0, 0);
  if (nb > 1) dma(1, 1);
  if (nb > 1) asm volatile("s_waitcnt vmcnt(4)" ::: "memory"); else asm volatile("s_waitcnt vmcnt(0)" ::: "memory");
  __syncthreads();
  int sc = 0;
  for (int kb = 0; kb < nb; ++kb) {
    const char* Kb = KV + sc * 16384;
    const char* Vb = Kb + 8192;
    const int sn2 = (sc == 0) ? 2 : sc - 1;
    if (kb + 2 < nb) dma(kb + 2, sn2);
    const bool msk = na && kb < nb_lat;
    int mt_lo = 0, mt_hi = 3;
    if (msk) { mt_lo = (w >= 2) ? w - 1 : 0; mt_hi = (w <= 1) ? w + 1 : 3; }
    bf16x8 kf[4][2];
#pragma unroll
    for (int mt = 0; mt < 4; ++mt)
      if (mt >= mt_lo && mt <= mt_hi) {
        kf[mt][0] = *(const bf16x8*)(Kb + koff + mt * 2048 + kx0);
        kf[mt][1] = *(const bf16x8*)(Kb + koff + mt * 2048 + kx1);
      }
    bf16x8 pf[NH][2];
    f32x4 s[NH][4];
#pragma unroll
    for (int hh = 0; hh < NH; ++hh)
#pragma unroll
      for (int mt = 0; mt < 4; ++mt) {
        if (mt >= mt_lo && mt <= mt_hi) {
          s[hh][mt] = mfma16(kf[mt][0], qf[hh][0], (f32x4){0.f, 0.f, 0.f, 0.f});
          s[hh][mt] = mfma16(kf[mt][1], qf[hh][1], s[hh][mt]);
        } else s[hh][mt] = (f32x4){-1e30f, -1e30f, -1e30f, -1e30f};
      }
    if (msk) {
#pragma unroll
      for (int hh = 0; hh < NH; ++hh)
#pragma unroll
        for (int mt = 0; mt < 4; ++mt)
          if (mt >= mt_lo && mt <= mt_hi) {
#pragma unroll
            for (int j = 0; j < 4; ++j) {
              int kc = mt * 16 + fq * 4 + j;
              bool valid = (kc >= cs) && (kc < cs + 16);
              int bi = min(max(kc - qj, -15), 15);
              s[hh][mt][j] = valid ? s[hh][mt][j] + rpbs[(dr0 + kb) * 31 + bi + 15] : -1e30f;
            }
          }
    }
#pragma unroll
    for (int hh = 0; hh < NH; ++hh) {
      float mx = fmaxf(fmaxf(fmaxf(s[hh][0][0], s[hh][0][1]), fmaxf(s[hh][0][2], s[hh][0][3])), fmaxf(fmaxf(s[hh][1][0], s[hh][1][1]), fmaxf(s[hh][1][2], s[hh][1][3])));
      mx = fmaxf(mx, fmaxf(fmaxf(fmaxf(s[hh][2][0], s[hh][2][1]), fmaxf(s[hh][2][2], s[hh][2][3])), fmaxf(fmaxf(s[hh][3][0], s[hh][3][1]), fmaxf(s[hh][3][2], s[hh][3][3]))));
      mx = fmaxf(mx, shx(mx, 16)); mx = fmaxf(mx, shx(mx, 32));
      const float mnew = fmaxf(mrun[hh], mx);
      const float alpha = __builtin_amdgcn_exp2f(mrun[hh] - mnew);
      mrun[hh] = mnew;
      const f32x4 av = (f32x4){alpha, alpha, alpha, alpha}, mv = (f32x4){mnew, mnew, mnew, mnew};
      lsum[hh] = lsum[hh] * av;
#pragma unroll
      for (int i = 0; i < 4; ++i) o[hh][i] = o[hh][i] * av;
#pragma unroll
      for (int mt = 0; mt < 4; ++mt) {
        f32x4 d = s[hh][mt] - mv;
        d[0] = __builtin_amdgcn_exp2f(d[0]); d[1] = __builtin_amdgcn_exp2f(d[1]); d[2] = __builtin_amdgcn_exp2f(d[2]); d[3] = __builtin_amdgcn_exp2f(d[3]);
        s[hh][mt] = d;
      }
#pragma unroll
      for (int kp = 0; kp < 2; ++kp) {
        u32x4 pk;
        pk.x = pack2(s[hh][2 * kp][0], s[hh][2 * kp][1]); pk.y = pack2(s[hh][2 * kp][2], s[hh][2 * kp][3]);
        pk.z = pack2(s[hh][2 * kp + 1][0], s[hh][2 * kp + 1][1]); pk.w = pack2(s[hh][2 * kp + 1][2], s[hh][2 * kp + 1][3]);
        pf[hh][kp] = __builtin_bit_cast(bf16x8, pk);
      }
    }
#pragma unroll
    for (int kp = 0; kp < 2; ++kp) {
      if ((kp == 0 && mt_lo <= 1) || (kp == 1 && mt_hi >= 2)) {
#pragma unroll
        for (int hh = 0; hh < NH; ++hh) lsum[hh] = mfma16(ones, pf[hh][kp], lsum[hh]);
        s16x4 vl[4], vh[4];
        {
          const unsigned a0 = (unsigned)(size_t)(Vb + voff + kp * 4096 + (((0 + ((fr & 3) >> 1)) ^ vr7) * 16));
          const unsigned a1 = (unsigned)(size_t)(Vb + voff + kp * 4096 + (((2 + ((fr & 3) >> 1)) ^ vr7) * 16));
          const unsigned a2 = (unsigned)(size_t)(Vb + voff + kp * 4096 + (((4 + ((fr & 3) >> 1)) ^ vr7) * 16));
          const unsigned a3 = (unsigned)(size_t)(Vb + voff + kp * 4096 + (((6 + ((fr & 3) >> 1)) ^ vr7) * 16));
          asm volatile(
              "ds_read_b64_tr_b16 %0, %8\n\tds_read_b64_tr_b16 %1, %8 offset:2048\n\t"
              "ds_read_b64_tr_b16 %2, %9\n\tds_read_b64_tr_b16 %3, %9 offset:2048\n\t"
              "ds_read_b64_tr_b16 %4, %10\n\tds_read_b64_tr_b16 %5, %10 offset:2048\n\t"
              "ds_read_b64_tr_b16 %6, %11\n\tds_read_b64_tr_b16 %7, %11 offset:2048\n\t"
              "s_waitcnt lgkmcnt(0)"
              : "=&v"(vl[0]), "=&v"(vh[0]), "=&v"(vl[1]), "=&v"(vh[1]), "=&v"(vl[2]), "=&v"(vh[2]), "=&v"(vl[3]), "=&v"(vh[3])
              : "v"(a0), "v"(a1), "v"(a2), "v"(a3)
              : "memory");
        }
#pragma unroll
        for (int dt = 0; dt < 4; ++dt) {
          bf16x8 vf = __builtin_shufflevector(vl[dt], vh[dt], 0, 1, 2, 3, 4, 5, 6, 7);
#pragma unroll
          for (int hh = 0; hh < NH; ++hh) o[hh][dt] = mfma16(vf, pf[hh][kp], o[hh][dt]);
        }
      }
    }
    if (kb + 2 < nb) asm volatile("s_waitcnt vmcnt(4) lgkmcnt(0)" ::: "memory");
    else asm volatile("s_waitcnt vmcnt(0) lgkmcnt(0)" ::: "memory");
    __builtin_amdgcn_s_barrier();
    asm volatile("" ::: "memory");
    sc = (sc == 2) ? 0 : sc + 1;
  }
#pragma unroll
  for (int hh = 0; hh < NH; ++hh) {
    const float inv = 1.f / lsum[hh][0];
    bf16_t* op = dry ? (bf16_t*)(p.ws + OFF_Y1) + (size_t)((qrow0 + w * 16 + fr) & 16383) * PC + qcol + hh * 64 + fq * 4
                     : P + (size_t)(qrow0 + w * 16 + fr) * PC + qcol + hh * 64 + fq * 4;
#pragma unroll
    for (int dt = 0; dt < 4; ++dt) {
      u32x2 u; u.x = pack2(o[hh][dt][0] * inv, o[hh][dt][1] * inv); u.y = pack2(o[hh][dt][2] * inv, o[hh][dt][3] * inv);
      *(u32x2*)(op + dt * 16) = u;
    }
  }
}

DI float logsig(float z) { return fminf(z, 0.f) - __logf(1.f + __expf(-fabsf(z))); }
DI int chunk_row0(int b, int cidx) { return cidx < 4 ? NLAT + b * LC + cidx * 64 : b * NSEQ + (cidx - 4) * 64; }
DI int chain_pos(int cidx, int dir) { return dir == 0 ? cidx : (cidx < 4 ? 3 - cidx : 39 - cidx); }

DI void gla_gates(const Params& p, int l, int h, int dir, int row0, float* bs, float* lrs, float* was, float* segt) {
  const int tid = tidx(p);
  const bf16_t* P = (const bf16_t*)(p.ws + OFF_P);
  {
    int s = tid >> 2, r4 = (tid & 3) * 4;
    u32x2 u = *(const u32x2*)(P + (size_t)(row0 + s) * PC + C_GLR + dir * 16 + r4);
    lrs[s * 17 + r4] = bflo(u.x); lrs[s * 17 + r4 + 1] = bfhi(u.x); lrs[s * 17 + r4 + 2] = bflo(u.y); lrs[s * 17 + r4 + 3] = bfhi(u.y);
    for (int i = tid; i < 512; i += 256) was[i] = p.gla_wa2[(((size_t)l * 2 + dir) * 16 + (i >> 5)) * 128 + h * 32 + (i & 31)];
  }
  __syncthreads();
  const int d = tid & 31, sg = tid >> 5;
  const float ba = p.gla_ba[(l * 2 + dir) * 128 + h * 32 + d];
  float la[8];
#pragma unroll
  for (int i = 0; i < 8; ++i) {
    int s = sg * 8 + i;
    float z = ba;
#pragma unroll
    for (int r = 0; r < 16; ++r) z += lrs[s * 17 + r] * was[r * 32 + d];
    la[i] = logsig(z) * (1.f / 16.f);
  }
  if (dir == 0) {
#pragma unroll
    for (int i = 1; i < 8; ++i) la[i] += la[i - 1];
    segt[sg * 32 + d] = la[7];
  } else {
#pragma unroll
    for (int i = 6; i >= 0; --i) la[i] += la[i + 1];
    segt[sg * 32 + d] = la[0];
  }
  __syncthreads();
  float pre = 0.f;
#pragma unroll
  for (int g = 0; g < 8; ++g) {
    float v = segt[g * 32 + d];
    if (dir == 0 ? (g < sg) : (g > sg)) pre += v;
  }
#pragma unroll
  for (int i = 0; i < 8; ++i) bs[(sg * 8 + i) * 33 + d] = la[i] + pre;
  __syncthreads();
}

DI void gla_passA(const Params& p, int l, int item, char* smem) {
  float* bs = (float*)smem;
  float* kw = bs + 64 * 33;
  float* vs = kw + 64 * 32;
  float* lrs = vs + 64 * 64;
  float* was = lrs + 64 * 17;
  float* segt = was + 512;
  const int tid = tidx(p);
  int dir = item & 1, cidx = (item >> 1) % 36, bh = item / 72, h = bh & 3, b = bh >> 2;
  const int row0 = chunk_row0(b, cidx);
  const bf16_t* P = (const bf16_t*)(p.ws + OFF_P);
  __syncthreads();
  gla_gates(p, l, h, dir, row0, bs, lrs, was, segt);
  {
    int s = tid >> 2, d8 = (tid & 3) * 8;
    u32x4 u = *(const u32x4*)(P + (size_t)(row0 + s) * PC + C_GLK + h * 32 + d8);
    unsigned uu[4] = {u.x, u.y, u.z, u.w};
    const int slast = dir == 0 ? 63 : 0;
#pragma unroll
    for (int e = 0; e < 4; ++e) {
      int d0 = d8 + 2 * e;
      kw[s * 32 + d0] = bflo(uu[e]) * __expf(bs[slast * 33 + d0] - bs[s * 33 + d0]);
      kw[s * 32 + d0 + 1] = bfhi(uu[e]) * __expf(bs[slast * 33 + d0 + 1] - bs[s * 33 + d0 + 1]);
    }
    int v16 = (tid & 3) * 16;
#pragma unroll
    for (int q = 0; q < 2; ++q) {
      u32x4 w = *(const u32x4*)(P + (size_t)(row0 + s) * PC + C_GLV + h * 64 + v16 + q * 8);
      unsigned ww[4] = {w.x, w.y, w.z, w.w};
#pragma unroll
      for (int e = 0; e < 4; ++e) { vs[s * 64 + v16 + q * 8 + 2 * e] = bflo(ww[e]); vs[s * 64 + v16 + q * 8 + 2 * e + 1] = bfhi(ww[e]); }
    }
  }
  __syncthreads();
  const int v = tid & 63, dg = (tid >> 6) * 8;
  float acc[8];
#pragma unroll
  for (int i = 0; i < 8; ++i) acc[i] = 0.f;
  for (int s = 0; s < 64; ++s) {
    float vv = vs[s * 64 + v];
    f32x4 k0 = *(const f32x4*)(kw + s * 32 + dg), k1 = *(const f32x4*)(kw + s * 32 + dg + 4);
    acc[0] += k0.x * vv; acc[1] += k0.y * vv; acc[2] += k0.z * vv; acc[3] += k0.w * vv;
    acc[4] += k1.x * vv; acc[5] += k1.y * vv; acc[6] += k1.z * vv; acc[7] += k1.w * vv;
  }
  const int pos = chain_pos(cidx, dir);
  float* LS = (float*)(p.ws + OFF_LS) + ((size_t)((b * 4 + h) * 2 + dir) * 36 + pos) * 2048;
#pragma unroll
  for (int i = 0; i < 8; ++i) LS[(dg + i) * 64 + v] = acc[i];
  if (tid < 32) {
    float* BL = (float*)(p.ws + OFF_BL) + ((size_t)((b * 4 + h) * 2 + dir) * 36 + pos) * 32;
    BL[tid] = bs[(dir == 0 ? 63 : 0) * 33 + tid];
  }
}

DI void gla_scan(const Params& p, int item) {
  const int tid = tidx(p);
  const int chain = item >> 3, e = (item & 7) * 256 + tid, d = e >> 6;
  float* LS = (float*)(p.ws + OFF_LS) + (size_t)chain * 36 * 2048 + e;
  const float* BL = (const float*)(p.ws + OFF_BL) + (size_t)chain * 36 * 32 + d;
  float S = 0.f;
#pragma unroll 6
  for (int pos = 0; pos < 36; ++pos) {
    float x = LS[(size_t)pos * 2048], bl = BL[pos * 32];
    LS[(size_t)pos * 2048] = S;
    S = __expf(bl) * S + x;
  }
}

DI void gla_passB(const Params& p, int l, int b, int h, int cidx, char* smem, bool dry = false) {
  float* bs = (float*)smem;
  bf16_t* Qe = (bf16_t*)(bs + 64 * 33);
  bf16_t* Ke = Qe + 64 * 40;
  bf16_t* Vs = Ke + 64 * 40;
  bf16_t* S0 = Vs + 64 * 72;
  float* lrs = (float*)(S0 + 32 * 72);
  float* was = lrs + 64 * 17;
  float* segt = was + 512;
  const int tid = tidx(p), lane = tid & 63, w = tid >> 6, fr = lane & 15, fq = lane >> 4;
  const int row0 = chunk_row0(b, cidx);
  bf16_t* P = (bf16_t*)(p.ws + OFF_P);
  f32x4 o[4];
#pragma unroll
  for (int i = 0; i < 4; ++i) o[i] = (f32x4){0.f, 0.f, 0.f, 0.f};
  __syncthreads();
  {
    int s = tid >> 2, v16 = (tid & 3) * 16;
    const bf16_t* vp = P + (size_t)(row0 + s) * PC + C_GLV + h * 64 + v16;
    *(u32x4*)(Vs + s * 72 + v16) = *(const u32x4*)vp;
    *(u32x4*)(Vs + s * 72 + v16 + 8) = *(const u32x4*)(vp + 8);
  }
  for (int dir = 0; dir < 2; ++dir) {
    gla_gates(p, l, h, dir, row0, bs, lrs, was, segt);
    {
      int s = tid >> 2, d8 = (tid & 3) * 8;
      u32x4 uq = *(const u32x4*)(P + (size_t)(row0 + s) * PC + C_GLQ + h * 32 + d8);
      u32x4 uk = *(const u32x4*)(P + (size_t)(row0 + s) * PC + C_GLK + h * 32 + d8);
      u32x4 oq, ok;
#pragma unroll
      for (int e = 0; e < 4; ++e) {
        int d0 = d8 + 2 * e;
        float b0 = bs[s * 33 + d0], b1 = bs[s * 33 + d0 + 1];
        oq[e] = pack2(bflo(uq[e]) * __expf(b0), bfhi(uq[e]) * __expf(b1));
        ok[e] = pack2(bflo(uk[e]) * __expf(-b0), bfhi(uk[e]) * __expf(-b1));
      }
      *(u32x4*)(Qe + s * 40 + d8) = oq;
      *(u32x4*)(Ke + s * 40 + d8) = ok;
      const int pos = chain_pos(cidx, dir);
      const float* LS = (const float*)(p.ws + OFF_LS) + ((size_t)((b * 4 + h) * 2 + dir) * 36 + pos) * 2048;
      int d = tid >> 3, v8 = (tid & 7) * 8;
      f32x4 s0 = *(const f32x4*)(LS + d * 64 + v8), s1 = *(const f32x4*)(LS + d * 64 + v8 + 4);
      u32x4 os;
      os.x = pack2(s0.x, s0.y); os.y = pack2(s0.z, s0.w); os.z = pack2(s1.x, s1.y); os.w = pack2(s1.z, s1.w);
      *(u32x4*)(S0 + d * 72 + v8) = os;
    }
    __syncthreads();
    {
      const bf16x8 qf = *(const bf16x8*)(Qe + (w * 16 + fr) * 40 + fq * 8);
      f32x4 at[4];
#pragma unroll
      for (int mt = 0; mt < 4; ++mt) {
        const bool need = dir == 0 ? (mt <= w) : (mt >= w);
        if (need) {
          const bf16x8 kf = *(const bf16x8*)(Ke + (mt * 16 + fr) * 40 + fq * 8);
          at[mt] = mfma16(kf, qf, (f32x4){0.f, 0.f, 0.f, 0.f});
          if (mt == w) {
#pragma unroll
            for (int j = 0; j < 4; ++j) {
              const int sI = fq * 4 + j;
              const bool keep = dir == 0 ? (sI <= fr) : (sI >= fr);
              at[mt][j] = keep ? at[mt][j] : 0.f;
            }
          }
        } else at[mt] = (f32x4){0.f, 0.f, 0.f, 0.f};
      }
#pragma unroll
      for (int kp = 0; kp < 2; ++kp) {
        const bool needp = dir == 0 ? (2 * kp <= w) : (2 * kp + 1 >= w);
        if (needp) {
          u32x4 pk;
          pk.x = pack2(at[2 * kp][0], at[2 * kp][1]); pk.y = pack2(at[2 * kp][2], at[2 * kp][3]);
          pk.z = pack2(at[2 * kp + 1][0], at[2 * kp + 1][1]); pk.w = pack2(at[2 * kp + 1][2], at[2 * kp + 1][3]);
          const bf16x8 pf = __builtin_bit_cast(bf16x8, pk);
#pragma unroll
          for (int dt = 0; dt < 4; ++dt) {
            const bf16_t* vp = Vs + (kp * 32 + fq * 4 + (fr >> 2)) * 72 + dt * 16 + (fr & 3) * 4;
            s16x4 lo = __builtin_amdgcn_ds_read_tr16_b64_v4i16((lds_s16x4*)vp);
            s16x4 hi = __builtin_amdgcn_ds_read_tr16_b64_v4i16((lds_s16x4*)(vp + 16 * 72));
            bf16x8 vf = __builtin_shufflevector(lo, hi, 0, 1, 2, 3, 4, 5, 6, 7);
            o[dt] = mfma16(vf, pf, o[dt]);
          }
        }
      }
#pragma unroll
      for (int dt = 0; dt < 4; ++dt) {
        const bf16_t* sp = S0 + (fq * 8 + (fr >> 2)) * 72 + dt * 16 + (fr & 3) * 4;
        s16x4 lo = __builtin_amdgcn_ds_read_tr16_b64_v4i16((lds_s16x4*)sp);
        s16x4 hi = __builtin_amdgcn_ds_read_tr16_b64_v4i16((lds_s16x4*)(sp + 4 * 72));
        bf16x8 sf = __builtin_shufflevector(lo, hi, 0, 1, 2, 3, 4, 5, 6, 7);
        o[dt] = mfma16(sf, qf, o[dt]);
      }
    }
    __syncthreads();
  }
  float ss = 0.f;
#pragma unroll
  for (int dt = 0; dt < 4; ++dt) ss += o[dt][0] * o[dt][0] + o[dt][1] * o[dt][1] + o[dt][2] * o[dt][2] + o[dt][3] * o[dt][3];
  ss += shx(ss, 16); ss += shx(ss, 32);
  const float inv = rsqrtf(ss * (1.f / 64.f) + 1e-6f);
#pragma unroll
  for (int dt = 0; dt < 4; ++dt) {
    const f32x4 nw = *(const f32x4*)(p.gla_norm_w + l * 64 + dt * 16 + fq * 4);
    bf16_t* gp = P + (size_t)(row0 + w * 16 + fr) * PC + C_GLG + h * 64 + dt * 16 + fq * 4;
    u32x2 g = *(const u32x2*)gp;
    u32x2 u;
    u.x = pack2(o[dt][0] * inv * nw.x * siluf(bflo(g.x)), o[dt][1] * inv * nw.y * siluf(bfhi(g.x)));
    u.y = pack2(o[dt][2] * inv * nw.z * siluf(bflo(g.y)), o[dt][3] * inv * nw.w * siluf(bfhi(g.y)));
    if (dry) gp = (bf16_t*)(p.ws + OFF_Y1) + (size_t)((row0 + w * 16 + fr) & 16383) * PC + C_GLG + h * 64 + dt * 16 + fq * 4;
    *(u32x2*)gp = u;
  }
}

DI void phase_mixA(const Params& p, int l, char* smem, bool dry = false, int only = 3) {
  const int NGQA = NB * 2 * 32, NGLA = NB * 4 * 36 * 2;
  for (int it = blockIdx.x; it < NGQA + NGLA; it += gridDim.x) {
    if (it < NGQA) {
      if (!(only & 1)) continue;
      int b = it >> 6, rem = it & 63, g = rem >> 5, qt = rem & 31;
      attn_item<3>(p, b * NSEQ + qt * 64, C_GAQ + g * 192, C_GAK + g * 64, C_GAV + g * 64, b * NSEQ, 32, NLAT + b * LC, 4, false, 0, nullptr, smem, dry);
    } else if (only & 2) gla_passA(p, l, it - NGQA, smem);
  }
}
DI void phase_mixS(const Params& p, int l, char* smem, bool dry = false) {
  const int NSC = NB * 4 * 2 * 8, NNA = NB * 6 * 32, NCG = (l == 0) ? NB * 2 * 4 : 0, NCN = (l == 0) ? NB * 6 * 4 : 0;
  for (int it = blockIdx.x; it < NSC + NNA + NCG + NCN; it += gridDim.x) {
    if (it < NSC) {
      if (!dry) gla_scan(p, it);
    } else if (it < NSC + NNA) {
      int i = it - NSC, b = i / 192, rem = i % 192, h = rem >> 5, r = rem & 31;
      int rs = min(max(r - 4, 0), 24);
      attn_item<1>(p, b * NSEQ + r * 64, C_NAQ + h * 64, C_NAK + h * 64, C_NAV + h * 64, b * NSEQ + rs * 64, 8, NLAT + b * LC, 4, true, rs - r + 7,
                   p.na_rpb + ((size_t)l * 6 + h) * 465, smem, dry);
    } else if (it < NSC + NNA + NCG) {
      int i = it - NSC - NNA, b = i >> 3, g = (i >> 2) & 1, qt = i & 3;
      attn_item<3>(p, NLAT + b * LC + qt * 64, C_GAQ + g * 192, C_GAK + g * 64, C_GAV + g * 64, 0, 0, NLAT + b * LC, 4, false, 0, nullptr, smem, dry);
    } else {
      int i = it - NSC - NNA - NCG, b = i / 24, rem = i % 24, h = rem >> 2, qt = rem & 3;
      attn_item<1>(p, NLAT + b * LC + qt * 64, C_NAQ + h * 64, C_NAK + h * 64, C_NAV + h * 64, 0, 0, NLAT + b * LC, 4, false, 0, nullptr, smem, dry);
    }
  }
}
DI void phase_mixB(const Params& p, int l, char* smem, bool dry = false) {
  const int cpl = (l == 0) ? 36 : 32;
  const int NGLB = NB * 4 * cpl;
  for (int it = blockIdx.x; it < NGLB; it += gridDim.x) {
    int cc = it % cpl, bh = it / cpl;
    gla_passB(p, l, bh >> 2, bh & 3, cc + (36 - cpl), smem, dry);
  }
}

DI void phase_final(const Params& p) {
  const int lane = tidx(p) & 63, w = tidx(p) >> 6;
  const float* g = p.ln2_g + 1024; const float* bb = p.ln2_b + 1024;
  for (int r = blockIdx.x * 4 + w; r < NLAT; r += gridDim.x * 4) {
    float* row = p.out + (size_t)r * 1024;
    f32x4 v[4];
    float s = 0.f;
#pragma unroll
    for (int i = 0; i < 4; ++i) { v[i] = *(const f32x4*)(row + i * 256 + lane * 4); s += v[i].x + v[i].y + v[i].z + v[i].w; }
#pragma unroll
    for (int m = 1; m < 64; m <<= 1) s += shx(s, m);
    float mu = s * (1.f / 1024.f), ss = 0.f;
#pragma unroll
    for (int i = 0; i < 4; ++i) { float a = v[i].x - mu, b = v[i].y - mu, c = v[i].z - mu, d = v[i].w - mu; ss += a * a + b * b + c * c + d * d; }
#pragma unroll
    for (int m = 1; m < 64; m <<= 1) ss += shx(ss, m);
    float rs = rsqrtf(ss * (1.f / 1024.f) + 1e-5f);
#pragma unroll
    for (int i = 0; i < 4; ++i) {
      f32x4 gg = *(const f32x4*)(g + i * 256 + lane * 4), be = *(const f32x4*)(bb + i * 256 + lane * 4), o;
      o.x = (v[i].x - mu) * rs * gg.x + be.x; o.y = (v[i].y - mu) * rs * gg.y + be.y;
      o.z = (v[i].z - mu) * rs * gg.z + be.z; o.w = (v[i].w - mu) * rs * gg.w + be.w;
      *(f32x4*)(row + i * 256 + lane * 4) = o;
    }
  }
}

DI void phase_uconv(const Params& p, int kind, int l) {
  const int tid = tidx(p), lane = tid & 63, w = tid >> 6;
  const int nrows = (kind == 1 && l == 1) ? NLAT : NROWS;
  const float* MODb = (const float*)(p.ws + OFF_MOD);
  const float* TABb = (const float*)(p.ws + OFF_TAB) + (size_t)l * 4 * 17 * 1024;
  for (int r = blockIdx.x * 4 + w; r < nrows; r += gridDim.x * 4) {
    const bool lat = r < NLAT;
    const int b = lat ? r / NSEQ : 16;
    const float* src; const float* st = nullptr; bf16_t* dstb;
    if (kind == 0) {
      if (l == 0) src = lat ? p.x + (size_t)r * 1024 : p.ctx + (size_t)(r - NLAT) * 1024;
      else { src = lat ? p.out + (size_t)r * 1024 : (const float*)(p.ws + OFF_CTXY2) + (size_t)(r - NLAT) * 1024; st = (const float*)(p.ws + OFF_ST2) + (size_t)r * 16; }
      dstb = (bf16_t*)(p.ws + OFF_Y1);
    } else {
      src = (const float*)(p.ws + OFF_Y1) + (size_t)r * 1024; st = (const float*)(p.ws + OFF_ST1) + (size_t)r * 16;
      dstb = (bf16_t*)(p.ws + OFF_UF);
    }
    float mu = 0.f, rs = 1.f;
    if (st) row_stats(st, mu, rs);
    const bool raw = (kind == 0 && l == 0);
    const float* t1 = raw ? MODb + (size_t)b * 6144 + 1024 : TABb + (size_t)(kind * 2) * 17 * 1024 + b * 1024;
    const float* t2 = raw ? MODb + (size_t)b * 6144 : TABb + (size_t)(kind * 2 + 1) * 17 * 1024 + b * 1024;
#pragma unroll
    for (int i = 0; i < 4; ++i) {
      const int k = i * 256 + lane * 4;
      f32x4 v = *(const f32x4*)(src + k), a = *(const f32x4*)(t1 + k), c = *(const f32x4*)(t2 + k);
      if (raw) { a.x += 1.f; a.y += 1.f; a.z += 1.f; a.w += 1.f; }
      u32x2 u;
      u.x = pack2((v.x - mu) * rs * a.x + c.x, (v.y - mu) * rs * a.y + c.y);
      u.y = pack2((v.z - mu) * rs * a.z + c.z, (v.w - mu) * rs * a.w + c.w);
      *(u32x2*)(dstb + ((size_t)(k >> 5) * NROWS + r) * 32 + (k & 31)) = u;
    }
  }
}

#define XB_TMO      128
#define XB_XCNT(j)  (256  + 64 * (j))
#define XB_XSUB(j)  (1280 + 64 * (j))
#define XB_XGEN(j)  (2304 + 64 * (j))
#define XB_TOP      3328
#define XB_TOPGEN   3392
#define XCD_BAR_WORDS 3456
#define XB_SPIN_CAP (1u << 18)
#define LAS __attribute__((address_space(3)))

__device__ __forceinline__ unsigned xb_ld(unsigned* p)              { return __hip_atomic_load(p, __ATOMIC_RELAXED, __HIP_MEMORY_SCOPE_AGENT); }
__device__ __forceinline__ unsigned xb_add(unsigned* p, unsigned v) { return __hip_atomic_fetch_add(p, v, __ATOMIC_RELAXED, __HIP_MEMORY_SCOPE_AGENT); }
__device__ __forceinline__ unsigned xb_xcc_id() { return (unsigned)__builtin_amdgcn_s_getreg((3 << 11) | 20) & 0xFu; }
#define XB_SPIN(cond, bar) do { unsigned _sp = 0; while (cond) { __builtin_amdgcn_s_sleep(1); \
    if ((++_sp & 255u) == 0u) { if (xb_ld(&(bar)[XB_TMO])) break; if (_sp > XB_SPIN_CAP) { atomicAdd(&(bar)[XB_TMO], 1u); break; } } } } while (0)

struct XcdBarrier {
    unsigned* bar; unsigned x;
    volatile LAS unsigned* st;
};

__device__ __forceinline__ XcdBarrier xcd_barrier_post(unsigned* bar, volatile LAS unsigned* st) {
    XcdBarrier b; b.bar = bar; b.x = xb_xcc_id(); b.st = st;
    if (threadIdx.x == 0) (void)xb_add(&bar[XB_XCNT(b.x)], 1u);
    return b;
}
__device__ __forceinline__ void xcd_barrier_complete(unsigned* bar, unsigned x, unsigned& nloc, unsigned& nx) {
    const unsigned G = gridDim.x * gridDim.y * gridDim.z;
    unsigned sum, cnt, mine, sp = 0u;
    for (;;) {
        sum = 0u; cnt = 0u; mine = 0u;
#pragma unroll
        for (unsigned j = 0; j < 16; ++j) { const unsigned c = xb_ld(&bar[XB_XCNT(j)]); sum += c; cnt += (c > 0u) ? 1u : 0u; mine = (j == x) ? c : mine; }
        if (sum == G) break;
        __builtin_amdgcn_s_sleep(1);
        if ((++sp & 255u) == 0u) { if (xb_ld(&bar[XB_TMO])) break; if (sp > XB_SPIN_CAP) { atomicAdd(&bar[XB_TMO], 1u); break; } }
    }
    nloc = mine > 0u ? mine : 1u; nx = cnt > 0u ? cnt : 1u;
}

__device__ __forceinline__ void xcd_barrier(const XcdBarrier& b) {
    asm volatile("s_waitcnt vmcnt(0)" ::: "memory");
    __syncthreads();
    if (threadIdx.x == 0) {
        unsigned* bar = b.bar;
        __builtin_amdgcn_s_waitcnt(0);
        unsigned nloc = b.st[0], nx = b.st[1];
        if (nloc == 0u) { xcd_barrier_complete(bar, b.x, nloc, nx); b.st[0] = nloc; b.st[1] = nx; }
        const unsigned old = xb_add(&bar[XB_XSUB(b.x)], 1u);
        const unsigned gen = old / nloc;
        if (old + 1u == (gen + 1u) * nloc) {
            __builtin_amdgcn_fence(__ATOMIC_RELEASE, "agent");
            asm volatile("s_waitcnt vmcnt(0)" ::: "memory");
            const unsigned og = xb_add(&bar[XB_TOP], 1u);
            const unsigned tg = og / nx;
            if (og + 1u == (tg + 1u) * nx) xb_add(&bar[XB_TOPGEN], 1u);
            else XB_SPIN(xb_ld(&bar[XB_TOPGEN]) == tg, bar);
            __builtin_amdgcn_fence(__ATOMIC_ACQUIRE, "agent");
            xb_add(&bar[XB_XGEN(b.x)], 1u);
            asm volatile("s_waitcnt vmcnt(0)" ::: "memory");
        } else {
            XB_SPIN(xb_ld(&bar[XB_XGEN(b.x)]) == gen, bar);
            __builtin_amdgcn_fence(__ATOMIC_ACQUIRE, "agent");
            asm volatile("s_waitcnt vmcnt(0)" ::: "memory");
        }
    }
    __syncthreads();
}


__global__ void __launch_bounds__(256, 2) mega(Params p_in) {
  Params p = p_in;
  p.wave_id = __builtin_amdgcn_readfirstlane((int)(threadIdx.x >> 6));
  extern __shared__ __attribute__((aligned(16))) char smem[];
  __shared__ uint4 xb_words;
  cg::grid_group grid = cg::this_grid();
  if (p.ph_lo < 0) grid.sync();
  if (threadIdx.x == 0) xb_words = make_uint4(0u, 0u, 0u, 0u);
  __syncthreads();
  XcdBarrier xb = xcd_barrier_post((unsigned*)(p.ws + OFF_BAR), (volatile LAS unsigned*)&xb_words);
  if (DUP & 32) { for (int i = 0; i < 16; ++i) xcd_barrier(xb); }
  for (int ph = p.ph_lo; ph < p.ph_hi; ++ph) {
    if (ph > p.ph_lo) xcd_barrier(xb);
    if (ph == 0) { phase_prepA(p, smem); if (DUP & 8) phase_prepA(p, smem); }
    else if (ph == 1) { phase_prepB(p); phase_uconv(p, 0, 0); }
    else {
      const int l = (ph - 2) / 9, s = (ph - 2) % 9;
      if (s == 0) { if (DUP & 1) phase_gemm<0, GV>(p, l, smem); phase_gemm<0>(p, l, smem); }
      else if (s == 1) { if (DUP & 2) phase_mixA(p, l, smem, true); if (DUP & 64) phase_mixA(p, l, smem, true, 2); phase_mixA(p, l, smem); }
      else if (s == 2) { if (DUP & 4) phase_mixS(p, l, smem, true); phase_mixS(p, l, smem); }
      else if (s == 3) { if (DUP & 128) phase_mixB(p, l, smem, true); phase_mixB(p, l, smem); }
      else if (s == 4) { if (DUP & 1) phase_gemm<1, GV>(p, l, smem); phase_gemm<1>(p, l, smem); }
      else if (s == 5) { phase_uconv(p, 1, l); if (DUP & 16) phase_uconv(p, 1, l); }
      else if (s == 6) { if (DUP & 1) phase_gemm<2, GV>(p, l, smem); phase_gemm<2>(p, l, smem); }
      else if (s == 7) { if (DUP & 1) phase_gemm<3, GV>(p, l, smem); phase_gemm<3>(p, l, smem); }
      else if (l == 0) phase_uconv(p, 0, 1);
      else phase_final(p);
    }
  }
}

extern "C" void kernel_launch(void* const* d_in, const int* in_sizes, int n_in, void* d_out, int out_size, void* d_ws, size_t ws_size,
                              hipStream_t stream) {
  static int grid = 0;
  if (grid == 0) {
    if (n_in != 20 || out_size != NLAT * 1024 || ws_size < WS_END) {
      fprintf(stderr, "kernel_launch: unexpected shapes (n_in %d out %d ws %zu need %zu)\n", n_in, out_size, ws_size, (size_t)WS_END);
      grid = -1; return;
    }
    int dev = 0, cus = 0, per = 0;
    hipGetDevice(&dev);
    hipDeviceGetAttribute(&cus, hipDeviceAttributeMultiprocessorCount, dev);
    hipFuncSetAttribute((const void*)mega, hipFuncAttributeMaxDynamicSharedMemorySize, SMEM_BYTES);
    hipOccupancyMaxActiveBlocksPerMultiprocessor(&per, (const void*)mega, 256, SMEM_BYTES);
    if (per < 1) per = 1;
    if (per > 2) per = 2;
    grid = cus * per;
  }
  if (grid < 0) return;
  if (hipMemsetAsync((char*)d_ws + OFF_BAR, 0, BAR_BYTES, stream) != hipSuccess) { fprintf(stderr, "kernel_launch: memset failed\n"); return; }
  Params p{};
  const float** pp = (const float**)&p;
  for (int i = 0; i < 20; ++i) pp[i] = (const float*)d_in[i];
  p.out = (float*)d_out; p.ws = (char*)d_ws;
#if ONE_LAUNCH
  p.ph_lo = 0; p.ph_hi = NPHASE;
  void* args[] = {&p};
  hipError_t e = hipLaunchCooperativeKernel((const void*)mega, dim3(grid), dim3(256), args, SMEM_BYTES, stream);
  if (e != hipSuccess) fprintf(stderr, "cooperative launch failed: %s (grid %d)\n", hipGetErrorString(e), grid);
#else
  for (int ph = 0; ph < NPHASE; ++ph) {
    p.ph_lo = ph; p.ph_hi = ph + 1;
    hipLaunchKernelGGL(mega, dim3(grid), dim3(256), SMEM_BYTES, stream, p);
  }
#endif
}
```

```cpp
#include <hip/hip_runtime.h>
#include <hip/hip_cooperative_groups.h>
#include <cstdio>
#include <cstdint>
namespace cg = cooperative_groups;

#ifndef PM
#define PM 0x1ff
#endif
#ifndef GV
#define GV 0
#endif
#ifndef DUP
#define DUP 0
#endif
#ifndef ONE_LAUNCH
#define ONE_LAUNCH 1
#endif

typedef unsigned short bf16_t;
typedef short bf16x8 __attribute__((ext_vector_type(8)));
typedef short s16x4 __attribute__((ext_vector_type(4)));
typedef float f32x4 __attribute__((ext_vector_type(4)));
typedef float f32x2 __attribute__((ext_vector_type(2)));
typedef unsigned u32x4 __attribute__((ext_vector_type(4)));
typedef unsigned u32x2 __attribute__((ext_vector_type(2)));
#define DI __device__ __forceinline__

constexpr int NB = 16, NSEQ = 2048, LC = 256, DM = 1024;
constexpr int NLAT = NB * NSEQ;
constexpr int NCTX = NB * LC;
constexpr int NROWS = NLAT + NCTX;
constexpr int PC = 2592;
constexpr int NPAD_IN = 2688;
constexpr int FH = 2816;
constexpr int C_NAQ = 0, C_NAK = 384, C_NAV = 768, C_GLQ = 1152, C_GLK = 1280, C_GLV = 1408, C_GLG = 1664,
              C_GAQ = 1920, C_GAK = 2304, C_GAV = 2432, C_GLR = 2560;
constexpr float ALPHA = 1.41421356237f;
constexpr float LOG2E = 1.44269504089f;
constexpr float QSCALE = 0.125f * LOG2E;

constexpr size_t al256(size_t x) { return (x + 255) & ~(size_t)255; }
constexpr size_t OFF_WTIN = 0;
constexpr size_t OFF_WTOUT = OFF_WTIN + al256((size_t)2 * NPAD_IN * 1024 * 2);
constexpr size_t OFF_WTFI = OFF_WTOUT + al256((size_t)2 * 1024 * 1024 * 2);
constexpr size_t OFF_WTFO = OFF_WTFI + al256((size_t)2 * 5632 * 1024 * 2);
constexpr size_t OFF_MOD = OFF_WTFO + al256((size_t)2 * 1024 * FH * 2);
constexpr size_t OFF_TAB = OFF_MOD + al256((size_t)2 * 17 * 6144 * 4);
constexpr size_t OFF_ROPE = OFF_TAB + al256((size_t)2 * 4 * 17 * 1024 * 4);
constexpr size_t OFF_ST1 = OFF_ROPE + al256((size_t)2 * 64 * 16 * 4);
constexpr size_t OFF_ST2 = OFF_ST1 + al256((size_t)NROWS * 16 * 4);
constexpr size_t OFF_LS = OFF_ST2 + al256((size_t)NROWS * 16 * 4);
constexpr size_t OFF_BL = OFF_LS + al256((size_t)NB * 4 * 2 * 36 * 2048 * 4);
constexpr size_t OFF_CTXY2 = OFF_BL + al256((size_t)NB * 4 * 2 * 36 * 32 * 4);
constexpr size_t OFF_UF = OFF_LS;
constexpr size_t OFF_Y1 = OFF_UF + al256((size_t)NROWS * 1024 * 2);
constexpr size_t OFF_P = OFF_Y1 + al256((size_t)NROWS * 1024 * 4);
constexpr size_t OFF_BAR = OFF_P + al256((size_t)NROWS * FH * 2);
constexpr size_t BAR_BYTES = 16384;
constexpr size_t WS_END = OFF_BAR + BAR_BYTES;

constexpr int SMEM_BYTES = 73728 + 6144;
constexpr int NPHASE = 20;

struct Params {
  const float *x, *c, *ctx, *c_ctx, *w_ada, *b_ada, *w_in, *na_rpb, *gla_wa2, *gla_ba, *gla_norm_w, *qnorm_w, *knorm_w,
      *w_out, *ln1_g, *ln1_b, *w_ffn_in, *w_ffn_out, *ln2_g, *ln2_b;
  float* out;
  char* ws;
  int ph_lo, ph_hi;
  int wave_id, pad_;
};

typedef __bf16 bf16x2_t __attribute__((ext_vector_type(2)));
DI unsigned pack2(float lo, float hi) {
  bf16x2_t v = {(__bf16)lo, (__bf16)hi};
  return __builtin_bit_cast(unsigned, v);
}
DI bf16_t f2bf(float f) { return (bf16_t)(pack2(f, 0.f) & 0xffffu); }
DI float bf2f(unsigned h) { return __uint_as_float(h << 16); }
DI float bflo(unsigned u) { return __uint_as_float(u << 16); }
DI float bfhi(unsigned u) { return __uint_as_float(u & 0xffff0000u); }
DI f32x4 mfma16(bf16x8 a, bf16x8 b, f32x4 c) { return __builtin_amdgcn_mfma_f32_16x16x32_bf16(a, b, c, 0, 0, 0); }
DI float siluf(float x) { return x / (1.f + __expf(-x)); }
DI int tidx(const Params& p) {
  int t = (p.wave_id << 6) | (int)__builtin_amdgcn_mbcnt_hi(~0u, __builtin_amdgcn_mbcnt_lo(~0u, 0u));
  asm volatile("" : "+v"(t));
  return t;
}
DI float shx(float v, int m) { return __shfl_xor(v, m, 64); }

DI int dest_row(int kind, int n) {
  if (kind == 0) return n < 1920 ? n : (n < 1952 ? n + 640 : n - 32);
  if (kind == 2) { int q = n / FH, hd = n - q * FH; return (hd >> 6) * 128 + ((hd >> 5) & 1) * 64 + q * 32 + (hd & 31); }
  return n;
}

DI void wt_tile(const Params& p, const float* __restrict__ src, int K, int N, int kt, int nt, bf16_t* __restrict__ dst, int dstStride, int kind, char* smem) {
  float* tile = (float*)smem;
  const int tid = tidx(p), k0 = kt * 64, n0 = nt * 64;
#pragma unroll 4
  for (int ii = 0; ii < 16; ++ii) {
    int i = (tid >> 6) + 4 * ii, j = tid & 63, n = n0 + j;
    tile[i * 65 + j] = (n < N) ? src[(size_t)(k0 + i) * N + n] : 0.f;
  }
  __syncthreads();
#pragma unroll 4
  for (int ii = 0; ii < 16; ++ii) {
    int jj = (tid >> 6) + 4 * ii, kk = tid & 63, n = n0 + jj;
    if (n < N) dst[((size_t)((k0 + kk) >> 5) * dstStride + dest_row(kind, n)) * 32 + ((k0 + kk) & 31)] = f2bf(tile[kk * 65 + jj]);
  }
}

DI void mod_item(const Params& p, int l, int cgi, char* smem) {
  float* sc = (float*)smem;
  float* red = sc + 17 * 256;
  const int tid = tidx(p), col = tid & 31, kg = tid >> 5, n = cgi * 32 + col;
  float acc[17];
#pragma unroll
  for (int r = 0; r < 17; ++r) acc[r] = 0.f;
  const float* w = p.w_ada + (size_t)l * 1024 * 6144 + n;
  for (int kc = 0; kc < 4; ++kc) {
    __syncthreads();
#pragma unroll
    for (int r = 0; r < 17; ++r) {
      float v = (r < 16) ? p.c[r * 1024 + kc * 256 + tid] : p.c_ctx[kc * 256 + tid];
      sc[r * 256 + tid] = siluf(v);
    }
    __syncthreads();
#pragma unroll 4
    for (int kk = 0; kk < 32; ++kk) {
      int kl = kg * 32 + kk;
      float wv = w[(size_t)(kc * 256 + kl) * 6144];
#pragma unroll
      for (int r = 0; r < 17; ++r) acc[r] += sc[r * 256 + kl] * wv;
    }
  }
#pragma unroll
  for (int r = 0; r < 17; ++r) red[(kg * 17 + r) * 32 + col] = acc[r];
  __syncthreads();
  float* MOD = (float*)(p.ws + OFF_MOD);
  for (int o = tid; o < 17 * 32; o += 256) {
    int r = o >> 5, cc = o & 31;
    float s = p.b_ada[l * 6144 + cgi * 32 + cc];
#pragma unroll
    for (int g = 0; g < 8; ++g) s += red[(g * 17 + r) * 32 + cc];
    MOD[((size_t)l * 17 + r) * 6144 + cgi * 32 + cc] = s;
  }
}

DI void phase_prepA(const Params& p, char* smem) {
  const int tid = tidx(p);
  for (int it = blockIdx.x; it < 6435; it += gridDim.x) {
    __syncthreads();
    if (it < 6048) {
      int l = it / 3024, r = it % 3024;
      if (r < 656) wt_tile(p, p.w_in + (size_t)l * 1024 * 2592, 1024, 2592, r / 41, r % 41, (bf16_t*)(p.ws + OFF_WTIN) + (size_t)l * NPAD_IN * 1024, NPAD_IN, 0, smem);
      else if (r < 912) { r -= 656; wt_tile(p, p.w_out + (size_t)l * 1024 * 1024, 1024, 1024, r / 16, r % 16, (bf16_t*)(p.ws + OFF_WTOUT) + (size_t)l * 1024 * 1024, 1024, 1, smem); }
      else if (r < 2320) { r -= 912; wt_tile(p, p.w_ffn_in + (size_t)l * 1024 * 5632, 1024, 5632, r / 88, r % 88, (bf16_t*)(p.ws + OFF_WTFI) + (size_t)l * 5632 * 1024, 5632, 2, smem); }
      else { r -= 2320; wt_tile(p, p.w_ffn_out + (size_t)l * FH * 1024, FH, 1024, r / 16, r % 16, (bf16_t*)(p.ws + OFF_WTFO) + (size_t)l * 1024 * FH, 1024, 1, smem); }
    } else if (it < 6050) {
      int l = it - 6048;
      for (int i = tid; i < 32 * 384; i += 256) {
        u32x4* d = (u32x4*)((bf16_t*)(p.ws + OFF_WTIN) + (size_t)l * NPAD_IN * 1024 + ((size_t)(i / 384) * NPAD_IN + 2592) * 32);
        d[i % 384] = (u32x4){0u, 0u, 0u, 0u};
      }
    } else if (it < 6434) {
      int r = it - 6050;
      mod_item(p, r / 192, r % 192, smem);
    } else {
      float* rc = (float*)(p.ws + OFF_ROPE);
      for (int i = tid; i < 1024; i += 256) {
        int pos = i >> 4, f = i & 15;
        float invf = powf(10000.f, -(float)f / 16.f);
        float ang = (float)pos * invf;
        rc[i] = cosf(ang);
        rc[1024 + i] = sinf(ang);
      }
    }
  }
}

DI void phase_prepB(const Params& p) {
  const float* MOD = (const float*)(p.ws + OFF_MOD);
  float* TAB = (float*)(p.ws + OFF_TAB);
  for (int i = blockIdx.x * 256 + tidx(p); i < 2 * 17 * 1024; i += gridDim.x * 256) {
    int k = i & 1023, b = (i >> 10) % 17, l = i / (17 * 1024);
    const float* m = MOD + ((size_t)l * 17 + b) * 6144;
    float sh1 = m[k], sc1 = m[1024 + k], sh2 = m[3072 + k], sc2 = m[4096 + k];
    float g0 = (l == 0) ? 1.f : p.ln2_g[k], b0 = (l == 0) ? 0.f : p.ln2_b[k];
    float* t = TAB + (size_t)l * 4 * 17 * 1024 + b * 1024 + k;
    t[0 * 17 * 1024] = g0 * (1.f + sc1);
    t[1 * 17 * 1024] = b0 * (1.f + sc1) + sh1;
    t[2 * 17 * 1024] = p.ln1_g[l * 1024 + k] * (1.f + sc2);
    t[3 * 17 * 1024] = p.ln1_b[l * 1024 + k] * (1.f + sc2) + sh2;
  }
}

DI void row_stats(const float* st, float& mu, float& rs) {
  const f32x4* s4 = (const f32x4*)st;
  f32x4 a = s4[0], b = s4[1], c = s4[2], d = s4[3];
  float S = a.x + a.z + b.x + b.z + c.x + c.z + d.x + d.z;
  float SS = a.y + a.w + b.y + b.w + c.y + c.w + d.y + d.w;
  mu = S * (1.f / 1024.f);
  float var = fmaxf(SS * (1.f / 1024.f) - mu * mu, 0.f);
  rs = rsqrtf(var + 1e-5f);
}

template <int MODE, int VAR = 0>
DI void gemm_tile(const Params& p, int l, int tm, int tn, char* smem) {
  constexpr int K = (MODE == 3) ? FH : 1024;
  constexpr int NK = K / 32;
  char* As = smem;
  char* Bs = smem + 16384;
  float* red = (float*)(smem + 73728);
  const int tid = tidx(p), lane = tid & 63, wid = tid >> 6, wr = wid >> 1, wc = wid & 1, fr = lane & 15, fq = lane >> 4;
  const int row0 = tm * 256;
  const bool lat = row0 < NLAT;
  const int bidx = lat ? row0 / NSEQ : 16;
  float* Y1 = (float*)(p.ws + OFF_Y1);
  float* CTXY2 = (float*)(p.ws + OFF_CTXY2);
  const float* ST1 = (const float*)(p.ws + OFF_ST1);
  const float* ST2 = (const float*)(p.ws + OFF_ST2);
  bf16_t* P = (bf16_t*)(p.ws + OFF_P);
  const float* MOD = (const float*)(p.ws + OFF_MOD) + ((size_t)l * 17 + bidx) * 6144;

  const bf16_t* absrc; int astride;
  if (MODE == 0) { absrc = (const bf16_t*)(p.ws + OFF_Y1) + (size_t)row0 * 32; astride = 32; }
  else if (MODE == 1) { absrc = P + (size_t)row0 * PC; astride = PC; }
  else if (MODE == 2) { absrc = (const bf16_t*)(p.ws + OFF_UF) + (size_t)row0 * 32; astride = 32; }
  else { absrc = P + (size_t)row0 * 32; astride = 32; }
  constexpr int NPADB = (MODE == 0) ? NPAD_IN : (MODE == 2 ? 5632 : 1024);
  const bf16_t* wt;
  if (MODE == 0) wt = (const bf16_t*)(p.ws + OFF_WTIN) + (size_t)l * NPAD_IN * 1024;
  else if (MODE == 1) wt = (const bf16_t*)(p.ws + OFF_WTOUT) + (size_t)l * 1024 * 1024;
  else if (MODE == 2) wt = (const bf16_t*)(p.ws + OFF_WTFI) + (size_t)l * 5632 * 1024;
  else wt = (const bf16_t*)(p.ws + OFF_WTFO) + (size_t)l * 1024 * FH;
  const int prow = lane >> 2, pch = (lane & 3) ^ ((-(prow >> 2)) & 3);
  const unsigned aoff = (unsigned)(((wid * 64 + prow) * astride + pch * 8) * 2);
  const unsigned apiece = (unsigned)(16 * astride * 2);
  const unsigned boff = (unsigned)(((tn * 128 + wid * 32 + prow) * 32 + pch * 8) * 2);
  const char* abase0 = (const char*)absrc;
  const char* bbase0 = (const char*)wt;
  char* adst_t = As + wid * 4096 + lane * 16;
  char* bdst_t = Bs + wid * 2048 + lane * 16;
  auto dma_a = [&](int kt, int buf, int i) __attribute__((always_inline)) {
    size_t kk;
    if (MODE == 1) { kk = kt * 64; if (kk >= 768) kk += 2560; }
    else kk = (size_t)kt * NROWS * 64;
    const char* ub = abase0 + kk;
    if (MODE == 1) __builtin_amdgcn_global_load_lds((const unsigned*)(ub + (aoff + (unsigned)i * apiece)), (unsigned*)(adst_t + buf * 24576 + i * 1024), 16, 0, 0);
    else {
      if (i == 0) __builtin_amdgcn_global_load_lds((const unsigned*)(ub + aoff), (unsigned*)(adst_t + buf * 24576), 16, 0, 0);
      else if (i == 1) __builtin_amdgcn_global_load_lds((const unsigned*)(ub + aoff), (unsigned*)(adst_t + buf * 24576), 16, 1024, 0);
      else if (i == 2) __builtin_amdgcn_global_load_lds((const unsigned*)(ub + aoff), (unsigned*)(adst_t + buf * 24576), 16, 2048, 0);
      else __builtin_amdgcn_global_load_lds((const unsigned*)(ub + aoff), (unsigned*)(adst_t + buf * 24576), 16, 3072, 0);
    }
  };
  auto dma_b = [&](int kt, int buf, int i) __attribute__((always_inline)) {
    const char* ub = bbase0 + (size_t)kt * NPADB * 64;
    if (i == 0) __builtin_amdgcn_global_load_lds((const unsigned*)(ub + boff), (unsigned*)(bdst_t + buf * 24576), 16, 0, 0);
    else __builtin_amdgcn_global_load_lds((const unsigned*)(ub + boff), (unsigned*)(bdst_t + buf * 24576), 16, 1024, 0);
  };
  auto dma = [&](int kt, int buf) __attribute__((always_inline)) {
#pragma unroll
    for (int i = 0; i < 4; ++i) dma_a(kt, buf, i);
#pragma unroll
    for (int i = 0; i < 2; ++i) dma_b(kt, buf, i);
  };
  const int fpos = (fq ^ ((-(fr >> 2)) & 3)) * 16;

  f32x4 acc[8][4];
#pragma unroll
  for (int m = 0; m < 8; ++m)
#pragma unroll
    for (int n = 0; n < 4; ++n) acc[m][n] = (f32x4){0.f, 0.f, 0.f, 0.f};

  __syncthreads();
  dma(0, 0);
  dma(1, 1);
  dma(2, 2);
  asm volatile("s_waitcnt vmcnt(12)" ::: "memory");
  __syncthreads();
  bf16x8 af[8], bfc[4], bfn[4];
  {
    const char* ab = As + (wr * 128 + fr) * 64 + fpos;
    const char* bb = Bs + (wc * 64 + fr) * 64 + fpos;
#pragma unroll
    for (int n = 0; n < 4; ++n) bfc[n] = *(const bf16x8*)(bb + n * 1024);
#pragma unroll
    for (int m = 0; m < 4; ++m) af[m] = *(const bf16x8*)(ab + m * 1024);
#pragma unroll
    for (int n = 0; n < 4; ++n) bfn[n] = bfc[n];
    __builtin_amdgcn_s_waitcnt(0xC07F);
  }
  int sc = 0;
#pragma unroll 1
  for (int kt = 0; kt < NK; ++kt) {
    const int sn = (sc == 2) ? 0 : sc + 1;
    {
      const char* ab = As + sc * 24576 + (wr * 128 + fr) * 64 + fpos;
#pragma unroll
      for (int m = 4; m < 8; ++m) af[m] = *(const bf16x8*)(ab + m * 1024);
    }
    __builtin_amdgcn_sched_barrier(0);
#pragma unroll
    for (int m = 0; m < 4; ++m)
#pragma unroll
      for (int n = 0; n < 4; ++n) { if (VAR != 2 && VAR != 3) acc[m][n] = mfma16(bfc[n], af[m], acc[m][n]); else asm volatile("" :: "v"(bfc[n]), "v"(af[m])); }
    __builtin_amdgcn_sched_barrier(0);
    if (kt + 2 < NK) asm volatile("s_waitcnt vmcnt(6) lgkmcnt(0)" ::: "memory");
    else asm volatile("s_waitcnt vmcnt(0) lgkmcnt(0)" ::: "memory");
    __syncthreads();
#pragma unroll
    for (int m = 4; m < 8; ++m)
#pragma unroll
      for (int n = 0; n < 4; ++n) { if (VAR != 2 && VAR != 3) acc[m][n] = mfma16(bfc[n], af[m], acc[m][n]); else asm volatile("" :: "v"(bfc[n]), "v"(af[m])); }
    __builtin_amdgcn_sched_barrier(0);
    if (kt + 1 < NK) {
      const char* ab = As + sn * 24576 + (wr * 128 + fr) * 64 + fpos;
      const char* bb = Bs + sn * 24576 + (wc * 64 + fr) * 64 + fpos;
#pragma unroll
      for (int n = 0; n < 4; ++n) bfn[n] = *(const bf16x8*)(bb + n * 1024);
#pragma unroll
      for (int m = 0; m < 4; ++m) af[m] = *(const bf16x8*)(ab + m * 1024);
    }
    __builtin_amdgcn_sched_barrier(0);
    if (VAR != 1 && VAR != 3 && kt + 3 < NK) dma(kt + 3, sc);
    __builtin_amdgcn_sched_barrier(0);
#pragma unroll
    for (int n = 0; n < 4; ++n) bfc[n] = bfn[n];
    sc = sn;
    __builtin_amdgcn_s_waitcnt(0xC07F);
  }
  int fr_e = fr;
  asm volatile("" : "+v"(fr_e));
  if (MODE == 0) {
    const int hs = tn * 2 + wc;
    if (hs > 40) return;
    const bool isq = (hs >= 30 && hs < 36), isk = (hs == 36 || hs == 37);
    if (isq || isk) {
      const float* nw = (isq ? p.qnorm_w : p.knorm_w) + l * 64;
      const float* rc = (const float*)(p.ws + OFF_ROPE);
      float w_[4][4];
#pragma unroll
      for (int n = 0; n < 4; ++n)
#pragma unroll
        for (int j = 0; j < 4; ++j) w_[n][j] = nw[n * 16 + fq * 4 + j];
#pragma unroll
      for (int m = 0; m < 8; ++m) {
        float ss = 0.f;
#pragma unroll
        for (int n = 0; n < 4; ++n)
#pragma unroll
          for (int j = 0; j < 4; ++j) ss += acc[m][n][j] * acc[m][n][j];
        ss += shx(ss, 16); ss += shx(ss, 32);
        float inv = rsqrtf(ss * (1.f / 64.f) + 1e-6f);
#pragma unroll
        for (int n = 0; n < 4; ++n)
#pragma unroll
          for (int j = 0; j < 4; ++j) acc[m][n][j] *= inv * w_[n][j];
        if (lat) {
          int t = (row0 + wr * 128 + m * 16 + fr_e) & (NSEQ - 1);
          int gr = t >> 6, gc = t & 63;
#pragma unroll
          for (int j = 0; j < 4; ++j) {
            float cr = rc[gr * 16 + fq * 4 + j], sr = rc[1024 + gr * 16 + fq * 4 + j];
            float cc = rc[gc * 16 + fq * 4 + j], sn = rc[1024 + gc * 16 + fq * 4 + j];
            float x1 = acc[m][0][j], x2 = acc[m][1][j], x3 = acc[m][2][j], x4 = acc[m][3][j];
            acc[m][0][j] = x1 * cr - x2 * sr; acc[m][1][j] = x2 * cr + x1 * sr;
            acc[m][2][j] = x3 * cc - x4 * sn; acc[m][3][j] = x4 * cc + x3 * sn;
          }
        }
      }
    }
    float scl = 1.f;
    if (hs < 6 || isq) scl = QSCALE;
    else if (hs == 18 || hs == 19) scl = 0.17677669529663687f;
    const int nmax = (hs == 40) ? 2 : 4;
#pragma unroll
    for (int m = 0; m < 8; ++m) {
      bf16_t* pr = P + (size_t)(row0 + wr * 128 + m * 16 + fr_e) * PC + hs * 64 + fq * 4;
#pragma unroll
      for (int n = 0; n < 4; ++n) {
        if (n < nmax) {
          u32x2 u; u.x = pack2(acc[m][n][0] * scl, acc[m][n][1] * scl); u.y = pack2(acc[m][n][2] * scl, acc[m][n][3] * scl);
          *(u32x2*)(pr + n * 16) = u;
        }
      }
    }
  } else if (MODE == 2) {
    bf16_t* H = P;
#pragma unroll
    for (int m = 0; m < 8; ++m) {
      bf16_t* hr = H + ((size_t)(tn * 2 + wc) * NROWS + row0 + wr * 128 + m * 16 + fr_e) * 32 + fq * 4;
#pragma unroll
      for (int n = 0; n < 2; ++n) {
        float h0 = siluf(acc[m][n][0]) * acc[m][n + 2][0], h1 = siluf(acc[m][n][1]) * acc[m][n + 2][1];
        float h2 = siluf(acc[m][n][2]) * acc[m][n + 2][2], h3 = siluf(acc[m][n][3]) * acc[m][n + 2][3];
        u32x2 u; u.x = pack2(h0, h1); u.y = pack2(h2, h3);
        *(u32x2*)(hr + n * 16) = u;
      }
    }
  } else {
    const float* gate = MOD + (MODE == 1 ? 2048 : 5120) + tn * 128 + wc * 64 + fq * 4;
    const float* lng = nullptr; const float* lnb = nullptr; const float* xs; const float* st = nullptr;
    float* dst; float* stout;
    bool doln;
    if (MODE == 1) {
      doln = (l == 1);
      if (l == 0) xs = lat ? p.x + (size_t)row0 * 1024 : p.ctx + (size_t)(row0 - NLAT) * 1024;
      else { xs = p.out + (size_t)row0 * 1024; st = ST2 + (size_t)row0 * 16; lng = p.ln2_g; lnb = p.ln2_b; }
      dst = Y1 + (size_t)row0 * 1024;
      stout = (float*)(p.ws + OFF_ST1) + (size_t)row0 * 16;
    } else {
      doln = true;
      xs = Y1 + (size_t)row0 * 1024; st = ST1 + (size_t)row0 * 16; lng = p.ln1_g + l * 1024; lnb = p.ln1_b + l * 1024;
      dst = lat ? p.out + (size_t)row0 * 1024 : CTXY2 + (size_t)(row0 - NLAT) * 1024;
      stout = (float*)(p.ws + OFF_ST2) + (size_t)row0 * 16;
    }
    const int cb = tn * 128 + wc * 64 + fq * 4;
    float* rst = red + 1024;
    if (doln) { float m_, r_; row_stats(st + (size_t)tid * 16, m_, r_); rst[tid * 2] = m_; rst[tid * 2 + 1] = r_; }
    __syncthreads();
#pragma unroll
    for (int m = 0; m < 8; ++m) {
      const int rl = wr * 128 + m * 16 + fr_e;
      float rmu = 0.f, rrs = 1.f;
      if (doln) { rmu = rst[rl * 2]; rrs = rst[rl * 2 + 1]; }
      float s_ = 0.f, ss = 0.f;
      const float* xr = xs + (size_t)rl * 1024 + cb;
      float* dr = dst + (size_t)rl * 1024 + cb;
#pragma unroll
      for (int n = 0; n < 4; ++n) {
        const f32x4 gv = *(const f32x4*)(gate + n * 16);
        f32x4 xv = *(const f32x4*)(xr + n * 16);
        if (doln) {
          const f32x4 lg = *(const f32x4*)(lng + cb + n * 16), lb = *(const f32x4*)(lnb + cb + n * 16);
          xv.x = (xv.x - rmu) * rrs * lg.x + lb.x; xv.y = (xv.y - rmu) * rrs * lg.y + lb.y;
          xv.z = (xv.z - rmu) * rrs * lg.z + lb.z; xv.w = (xv.w - rmu) * rrs * lg.w + lb.w;
        }
        f32x4 o;
        o.x = ALPHA * xv.x + gv.x * acc[m][n][0]; o.y = ALPHA * xv.y + gv.y * acc[m][n][1];
        o.z = ALPHA * xv.z + gv.z * acc[m][n][2]; o.w = ALPHA * xv.w + gv.w * acc[m][n][3];
        *(f32x4*)(dr + n * 16) = o;
        s_ += o.x + o.y + o.z + o.w;
        ss += o.x * o.x + o.y * o.y + o.z * o.z + o.w * o.w;
      }
      s_ += shx(s_, 16); s_ += shx(s_, 32);
      ss += shx(ss, 16); ss += shx(ss, 32);
      if (fq == 0) { red[((wr * 2 + wc) * 128 + m * 16 + fr_e) * 2] = s_; red[((wr * 2 + wc) * 128 + m * 16 + fr_e) * 2 + 1] = ss; }
      if (m & 1) __builtin_amdgcn_sched_barrier(0);
    }
    __syncthreads();
    {
      int r = tid, w_ = r >> 7, rr = r & 127;
      float s = red[((w_ * 2 + 0) * 128 + rr) * 2] + red[((w_ * 2 + 1) * 128 + rr) * 2];
      float ss = red[((w_ * 2 + 0) * 128 + rr) * 2 + 1] + red[((w_ * 2 + 1) * 128 + rr) * 2 + 1];
      *(f32x2*)(stout + (size_t)r * 16 + tn * 2) = (f32x2){s, ss};
    }
  }
}

template <int MODE, int VAR = 0>
DI void phase_gemm(const Params& p, int l, char* smem) {
  const int NT = (MODE == 0) ? 21 : (MODE == 2 ? 44 : 8);
  const int MT = (l == 0 || MODE == 0) ? 144 : 128;
  const int vb = (blockIdx.x & 7) * (gridDim.x >> 3) + (blockIdx.x >> 3);
  for (int t = vb; t < MT * NT; t += gridDim.x) {
    const int g = t / (8 * NT), r = t - g * 8 * NT;
    gemm_tile<MODE, VAR>(p, l, g * 8 + (r & 7), r >> 3, smem);
  }
}

typedef __attribute__((address_space(3))) s16x4 lds_s16x4;
template <int NH>
DI void attn_item(const Params& p, int qrow0, int qcol, int kcol, int vcol, int lat_row0, int nb_lat, int ctx_row0, int nb_ctx,
                  bool na, int dr0, const float* rpb_h, char* smem, bool dry = false) {
  char* KV = smem;
  float* rpbs = (float*)(smem + 3 * 16384);
  const int tid = tidx(p), lane = tid & 63, w = tid >> 6, fr = lane & 15, fq = lane >> 4;
  bf16_t* P = (bf16_t*)(p.ws + OFF_P);
  __syncthreads();
  if (na) for (int i = tid; i < 465; i += 256) rpbs[i] = rpb_h[i] * LOG2E;
  bf16x8 qf[NH][2];
  f32x4 o[NH][4], lsum[NH];
  float mrun[NH];
  const bf16x8 ones = (bf16x8){0x3F80, 0x3F80, 0x3F80, 0x3F80, 0x3F80, 0x3F80, 0x3F80, 0x3F80};
#pragma unroll
  for (int hh = 0; hh < NH; ++hh) {
    const bf16_t* qp = P + (size_t)(qrow0 + w * 16 + fr) * PC + qcol + hh * 64 + fq * 8;
    qf[hh][0] = *(const bf16x8*)qp; qf[hh][1] = *(const bf16x8*)(qp + 32);
#pragma unroll
    for (int i = 0; i < 4; ++i) o[hh][i] = (f32x4){0.f, 0.f, 0.f, 0.f};
    mrun[hh] = -1e30f; lsum[hh] = (f32x4){0.f, 0.f, 0.f, 0.f};
  }
  const int nb = nb_lat + nb_ctx;
  const unsigned goff = (unsigned)(((w * 16 + (lane >> 3)) * PC + (((lane & 7) ^ (lane >> 3)) * 8)) * 2);
  char* dstk = KV + w * 2048 + lane * 16;
  auto dma = [&](int kb, int st) __attribute__((always_inline)) {
    const int rb = kb < nb_lat ? lat_row0 + kb * 64 : ctx_row0 + (kb - nb_lat) * 64;
    const char* ub = (const char*)(P + (size_t)rb * PC);
#pragma unroll
    for (int i = 0; i < 2; ++i) {
      __builtin_amdgcn_global_load_lds((const unsigned*)(ub + kcol * 2 + (goff + (unsigned)(i * 8 * PC * 2))), (unsigned*)(dstk + st * 16384 + i * 1024), 16, 0, 0);
      __builtin_amdgcn_global_load_lds((const unsigned*)(ub + vcol * 2 + (goff + (unsigned)(i * 8 * PC * 2))), (unsigned*)(dstk + st * 16384 + 8192 + i * 1024), 16, 0, 0);
    }
  };
  const int qj = w * 16 + fr;
  const int cs = min(max(qj - 8, 0), 48);
  const int koff = fr * 128;
  const int kx0 = ((fq) ^ (fr & 7)) * 16, kx1 = ((4 + fq) ^ (fr & 7)) * 16;
  const int vr7 = ((fq & 1) * 4 + (fr >> 2));
  const int voff = (fq * 4 + (fr >> 2)) * 128 + (fr & 1) * 8;
  dma(0, 0);
  if (nb > 1) dma(1, 1);
  if (nb > 1) asm volatile("s_waitcnt vmcnt(4)" ::: "memory"); else asm volatile("s_waitcnt vmcnt(0)" ::: "memory");
  __syncthreads();
  int sc = 0;
  for (int kb = 0; kb < nb; ++kb) {
    const char* Kb = KV + sc * 16384;
    const char* Vb = Kb + 8192;
    const int sn2 = (sc == 0) ? 2 : sc - 1;
    if (kb + 2 < nb) dma(kb + 2, sn2);
    const bool msk = na && kb < nb_lat;
    int mt_lo = 0, mt_hi = 3;
    if (msk) { mt_lo = (w >= 2) ? w - 1 : 0; mt_hi = (w <= 1) ? w + 1 : 3; }
    bf16x8 kf[4][2];
#pragma unroll
    for (int mt = 0; mt < 4; ++mt)
      if (mt >= mt_lo && mt <= mt_hi) {
        kf[mt][0] = *(const bf16x8*)(Kb + koff + mt * 2048 + kx0);
        kf[mt][1] = *(const bf16x8*)(Kb + koff + mt * 2048 + kx1);
      }
    bf16x8 pf[NH][2];
    f32x4 s[NH][4];
#pragma unroll
    for (int hh = 0; hh < NH; ++hh)
#pragma unroll
      for (int mt = 0; mt < 4; ++mt) {
        if (mt >= mt_lo && mt <= mt_hi) {
          s[hh][mt] = mfma16(kf[mt][0], qf[hh][0], (f32x4){0.f, 0.f, 0.f, 0.f});
          s[hh][mt] = mfma16(kf[mt][1], qf[hh][1], s[hh][mt]);
        } else s[hh][mt] = (f32x4){-1e30f, -1e30f, -1e30f, -1e30f};
      }
    if (msk) {
#pragma unroll
      for (int hh = 0; hh < NH; ++hh)
#pragma unroll
        for (int mt = 0; mt < 4; ++mt)
          if (mt >= mt_lo && mt <= mt_hi) {
#pragma unroll
            for (int j = 0; j < 4; ++j) {
              int kc = mt * 16 + fq * 4 + j;
              bool valid = (kc >= cs) && (kc < cs + 16);
              int bi = min(max(kc - qj, -15), 15);
              s[hh][mt][j] = valid ? s[hh][mt][j] + rpbs[(dr0 + kb) * 31 + bi + 15] : -1e30f;
            }
          }
    }
#pragma unroll
    for (int hh = 0; hh < NH; ++hh) {
      float mx = fmaxf(fmaxf(fmaxf(s[hh][0][0], s[hh][0][1]), fmaxf(s[hh][0][2], s[hh][0][3])), fmaxf(fmaxf(s[hh][1][0], s[hh][1][1]), fmaxf(s[hh][1][2], s[hh][1][3])));
      mx = fmaxf(mx, fmaxf(fmaxf(fmaxf(s[hh][2][0], s[hh][2][1]), fmaxf(s[hh][2][2], s[hh][2][3])), fmaxf(fmaxf(s[hh][3][0], s[hh][3][1]), fmaxf(s[hh][3][2], s[hh][3][3]))));
      mx = fmaxf(mx, shx(mx, 16)); mx = fmaxf(mx, shx(mx, 32));
      const float mnew = fmaxf(mrun[hh], mx);
      const float alpha = __builtin_amdgcn_exp2f(mrun[hh] - mnew);
      mrun[hh] = mnew;
      const f32x4 av = (f32x4){alpha, alpha, alpha, alpha}, mv = (f32x4){mnew, mnew, mnew, mnew};
      lsum[hh] = lsum[hh] * av;
#pragma unroll
      for (int i = 0; i < 4; ++i) o[hh][i] = o[hh][i] * av;
#pragma unroll
      for (int mt = 0; mt < 4; ++mt) {
        f32x4 d = s[hh][mt] - mv;
        d[0] = __builtin_amdgcn_exp2f(d[0]); d[1] = __builtin_amdgcn_exp2f(d[1]); d[2] = __builtin_amdgcn_exp2f(d[2]); d[3] = __builtin_amdgcn_exp2f(d[3]);
        s[hh][mt] = d;
      }
#pragma unroll
      for (int kp = 0; kp < 2; ++kp) {
        u32x4 pk;
        pk.x = pack2(s[hh][2 * kp][0], s[hh][2 * kp][1]); pk.y = pack2(s[hh][2 * kp][2], s[hh][2 * kp][3]);
        pk.z = pack2(s[hh][2 * kp + 1][0], s[hh][2 * kp + 1][1]); pk.w = pack2(s[hh][2 * kp + 1][2], s[hh][2 * kp + 1][3]);
        pf[hh][kp] = __builtin_bit_cast(bf16x8, pk);
      }
    }
#pragma unroll
    for (int kp = 0; kp < 2; ++kp) {
      if ((kp == 0 && mt_lo <= 1) || (kp == 1 && mt_hi >= 2)) {
#pragma unroll
        for (int hh = 0; hh < NH; ++hh) lsum[hh] = mfma16(ones, pf[hh][kp], lsum[hh]);
        s16x4 vl[4], vh[4];
        {
          const unsigned a0 = (unsigned)(size_t)(Vb + voff + kp * 4096 + (((0 + ((fr & 3) >> 1)) ^ vr7) * 16));
          const unsigned a1 = (unsigned)(size_t)(Vb + voff + kp * 4096 + (((2 + ((fr & 3) >> 1)) ^ vr7) * 16));
          const unsigned a2 = (unsigned)(size_t)(Vb + voff + kp * 4096 + (((4 + ((fr & 3) >> 1)) ^ vr7) * 16));
          const unsigned a3 = (unsigned)(size_t)(Vb + voff + kp * 4096 + (((6 + ((fr & 3) >> 1)) ^ vr7) * 16));
          asm volatile(
              "ds_read_b64_tr_b16 %0, %8\n\tds_read_b64_tr_b16 %1, %8 offset:2048\n\t"
              "ds_read_b64_tr_b16 %2, %9\n\tds_read_b64_tr_b16 %3, %9 offset:2048\n\t"
              "ds_read_b64_tr_b16 %4, %10\n\tds_read_b64_tr_b16 %5, %10 offset:2048\n\t"
              "ds_read_b64_tr_b16 %6, %11\n\tds_read_b64_tr_b16 %7, %11 offset:2048\n\t"
              "s_waitcnt lgkmcnt(0)"
              : "=&v"(vl[0]), "=&v"(vh[0]), "=&v"(vl[1]), "=&v"(vh[1]), "=&v"(vl[2]), "=&v"(vh[2]), "=&v"(vl[3]), "=&v"(vh[3])
              : "v"(a0), "v"(a1), "v"(a2), "v"(a3)
              : "memory");
        }
#pragma unroll
        for (int dt = 0; dt < 4; ++dt) {
          bf16x8 vf = __builtin_shufflevector(vl[dt], vh[dt], 0, 1, 2, 3, 4, 5, 6, 7);
#pragma unroll
          for (int hh = 0; hh < NH; ++hh) o[hh][dt] = mfma16(vf, pf[hh][kp], o[hh][dt]);
        }
      }
    }
    if (kb + 2 < nb) asm volatile("s_waitcnt vmcnt(4) lgkmcnt(0)" ::: "memory");
    else asm volatile("s_waitcnt vmcnt(0) lgkmcnt(0)" ::: "memory");
    __builtin_amdgcn_s_barrier();
    asm volatile("" ::: "memory");
    sc = (sc == 2) ? 0 : sc + 1;
  }
#pragma unroll
  for (int hh = 0; hh < NH; ++hh) {
    const float inv = 1.f / lsum[hh][0];
    bf16_t* op = dry ? (bf16_t*)(p.ws + OFF_Y1) + (size_t)((qrow0 + w * 16 + fr) & 16383) * PC + qcol + hh * 64 + fq * 4
                     : P + (size_t)(qrow0 + w * 16 + fr) * PC + qcol + hh * 64 + fq * 4;
#pragma unroll
    for (int dt = 0; dt < 4; ++dt) {
      u32x2 u; u.x = pack2(o[hh][dt][0] * inv, o[hh][dt][1] * inv); u.y = pack2(o[hh][dt][2] * inv, o[hh][dt][3] * inv);
      *(u32x2*)(op + dt * 16) = u;
    }
  }
}

DI float logsig(float z) { return fminf(z, 0.f) - __logf(1.f + __expf(-fabsf(z))); }
DI int chunk_row0(int b, int cidx) { return cidx < 4 ? NLAT + b * LC + cidx * 64 : b * NSEQ + (cidx - 4) * 64; }
DI int chain_pos(int cidx, int dir) { return dir == 0 ? cidx : (cidx < 4 ? 3 - cidx : 39 - cidx); }

DI void gla_gates(const Params& p, int l, int h, int dir, int row0, float* bs, float* lrs, float* was, float* segt) {
  const int tid = tidx(p);
  const bf16_t* P = (const bf16_t*)(p.ws + OFF_P);
  {
    int s = tid >> 2, r4 = (tid & 3) * 4;
    u32x2 u = *(const u32x2*)(P + (size_t)(row0 + s) * PC + C_GLR + dir * 16 + r4);
    lrs[s * 17 + r4] = bflo(u.x); lrs[s * 17 + r4 + 1] = bfhi(u.x); lrs[s * 17 + r4 + 2] = bflo(u.y); lrs[s * 17 + r4 + 3] = bfhi(u.y);
    for (int i = tid; i < 512; i += 256) was[i] = p.gla_wa2[(((size_t)l * 2 + dir) * 16 + (i >> 5)) * 128 + h * 32 + (i & 31)];
  }
  __syncthreads();
  const int d = tid & 31, sg = tid >> 5;
  const float ba = p.gla_ba[(l * 2 + dir) * 128 + h * 32 + d];
  float la[8];
#pragma unroll
  for (int i = 0; i < 8; ++i) {
    int s = sg * 8 + i;
    float z = ba;
#pragma unroll
    for (int r = 0; r < 16; ++r) z += lrs[s * 17 + r] * was[r * 32 + d];
    la[i] = logsig(z) * (1.f / 16.f);
  }
  if (dir == 0) {
#pragma unroll
    for (int i = 1; i < 8; ++i) la[i] += la[i - 1];
    segt[sg * 32 + d] = la[7];
  } else {
#pragma unroll
    for (int i = 6; i >= 0; --i) la[i] += la[i + 1];
    segt[sg * 32 + d] = la[0];
  }
  __syncthreads();
  float pre = 0.f;
#pragma unroll
  for (int g = 0; g < 8; ++g) {
    float v = segt[g * 32 + d];
    if (dir == 0 ? (g < sg) : (g > sg)) pre += v;
  }
#pragma unroll
  for (int i = 0; i < 8; ++i) bs[(sg * 8 + i) * 33 + d] = la[i] + pre;
  __syncthreads();
}

DI void gla_passA(const Params& p, int l, int item, char* smem) {
  float* bs = (float*)smem;
  float* kw = bs + 64 * 33;
  float* vs = kw + 64 * 32;
  float* lrs = vs + 64 * 64;
  float* was = lrs + 64 * 17;
  float* segt = was + 512;
  const int tid = tidx(p);
  int dir = item & 1, cidx = (item >> 1) % 36, bh = item / 72, h = bh & 3, b = bh >> 2;
  const int row0 = chunk_row0(b, cidx);
  const bf16_t* P = (const bf16_t*)(p.ws + OFF_P);
  __syncthreads();
  gla_gates(p, l, h, dir, row0, bs, lrs, was, segt);
  {
    int s = tid >> 2, d8 = (tid & 3) * 8;
    u32x4 u = *(const u32x4*)(P + (size_t)(row0 + s) * PC + C_GLK + h * 32 + d8);
    unsigned uu[4] = {u.x, u.y, u.z, u.w};
    const int slast = dir == 0 ? 63 : 0;
#pragma unroll
    for (int e = 0; e < 4; ++e) {
      int d0 = d8 + 2 * e;
      kw[s * 32 + d0] = bflo(uu[e]) * __expf(bs[slast * 33 + d0] - bs[s * 33 + d0]);
      kw[s * 32 + d0 + 1] = bfhi(uu[e]) * __expf(bs[slast * 33 + d0 + 1] - bs[s * 33 + d0 + 1]);
    }
    int v16 = (tid & 3) * 16;
#pragma unroll
    for (int q = 0; q < 2; ++q) {
      u32x4 w = *(const u32x4*)(P + (size_t)(row0 + s) * PC + C_GLV + h * 64 + v16 + q * 8);
      unsigned ww[4] = {w.x, w.y, w.z, w.w};
#pragma unroll
      for (int e = 0; e < 4; ++e) { vs[s * 64 + v16 + q * 8 + 2 * e] = bflo(ww[e]); vs[s * 64 + v16 + q * 8 + 2 * e + 1] = bfhi(ww[e]); }
    }
  }
  __syncthreads();
  const int v = tid & 63, dg = (tid >> 6) * 8;
  float acc[8];
#pragma unroll
  for (int i = 0; i < 8; ++i) acc[i] = 0.f;
  for (int s = 0; s < 64; ++s) {
    float vv = vs[s * 64 + v];
    f32x4 k0 = *(const f32x4*)(kw + s * 32 + dg), k1 = *(const f32x4*)(kw + s * 32 + dg + 4);
    acc[0] += k0.x * vv; acc[1] += k0.y * vv; acc[2] += k0.z * vv; acc[3] += k0.w * vv;
    acc[4] += k1.x * vv; acc[5] += k1.y * vv; acc[6] += k1.z * vv; acc[7] += k1.w * vv;
  }
  const int pos = chain_pos(cidx, dir);
  float* LS = (float*)(p.ws + OFF_LS) + ((size_t)((b * 4 + h) * 2 + dir) * 36 + pos) * 2048;
#pragma unroll
  for (int i = 0; i < 8; ++i) LS[(dg + i) * 64 + v] = acc[i];
  if (tid < 32) {
    float* BL = (float*)(p.ws + OFF_BL) + ((size_t)((b * 4 + h) * 2 + dir) * 36 + pos) * 32;
    BL[tid] = bs[(dir == 0 ? 63 : 0) * 33 + tid];
  }
}

DI void gla_scan(const Params& p, int item) {
  const int tid = tidx(p);
  const int chain = item >> 3, e = (item & 7) * 256 + tid, d = e >> 6;
  float* LS = (float*)(p.ws + OFF_LS) + (size_t)chain * 36 * 2048 + e;
  const float* BL = (const float*)(p.ws + OFF_BL) + (size_t)chain * 36 * 32 + d;
  float S = 0.f;
#pragma unroll 6
  for (int pos = 0; pos < 36; ++pos) {
    float x = LS[(size_t)pos * 2048], bl = BL[pos * 32];
    LS[(size_t)pos * 2048] = S;
    S = __expf(bl) * S + x;
  }
}

DI void gla_passB(const Params& p, int l, int b, int h, int cidx, char* smem, bool dry = false) {
  float* bs = (float*)smem;
  bf16_t* Qe = (bf16_t*)(bs + 64 * 33);
  bf16_t* Ke = Qe + 64 * 40;
  bf16_t* Vs = Ke + 64 * 40;
  bf16_t* S0 = Vs + 64 * 72;
  float* lrs = (float*)(S0 + 32 * 72);
  float* was = lrs + 64 * 17;
  float* segt = was + 512;
  const int tid = tidx(p), lane = tid & 63, w = tid >> 6, fr = lane & 15, fq = lane >> 4;
  const int row0 = chunk_row0(b, cidx);
  bf16_t* P = (bf16_t*)(p.ws + OFF_P);
  f32x4 o[4];
#pragma unroll
  for (int i = 0; i < 4; ++i) o[i] = (f32x4){0.f, 0.f, 0.f, 0.f};
  __syncthreads();
  {
    int s = tid >> 2, v16 = (tid & 3) * 16;
    const bf16_t* vp = P + (size_t)(row0 + s) * PC + C_GLV + h * 64 + v16;
    *(u32x4*)(Vs + s * 72 + v16) = *(const u32x4*)vp;
    *(u32x4*)(Vs + s * 72 + v16 + 8) = *(const u32x4*)(vp + 8);
  }
  for (int dir = 0; dir < 2; ++dir) {
    gla_gates(p, l, h, dir, row0, bs, lrs, was, segt);
    {
      int s = tid >> 2, d8 = (tid & 3) * 8;
      u32x4 uq = *(const u32x4*)(P + (size_t)(row0 + s) * PC + C_GLQ + h * 32 + d8);
      u32x4 uk = *(const u32x4*)(P + (size_t)(row0 + s) * PC + C_GLK + h * 32 + d8);
      u32x4 oq, ok;
#pragma unroll
      for (int e = 0; e < 4; ++e) {
        int d0 = d8 + 2 * e;
        float b0 = bs[s * 33 + d0], b1 = bs[s * 33 + d0 + 1];
        oq[e] = pack2(bflo(uq[e]) * __expf(b0), bfhi(uq[e]) * __expf(b1));
        ok[e] = pack2(bflo(uk[e]) * __expf(-b0), bfhi(uk[e]) * __expf(-b1));
      }
      *(u32x4*)(Qe + s * 40 + d8) = oq;
      *(u32x4*)(Ke + s * 40 + d8) = ok;
      const int pos = chain_pos(cidx, dir);
      const float* LS = (const float*)(p.ws + OFF_LS) + ((size_t)((b * 4 + h) * 2 + dir) * 36 + pos) * 2048;
      int d = tid >> 3, v8 = (tid & 7) * 8;
      f32x4 s0 = *(const f32x4*)(LS + d * 64 + v8), s1 = *(const f32x4*)(LS + d * 64 + v8 + 4);
      u32x4 os;
      os.x = pack2(s0.x, s0.y); os.y = pack2(s0.z, s0.w); os.z = pack2(s1.x, s1.y); os.w = pack2(s1.z, s1.w);
      *(u32x4*)(S0 + d * 72 + v8) = os;
    }
    __syncthreads();
    {
      const bf16x8 qf = *(const bf16x8*)(Qe + (w * 16 + fr) * 40 + fq * 8);
      f32x4 at[4];
#pragma unroll
      for (int mt = 0; mt < 4; ++mt) {
        const bool need = dir == 0 ? (mt <= w) : (mt >= w);
        if (need) {
          const bf16x8 kf = *(const bf16x8*)(Ke + (mt * 16 + fr) * 40 + fq * 8);
          at[mt] = mfma16(kf, qf, (f32x4){0.f, 0.f, 0.f, 0.f});
          if (mt == w) {
#pragma unroll
            for (int j = 0; j < 4; ++j) {
              const int sI = fq * 4 + j;
              const bool keep = dir == 0 ? (sI <= fr) : (sI >= fr);
              at[mt][j] = keep ? at[mt][j] : 0.f;
            }
          }
        } else at[mt] = (f32x4){0.f, 0.f, 0.f, 0.f};
      }
#pragma unroll
      for (int kp = 0; kp < 2; ++kp) {
        const bool needp = dir == 0 ? (2 * kp <= w) : (2 * kp + 1 >= w);
        if (needp) {
          u32x4 pk;
          pk.x = pack2(at[2 * kp][0], at[2 * kp][1]); pk.y = pack2(at[2 * kp][2], at[2 * kp][3]);
          pk.z = pack2(at[2 * kp + 1][0], at[2 * kp + 1][1]); pk.w = pack2(at[2 * kp + 1][2], at[2 * kp + 1][3]);
          const bf16x8 pf = __builtin_bit_cast(bf16x8, pk);
#pragma unroll
          for (int dt = 0; dt < 4; ++dt) {
            const bf16_t* vp = Vs + (kp * 32 + fq * 4 + (fr >> 2)) * 72 + dt * 16 + (fr & 3) * 4;
            s16x4 lo = __builtin_amdgcn_ds_read_tr16_b64_v4i16((lds_s16x4*)vp);
            s16x4 hi = __builtin_amdgcn_ds_read_tr16_b64_v4i16((lds_s16x4*)(vp + 16 * 72));
            bf16x8 vf = __builtin_shufflevector(lo, hi, 0, 1, 2, 3, 4, 5, 6, 7);
            o[dt] = mfma16(vf, pf, o[dt]);
          }
        }
      }
#pragma unroll
      for (int dt = 0; dt < 4; ++dt) {
        const bf16_t* sp = S0 + (fq * 8 + (fr >> 2)) * 72 + dt * 16 + (fr & 3) * 4;
        s16x4 lo = __builtin_amdgcn_ds_read_tr16_b64_v4i16((lds_s16x4*)sp);
        s16x4 hi = __builtin_amdgcn_ds_read_tr16_b64_v4i16((lds_s16x4*)(sp + 4 * 72));
        bf16x8 sf = __builtin_shufflevector(lo, hi, 0, 1, 2, 3, 4, 5, 6, 7);
        o[dt] = mfma16(sf, qf, o[dt]);
      }
    }
    __syncthreads();
  }
  float ss = 0.f;
#pragma unroll
  for (int dt = 0; dt < 4; ++dt) ss += o[dt][0] * o[dt][0] + o[dt][1] * o[dt][1] + o[dt][2] * o[dt][2] + o[dt][3] * o[dt][3];
  ss += shx(ss, 16); ss += shx(ss, 32);
  const float inv = rsqrtf(ss * (1.f / 64.f) + 1e-6f);
#pragma unroll
  for (int dt = 0; dt < 4; ++dt) {
    const f32x4 nw = *(const f32x4*)(p.gla_norm_w + l * 64 + dt * 16 + fq * 4);
    bf16_t* gp = P + (size_t)(row0 + w * 16 + fr) * PC + C_GLG + h * 64 + dt * 16 + fq * 4;
    u32x2 g = *(const u32x2*)gp;
    u32x2 u;
    u.x = pack2(o[dt][0] * inv * nw.x * siluf(bflo(g.x)), o[dt][1] * inv * nw.y * siluf(bfhi(g.x)));
    u.y = pack2(o[dt][2] * inv * nw.z * siluf(bflo(g.y)), o[dt][3] * inv * nw.w * siluf(bfhi(g.y)));
    if (dry) gp = (bf16_t*)(p.ws + OFF_Y1) + (size_t)((row0 + w * 16 + fr) & 16383) * PC + C_GLG + h * 64 + dt * 16 + fq * 4;
    *(u32x2*)gp = u;
  }
}

DI void phase_mixA(const Params& p, int l, char* smem, bool dry = false, int only = 3) {
  const int NGQA = NB * 2 * 32, NGLA = NB * 4 * 36 * 2;
  for (int it = blockIdx.x; it < NGQA + NGLA; it += gridDim.x) {
    if (it < NGQA) {
      if (!(only & 1)) continue;
      int b = it >> 6, rem = it & 63, g = rem >> 5, qt = rem & 31;
      attn_item<3>(p, b * NSEQ + qt * 64, C_GAQ + g * 192, C_GAK + g * 64, C_GAV + g * 64, b * NSEQ, 32, NLAT + b * LC, 4, false, 0, nullptr, smem, dry);
    } else if (only & 2) gla_passA(p, l, it - NGQA, smem);
  }
}
DI void phase_mixS(const Params& p, int l, char* smem, bool dry = false) {
  const int NSC = NB * 4 * 2 * 8, NNA = NB * 6 * 32, NCG = (l == 0) ? NB * 2 * 4 : 0, NCN = (l == 0) ? NB * 6 * 4 : 0;
  for (int it = blockIdx.x; it < NSC + NNA + NCG + NCN; it += gridDim.x) {
    if (it < NSC) {
      if (!dry) gla_scan(p, it);
    } else if (it < NSC + NNA) {
      int i = it - NSC, b = i / 192, rem = i % 192, h = rem >> 5, r = rem & 31;
      int rs = min(max(r - 4, 0), 24);
      attn_item<1>(p, b * NSEQ + r * 64, C_NAQ + h * 64, C_NAK + h * 64, C_NAV + h * 64, b * NSEQ + rs * 64, 8, NLAT + b * LC, 4, true, rs - r + 7,
                   p.na_rpb + ((size_t)l * 6 + h) * 465, smem, dry);
    } else if (it < NSC + NNA + NCG) {
      int i = it - NSC - NNA, b = i >> 3, g = (i >> 2) & 1, qt = i & 3;
      attn_item<3>(p, NLAT + b * LC + qt * 64, C_GAQ + g * 192, C_GAK + g * 64, C_GAV + g * 64, 0, 0, NLAT + b * LC, 4, false, 0, nullptr, smem, dry);
    } else {
      int i = it - NSC - NNA - NCG, b = i / 24, rem = i % 24, h = rem >> 2, qt = rem & 3;
      attn_item<1>(p, NLAT + b * LC + qt * 64, C_NAQ + h * 64, C_NAK + h * 64, C_NAV + h * 64, 0, 0, NLAT + b * LC, 4, false, 0, nullptr, smem, dry);
    }
  }
}
DI void phase_mixB(const Params& p, int l, char* smem, bool dry = false) {
  const int cpl = (l == 0) ? 36 : 32;
  const int NGLB = NB * 4 * cpl;
  for (int it = blockIdx.x; it < NGLB; it += gridDim.x) {
    int cc = it % cpl, bh = it / cpl;
    gla_passB(p, l, bh >> 2, bh & 3, cc + (36 - cpl), smem, dry);
  }
}

DI void phase_final(const Params& p) {
  const int lane = tidx(p) & 63, w = tidx(p) >> 6;
  const float* g = p.ln2_g + 1024; const float* bb = p.ln2_b + 1024;
  for (int r = blockIdx.x * 4 + w; r < NLAT; r += gridDim.x * 4) {
    float* row = p.out + (size_t)r * 1024;
    f32x4 v[4];
    float s = 0.f;
#pragma unroll
    for (int i = 0; i < 4; ++i) { v[i] = *(const f32x4*)(row + i * 256 + lane * 4); s += v[i].x + v[i].y + v[i].z + v[i].w; }
#pragma unroll
    for (int m = 1; m < 64; m <<= 1) s += shx(s, m);
    float mu = s * (1.f / 1024.f), ss = 0.f;
#pragma unroll
    for (int i = 0; i < 4; ++i) { float a = v[i].x - mu, b = v[i].y - mu, c = v[i].z - mu, d = v[i].w - mu; ss += a * a + b * b + c * c + d * d; }
#pragma unroll
    for (int m = 1; m < 64; m <<= 1) ss += shx(ss, m);
    float rs = rsqrtf(ss * (1.f / 1024.f) + 1e-5f);
#pragma unroll
    for (int i = 0; i < 4; ++i) {
      f32x4 gg = *(const f32x4*)(g + i * 256 + lane * 4), be = *(const f32x4*)(bb + i * 256 + lane * 4), o;
      o.x = (v[i].x - mu) * rs * gg.x + be.x; o.y = (v[i].y - mu) * rs * gg.y + be.y;
      o.z = (v[i].z - mu) * rs * gg.z + be.z; o.w = (v[i].w - mu) * rs * gg.w + be.w;
      *(f32x4*)(row + i * 256 + lane * 4) = o;
    }
  }
}

DI void phase_uconv(const Params& p, int kind, int l) {
  const int tid = tidx(p), lane = tid & 63, w = tid >> 6;
  const int nrows = (kind == 1 && l == 1) ? NLAT : NROWS;
  const float* MODb = (const float*)(p.ws + OFF_MOD);
  const float* TABb = (const float*)(p.ws + OFF_TAB) + (size_t)l * 4 * 17 * 1024;
  for (int r = blockIdx.x * 4 + w; r < nrows; r += gridDim.x * 4) {
    const bool lat = r < NLAT;
    const int b = lat ? r / NSEQ : 16;
    const float* src; const float* st = nullptr; bf16_t* dstb;
    if (kind == 0) {
      if (l == 0) src = lat ? p.x + (size_t)r * 1024 : p.ctx + (size_t)(r - NLAT) * 1024;
      else { src = lat ? p.out + (size_t)r * 1024 : (const float*)(p.ws + OFF_CTXY2) + (size_t)(r - NLAT) * 1024; st = (const float*)(p.ws + OFF_ST2) + (size_t)r * 16; }
      dstb = (bf16_t*)(p.ws + OFF_Y1);
    } else {
      src = (const float*)(p.ws + OFF_Y1) + (size_t)r * 1024; st = (const float*)(p.ws + OFF_ST1) + (size_t)r * 16;
      dstb = (bf16_t*)(p.ws + OFF_UF);
    }
    float mu = 0.f, rs = 1.f;
    if (st) row_stats(st, mu, rs);
    const bool raw = (kind == 0 && l == 0);
    const float* t1 = raw ? MODb + (size_t)b * 6144 + 1024 : TABb + (size_t)(kind * 2) * 17 * 1024 + b * 1024;
    const float* t2 = raw ? MODb + (size_t)b * 6144 : TABb + (size_t)(kind * 2 + 1) * 17 * 1024 + b * 1024;
#pragma unroll
    for (int i = 0; i < 4; ++i) {
      const int k = i * 256 + lane * 4;
      f32x4 v = *(const f32x4*)(src + k), a = *(const f32x4*)(t1 + k), c = *(const f32x4*)(t2 + k);
      if (raw) { a.x += 1.f; a.y += 1.f; a.z += 1.f; a.w += 1.f; }
      u32x2 u;
      u.x = pack2((v.x - mu) * rs * a.x + c.x, (v.y - mu) * rs * a.y + c.y);
      u.y = pack2((v.z - mu) * rs * a.z + c.z, (v.w - mu) * rs * a.w + c.w);
      *(u32x2*)(dstb + ((size_t)(k >> 5) * NROWS + r) * 32 + (k & 31)) = u;
    }
  }
}

#define XB_TMO      128
#define XB_XCNT(j)  (256  + 64 * (j))
#define XB_XSUB(j)  (1280 + 64 * (j))
#define XB_XGEN(j)  (2304 + 64 * (j))
#define XB_TOP      3328
#define XB_TOPGEN   3392
#define XCD_BAR_WORDS 3456
#define XB_SPIN_CAP (1u << 18)
#define LAS __attribute__((address_space(3)))

__device__ __forceinline__ unsigned xb_ld(unsigned* p)              { return __hip_atomic_load(p, __ATOMIC_RELAXED, __HIP_MEMORY_SCOPE_AGENT); }
__device__ __forceinline__ unsigned xb_add(unsigned* p, unsigned v) { return __hip_atomic_fetch_add(p, v, __ATOMIC_RELAXED, __HIP_MEMORY_SCOPE_AGENT); }
__device__ __forceinline__ unsigned xb_xcc_id() { return (unsigned)__builtin_amdgcn_s_getreg((3 << 11) | 20) & 0xFu; }
#define XB_SPIN(cond, bar) do { unsigned _sp = 0; while (cond) { __builtin_amdgcn_s_sleep(1); \
    if ((++_sp & 255u) == 0u) { if (xb_ld(&(bar)[XB_TMO])) break; if (_sp > XB_SPIN_CAP) { atomicAdd(&(bar)[XB_TMO], 1u); break; } } } } while (0)

struct XcdBarrier {
    unsigned* bar; unsigned x;
    volatile LAS unsigned* st;
};

__device__ __forceinline__ XcdBarrier xcd_barrier_post(unsigned* bar, volatile LAS unsigned* st) {
    XcdBarrier b; b.bar = bar; b.x = xb_xcc_id(); b.st = st;
    if (threadIdx.x == 0) (void)xb_add(&bar[XB_XCNT(b.x)], 1u);
    return b;
}
__device__ __forceinline__ void xcd_barrier_complete(unsigned* bar, unsigned x, unsigned& nloc, unsigned& nx) {
    const unsigned G = gridDim.x * gridDim.y * gridDim.z;
    unsigned sum, cnt, mine, sp = 0u;
    for (;;) {
        sum = 0u; cnt = 0u; mine = 0u;
#pragma unroll
        for (unsigned j = 0; j < 16; ++j) { const unsigned c = xb_ld(&bar[XB_XCNT(j)]); sum += c; cnt += (c > 0u) ? 1u : 0u; mine = (j == x) ? c : mine; }
        if (sum == G) break;
        __builtin_amdgcn_s_sleep(1);
        if ((++sp & 255u) == 0u) { if (xb_ld(&bar[XB_TMO])) break; if (sp > XB_SPIN_CAP) { atomicAdd(&bar[XB_TMO], 1u); break; } }
    }
    nloc = mine > 0u ? mine : 1u; nx = cnt > 0u ? cnt : 1u;
}

__device__ __forceinline__ void xcd_barrier(const XcdBarrier& b) {
    asm volatile("s_waitcnt vmcnt(0)" ::: "memory");
    __syncthreads();
    if (threadIdx.x == 0) {
        unsigned* bar = b.bar;
        __builtin_amdgcn_s_waitcnt(0);
        unsigned nloc = b.st[0], nx = b.st[1];
        if (nloc == 0u) { xcd_barrier_complete(bar, b.x, nloc, nx); b.st[0] = nloc; b.st[1] = nx; }
        const unsigned old = xb_add(&bar[XB_XSUB(b.x)], 1u);
        const unsigned gen = old / nloc;
        if (old + 1u == (gen + 1u) * nloc) {
            __builtin_amdgcn_fence(__ATOMIC_RELEASE, "agent");
            asm volatile("s_waitcnt vmcnt(0)" ::: "memory");
            const unsigned og = xb_add(&bar[XB_TOP], 1u);
            const unsigned tg = og / nx;
            if (og + 1u == (tg + 1u) * nx) xb_add(&bar[XB_TOPGEN], 1u);
            else XB_SPIN(xb_ld(&bar[XB_TOPGEN]) == tg, bar);
            __builtin_amdgcn_fence(__ATOMIC_ACQUIRE, "agent");
            xb_add(&bar[XB_XGEN(b.x)], 1u);
            asm volatile("s_waitcnt vmcnt(0)" ::: "memory");
        } else {
            XB_SPIN(xb_ld(&bar[XB_XGEN(b.x)]) == gen, bar);
            __builtin_amdgcn_fence(__ATOMIC_ACQUIRE, "agent");
            asm volatile("s_waitcnt vmcnt(0)" ::: "memory");
        }
    }
    __syncthreads();
}


__global__ void __launch_bounds__(256, 2) mega(Params p_in) {
  Params p = p_in;
  p.wave_id = __builtin_amdgcn_readfirstlane((int)(threadIdx.x >> 6));
  extern __shared__ __attribute__((aligned(16))) char smem[];
  __shared__ uint4 xb_words;
  cg::grid_group grid = cg::this_grid();
  if (p.ph_lo < 0) grid.sync();
  if (threadIdx.x == 0) xb_words = make_uint4(0u, 0u, 0u, 0u);
  __syncthreads();
  XcdBarrier xb = xcd_barrier_post((unsigned*)(p.ws + OFF_BAR), (volatile LAS unsigned*)&xb_words);
  if (DUP & 32) { for (int i = 0; i < 16; ++i) xcd_barrier(xb); }
  for (int ph = p.ph_lo; ph < p.ph_hi; ++ph) {
    if (ph > p.ph_lo) xcd_barrier(xb);
    if (ph == 0) { phase_prepA(p, smem); if (DUP & 8) phase_prepA(p, smem); }
    else if (ph == 1) { phase_prepB(p); phase_uconv(p, 0, 0); }
    else {
      const int l = (ph - 2) / 9, s = (ph - 2) % 9;
      if (s == 0) { if (DUP & 1) phase_gemm<0, GV>(p, l, smem); phase_gemm<0>(p, l, smem); }
      else if (s == 1) { if (DUP & 2) phase_mixA(p, l, smem, true); if (DUP & 64) phase_mixA(p, l, smem, true, 2); phase_mixA(p, l, smem); }
      else if (s == 2) { if (DUP & 4) phase_mixS(p, l, smem, true); phase_mixS(p, l, smem); }
      else if (s == 3) { if (DUP & 128) phase_mixB(p, l, smem, true); phase_mixB(p, l, smem); }
      else if (s == 4) { if (DUP & 1) phase_gemm<1, GV>(p, l, smem); phase_gemm<1>(p, l, smem); }
      else if (s == 5) { phase_uconv(p, 1, l); if (DUP & 16) phase_uconv(p, 1, l); }
      else if (s == 6) { if (DUP & 1) phase_gemm<2, GV>(p, l, smem); phase_gemm<2>(p, l, smem); }
      else if (s == 7) { if (DUP & 1) phase_gemm<3, GV>(p, l, smem); phase_gemm<3>(p, l, smem); }
      else if (l == 0) phase_uconv(p, 0, 1);
      else phase_final(p);
    }
  }
}

extern "C" void kernel_launch(void* const* d_in, const int* in_sizes, int n_in, void* d_out, int out_size, void* d_ws, size_t ws_size,
                              hipStream_t stream) {
  static int grid = 0;
  if (grid == 0) {
    if (n_in != 20 || out_size != NLAT * 1024 || ws_size < WS_END) {
      fprintf(stderr, "kernel_launch: unexpected shapes (n_in %d out %d ws %zu need %zu)\n", n_in, out_size, ws_size, (size_t)WS_END);
      grid = -1; return;
    }
    int dev = 0, cus = 0, per = 0;
    hipGetDevice(&dev);
    hipDeviceGetAttribute(&cus, hipDeviceAttributeMultiprocessorCount, dev);
    hipFuncSetAttribute((const void*)mega, hipFuncAttributeMaxDynamicSharedMemorySize, SMEM_BYTES);
    hipOccupancyMaxActiveBlocksPerMultiprocessor(&per, (const void*)mega, 256, SMEM_BYTES);
    if (per < 1) per = 1;
    if (per > 2) per = 2;
    grid = cus * per;
  }
  if (grid < 0) return;
  if (hipMemsetAsync((char*)d_ws + OFF_BAR, 0, BAR_BYTES, stream) != hipSuccess) { fprintf(stderr, "kernel_launch: memset failed\n"); return; }
  Params p{};
  const float** pp = (const float**)&p;
  for (int i = 0; i < 20; ++i) pp[i] = (const float*)d_in[i];
  p.out = (float*)d_out; p.ws = (char*)d_ws;
#if ONE_LAUNCH
  p.ph_lo = 0; p.ph_hi = NPHASE;
  void* args[] = {&p};
  hipError_t e = hipLaunchCooperativeKernel((const void*)mega, dim3(grid), dim3(256), args, SMEM_BYTES, stream);
  if (e != hipSuccess) fprintf(stderr, "cooperative launch failed: %s (grid %d)\n", hipGetErrorString(e), grid);
#else
  for (int ph = 0; ph < NPHASE; ++ph) {
    p.ph_lo = ph; p.ph_hi = ph + 1;
    hipLaunchKernelGGL(mega, dim3(grid), dim3(256), SMEM_BYTES, stream, p);
  }
#endif
}
```

```cpp
#include <hip/hip_runtime.h>
#include <hip/hip_cooperative_groups.h>
#include <cstdio>
#include <cstdint>
namespace cg = cooperative_groups;

#ifndef PM
#define PM 0x1ff
#endif
#ifndef GV
#define GV 0
#endif
#ifndef DUP
#define DUP 0
#endif
#ifndef ONE_LAUNCH
#define ONE_LAUNCH 1
#endif

typedef unsigned short bf16_t;
typedef short bf16x8 __attribute__((ext_vector_type(8)));
typedef short s16x4 __attribute__((ext_vector_type(4)));
typedef float f32x4 __attribute__((ext_vector_type(4)));
typedef float f32x2 __attribute__((ext_vector_type(2)));
typedef unsigned u32x4 __attribute__((ext_vector_type(4)));
typedef unsigned u32x2 __attribute__((ext_vector_type(2)));
#define DI __device__ __forceinline__

constexpr int NB = 16, NSEQ = 2048, LC = 256, DM = 1024;
constexpr int NLAT = NB * NSEQ;
constexpr int NCTX = NB * LC;
constexpr int NROWS = NLAT + NCTX;
constexpr int PC = 2592;
constexpr int NPAD_IN = 2688;
constexpr int FH = 2816;
constexpr int C_NAQ = 0, C_NAK = 384, C_NAV = 768, C_GLQ = 1152, C_GLK = 1280, C_GLV = 1408, C_GLG = 1664,
              C_GAQ = 1920, C_GAK = 2304, C_GAV = 2432, C_GLR = 2560;
constexpr float ALPHA = 1.41421356237f;
constexpr float LOG2E = 1.44269504089f;
constexpr float QSCALE = 0.125f * LOG2E;

constexpr size_t al256(size_t x) { return (x + 255) & ~(size_t)255; }
constexpr size_t OFF_WTIN = 0;
constexpr size_t OFF_WTOUT = OFF_WTIN + al256((size_t)2 * NPAD_IN * 1024 * 2);
constexpr size_t OFF_WTFI = OFF_WTOUT + al256((size_t)2 * 1024 * 1024 * 2);
constexpr size_t OFF_WTFO = OFF_WTFI + al256((size_t)2 * 5632 * 1024 * 2);
constexpr size_t OFF_MOD = OFF_WTFO + al256((size_t)2 * 1024 * FH * 2);
constexpr size_t OFF_TAB = OFF_MOD + al256((size_t)2 * 17 * 6144 * 4);
constexpr size_t OFF_ROPE = OFF_TAB + al256((size_t)2 * 4 * 17 * 1024 * 4);
constexpr size_t OFF_ST1 = OFF_ROPE + al256((size_t)2 * 64 * 16 * 4);
constexpr size_t OFF_ST2 = OFF_ST1 + al256((size_t)NROWS * 16 * 4);
constexpr size_t OFF_LS = OFF_ST2 + al256((size_t)NROWS * 16 * 4);
constexpr size_t OFF_BL = OFF_LS + al256((size_t)NB * 4 * 2 * 36 * 2048 * 4);
constexpr size_t OFF_CTXY2 = OFF_BL + al256((size_t)NB * 4 * 2 * 36 * 32 * 4);
constexpr size_t OFF_UF = OFF_LS;
constexpr size_t OFF_Y1 = OFF_UF + al256((size_t)NROWS * 1024 * 2);
constexpr size_t OFF_P = OFF_Y1 + al256((size_t)NROWS * 1024 * 4);
constexpr size_t OFF_BAR = OFF_P + al256((size_t)NROWS * FH * 2);
constexpr size_t BAR_BYTES = 16384;
constexpr size_t OFF_BS = OFF_BAR + BAR_BYTES;
constexpr size_t WS_END = OFF_BS + al256((size_t)NB * 4 * 2 * 36 * 2048 * 4);

constexpr int SMEM_BYTES = 73728 + 6144;
constexpr int NPHASE = 20;

struct Params {
  const float *x, *c, *ctx, *c_ctx, *w_ada, *b_ada, *w_in, *na_rpb, *gla_wa2, *gla_ba, *gla_norm_w, *qnorm_w, *knorm_w,
      *w_out, *ln1_g, *ln1_b, *w_ffn_in, *w_ffn_out, *ln2_g, *ln2_b;
  float* out;
  char* ws;
  int ph_lo, ph_hi;
  int wave_id, pad_;
};

typedef __bf16 bf16x2_t __attribute__((ext_vector_type(2)));
DI unsigned pack2(float lo, float hi) {
  bf16x2_t v = {(__bf16)lo, (__bf16)hi};
  return __builtin_bit_cast(unsigned, v);
}
DI bf16_t f2bf(float f) { return (bf16_t)(pack2(f, 0.f) & 0xffffu); }
DI float bf2f(unsigned h) { return __uint_as_float(h << 16); }
DI float bflo(unsigned u) { return __uint_as_float(u << 16); }
DI float bfhi(unsigned u) { return __uint_as_float(u & 0xffff0000u); }
DI f32x4 mfma16(bf16x8 a, bf16x8 b, f32x4 c) { return __builtin_amdgcn_mfma_f32_16x16x32_bf16(a, b, c, 0, 0, 0); }
DI float siluf(float x) { return x / (1.f + __expf(-x)); }
DI int tidx(const Params& p) {
  int t = (p.wave_id << 6) | (int)__builtin_amdgcn_mbcnt_hi(~0u, __builtin_amdgcn_mbcnt_lo(~0u, 0u));
  asm volatile("" : "+v"(t));
  return t;
}
DI float shx(float v, int m) { return __shfl_xor(v, m, 64); }

DI int dest_row(int kind, int n) {
  if (kind == 0) return n < 1920 ? n : (n < 1952 ? n + 640 : n - 32);
  if (kind == 2) { int q = n / FH, hd = n - q * FH; return (hd >> 6) * 128 + ((hd >> 5) & 1) * 64 + q * 32 + (hd & 31); }
  return n;
}

DI void wt_tile(const Params& p, const float* __restrict__ src, int K, int N, int kt, int nt, bf16_t* __restrict__ dst, int dstStride, int kind, char* smem) {
  float* tile = (float*)smem;
  const int tid = tidx(p), k0 = kt * 64, n0 = nt * 64;
#pragma unroll 4
  for (int ii = 0; ii < 16; ++ii) {
    int i = (tid >> 6) + 4 * ii, j = tid & 63, n = n0 + j;
    tile[i * 65 + j] = (n < N) ? src[(size_t)(k0 + i) * N + n] : 0.f;
  }
  __syncthreads();
#pragma unroll 4
  for (int ii = 0; ii < 16; ++ii) {
    int jj = (tid >> 6) + 4 * ii, kk = tid & 63, n = n0 + jj;
    if (n < N) dst[((size_t)((k0 + kk) >> 5) * dstStride + dest_row(kind, n)) * 32 + ((k0 + kk) & 31)] = f2bf(tile[kk * 65 + jj]);
  }
}

DI void mod_item(const Params& p, int l, int cgi, char* smem) {
  float* sc = (float*)smem;
  float* red = sc + 17 * 256;
  const int tid = tidx(p), col = tid & 31, kg = tid >> 5, n = cgi * 32 + col;
  float acc[17];
#pragma unroll
  for (int r = 0; r < 17; ++r) acc[r] = 0.f;
  const float* w = p.w_ada + (size_t)l * 1024 * 6144 + n;
  for (int kc = 0; kc < 4; ++kc) {
    __syncthreads();
#pragma unroll
    for (int r = 0; r < 17; ++r) {
      float v = (r < 16) ? p.c[r * 1024 + kc * 256 + tid] : p.c_ctx[kc * 256 + tid];
      sc[r * 256 + tid] = siluf(v);
    }
    __syncthreads();
#pragma unroll 4
    for (int kk = 0; kk < 32; ++kk) {
      int kl = kg * 32 + kk;
      float wv = w[(size_t)(kc * 256 + kl) * 6144];
#pragma unroll
      for (int r = 0; r < 17; ++r) acc[r] += sc[r * 256 + kl] * wv;
    }
  }
#pragma unroll
  for (int r = 0; r < 17; ++r) red[(kg * 17 + r) * 32 + col] = acc[r];
  __syncthreads();
  float* MOD = (float*)(p.ws + OFF_MOD);
  for (int o = tid; o < 17 * 32; o += 256) {
    int r = o >> 5, cc = o & 31;
    float s = p.b_ada[l * 6144 + cgi * 32 + cc];
#pragma unroll
    for (int g = 0; g < 8; ++g) s += red[(g * 17 + r) * 32 + cc];
    MOD[((size_t)l * 17 + r) * 6144 + cgi * 32 + cc] = s;
  }
}

DI void phase_prepA(const Params& p, char* smem) {
  const int tid = tidx(p);
  for (int it = blockIdx.x; it < 6435; it += gridDim.x) {
    __syncthreads();
    if (it < 6048) {
      int l = it / 3024, r = it % 3024;
      if (r < 656) wt_tile(p, p.w_in + (size_t)l * 1024 * 2592, 1024, 2592, r / 41, r % 41, (bf16_t*)(p.ws + OFF_WTIN) + (size_t)l * NPAD_IN * 1024, NPAD_IN, 0, smem);
      else if (r < 912) { r -= 656; wt_tile(p, p.w_out + (size_t)l * 1024 * 1024, 1024, 1024, r / 16, r % 16, (bf16_t*)(p.ws + OFF_WTOUT) + (size_t)l * 1024 * 1024, 1024, 1, smem); }
      else if (r < 2320) { r -= 912; wt_tile(p, p.w_ffn_in + (size_t)l * 1024 * 5632, 1024, 5632, r / 88, r % 88, (bf16_t*)(p.ws + OFF_WTFI) + (size_t)l * 5632 * 1024, 5632, 2, smem); }
      else { r -= 2320; wt_tile(p, p.w_ffn_out + (size_t)l * FH * 1024, FH, 1024, r / 16, r % 16, (bf16_t*)(p.ws + OFF_WTFO) + (size_t)l * 1024 * FH, 1024, 1, smem); }
    } else if (it < 6050) {
      int l = it - 6048;
      for (int i = tid; i < 32 * 384; i += 256) {
        u32x4* d = (u32x4*)((bf16_t*)(p.ws + OFF_WTIN) + (size_t)l * NPAD_IN * 1024 + ((size_t)(i / 384) * NPAD_IN + 2592) * 32);
        d[i % 384] = (u32x4){0u, 0u, 0u, 0u};
      }
    } else if (it < 6434) {
      int r = it - 6050;
      mod_item(p, r / 192, r % 192, smem);
    } else {
      float* rc = (float*)(p.ws + OFF_ROPE);
      for (int i = tid; i < 1024; i += 256) {
        int pos = i >> 4, f = i & 15;
        float invf = powf(10000.f, -(float)f / 16.f);
        float ang = (float)pos * invf;
        rc[i] = cosf(ang);
        rc[1024 + i] = sinf(ang);
      }
    }
  }
}

DI void phase_prepB(const Params& p) {
  const float* MOD = (const float*)(p.ws + OFF_MOD);
  float* TAB = (float*)(p.ws + OFF_TAB);
  for (int i = blockIdx.x * 256 + tidx(p); i < 2 * 17 * 1024; i += gridDim.x * 256) {
    int k = i & 1023, b = (i >> 10) % 17, l = i / (17 * 1024);
    const float* m = MOD + ((size_t)l * 17 + b) * 6144;
    float sh1 = m[k], sc1 = m[1024 + k], sh2 = m[3072 + k], sc2 = m[4096 + k];
    float g0 = (l == 0) ? 1.f : p.ln2_g[k], b0 = (l == 0) ? 0.f : p.ln2_b[k];
    float* t = TAB + (size_t)l * 4 * 17 * 1024 + b * 1024 + k;
    t[0 * 17 * 1024] = g0 * (1.f + sc1);
    t[1 * 17 * 1024] = b0 * (1.f + sc1) + sh1;
    t[2 * 17 * 1024] = p.ln1_g[l * 1024 + k] * (1.f + sc2);
    t[3 * 17 * 1024] = p.ln1_b[l * 1024 + k] * (1.f + sc2) + sh2;
  }
}

DI void row_stats(const float* st, float& mu, float& rs) {
  const f32x4* s4 = (const f32x4*)st;
  f32x4 a = s4[0], b = s4[1], c = s4[2], d = s4[3];
  float S = a.x + a.z + b.x + b.z + c.x + c.z + d.x + d.z;
  float SS = a.y + a.w + b.y + b.w + c.y + c.w + d.y + d.w;
  mu = S * (1.f / 1024.f);
  float var = fmaxf(SS * (1.f / 1024.f) - mu * mu, 0.f);
  rs = rsqrtf(var + 1e-5f);
}

template <int MODE, int VAR = 0>
DI void gemm_tile(const Params& p, int l, int tm, int tn, char* smem) {
  constexpr int K = (MODE == 3) ? FH : 1024;
  constexpr int NK = K / 32;
  char* As = smem;
  char* Bs = smem + 16384;
  float* red = (float*)(smem + 73728);
  const int tid = tidx(p), lane = tid & 63, wid = tid >> 6, wr = wid >> 1, wc = wid & 1, fr = lane & 15, fq = lane >> 4;
  const int row0 = tm * 256;
  const bool lat = row0 < NLAT;
  const int bidx = lat ? row0 / NSEQ : 16;
  float* Y1 = (float*)(p.ws + OFF_Y1);
  float* CTXY2 = (float*)(p.ws + OFF_CTXY2);
  const float* ST1 = (const float*)(p.ws + OFF_ST1);
  const float* ST2 = (const float*)(p.ws + OFF_ST2);
  bf16_t* P = (bf16_t*)(p.ws + OFF_P);
  const float* MOD = (const float*)(p.ws + OFF_MOD) + ((size_t)l * 17 + bidx) * 6144;

  const bf16_t* absrc; int astride;
  if (MODE == 0) { absrc = (const bf16_t*)(p.ws + OFF_Y1) + (size_t)row0 * 32; astride = 32; }
  else if (MODE == 1) { absrc = P + (size_t)row0 * PC; astride = PC; }
  else if (MODE == 2) { absrc = (const bf16_t*)(p.ws + OFF_UF) + (size_t)row0 * 32; astride = 32; }
  else { absrc = P + (size_t)row0 * 32; astride = 32; }
  constexpr int NPADB = (MODE == 0) ? NPAD_IN : (MODE == 2 ? 5632 : 1024);
  const bf16_t* wt;
  if (MODE == 0) wt = (const bf16_t*)(p.ws + OFF_WTIN) + (size_t)l * NPAD_IN * 1024;
  else if (MODE == 1) wt = (const bf16_t*)(p.ws + OFF_WTOUT) + (size_t)l * 1024 * 1024;
  else if (MODE == 2) wt = (const bf16_t*)(p.ws + OFF_WTFI) + (size_t)l * 5632 * 1024;
  else wt = (const bf16_t*)(p.ws + OFF_WTFO) + (size_t)l * 1024 * FH;
  const int prow = lane >> 2, pch = (lane & 3) ^ ((-(prow >> 2)) & 3);
  const unsigned aoff = (unsigned)(((wid * 64 + prow) * astride + pch * 8) * 2);
  const unsigned apiece = (unsigned)(16 * astride * 2);
  const unsigned boff = (unsigned)(((tn * 128 + wid * 32 + prow) * 32 + pch * 8) * 2);
  const char* abase0 = (const char*)absrc;
  const char* bbase0 = (const char*)wt;
  char* adst_t = As + wid * 4096 + lane * 16;
  char* bdst_t = Bs + wid * 2048 + lane * 16;
  auto dma_a = [&](int kt, int buf, int i) __attribute__((always_inline)) {
    size_t kk;
    if (MODE == 1) { kk = kt * 64; if (kk >= 768) kk += 2560; }
    else kk = (size_t)kt * NROWS * 64;
    const char* ub = abase0 + kk;
    if (MODE == 1) __builtin_amdgcn_global_load_lds((const unsigned*)(ub + (aoff + (unsigned)i * apiece)), (unsigned*)(adst_t + buf * 24576 + i * 1024), 16, 0, 0);
    else {
      if (i == 0) __builtin_amdgcn_global_load_lds((const unsigned*)(ub + aoff), (unsigned*)(adst_t + buf * 24576), 16, 0, 0);
      else if (i == 1) __builtin_amdgcn_global_load_lds((const unsigned*)(ub + aoff), (unsigned*)(adst_t + buf * 24576), 16, 1024, 0);
      else if (i == 2) __builtin_amdgcn_global_load_lds((const unsigned*)(ub + aoff), (unsigned*)(adst_t + buf * 24576), 16, 2048, 0);
      else __builtin_amdgcn_global_load_lds((const unsigned*)(ub + aoff), (unsigned*)(adst_t + buf * 24576), 16, 3072, 0);
    }
  };
  auto dma_b = [&](int kt, int buf, int i) __attribute__((always_inline)) {
    const char* ub = bbase0 + (size_t)kt * NPADB * 64;
    if (i == 0) __builtin_amdgcn_global_load_lds((const unsigned*)(ub + boff), (unsigned*)(bdst_t + buf * 24576), 16, 0, 0);
    else __builtin_amdgcn_global_load_lds((const unsigned*)(ub + boff), (unsigned*)(bdst_t + buf * 24576), 16, 1024, 0);
  };
  auto dma = [&](int kt, int buf) __attribute__((always_inline)) {
#pragma unroll
    for (int i = 0; i < 4; ++i) dma_a(kt, buf, i);
#pragma unroll
    for (int i = 0; i < 2; ++i) dma_b(kt, buf, i);
  };
  const int fpos = (fq ^ ((-(fr >> 2)) & 3)) * 16;

  f32x4 acc[8][4];
#pragma unroll
  for (int m = 0; m < 8; ++m)
#pragma unroll
    for (int n = 0; n < 4; ++n) acc[m][n] = (f32x4){0.f, 0.f, 0.f, 0.f};

  __syncthreads();
  dma(0, 0);
  dma(1, 1);
  dma(2, 2);
  asm volatile("s_waitcnt vmcnt(12)" ::: "memory");
  __syncthreads();
  bf16x8 af[8], bfc[4], bfn[4];
  {
    const char* ab = As + (wr * 128 + fr) * 64 + fpos;
    const char* bb = Bs + (wc * 64 + fr) * 64 + fpos;
#pragma unroll
    for (int n = 0; n < 4; ++n) bfc[n] = *(const bf16x8*)(bb + n * 1024);
#pragma unroll
    for (int m = 0; m < 4; ++m) af[m] = *(const bf16x8*)(ab + m * 1024);
#pragma unroll
    for (int n = 0; n < 4; ++n) bfn[n] = bfc[n];
    __builtin_amdgcn_s_waitcnt(0xC07F);
  }
  int sc = 0;
#pragma unroll 1
  for (int kt = 0; kt < NK; ++kt) {
    const int sn = (sc == 2) ? 0 : sc + 1;
    {
      const char* ab = As + sc * 24576 + (wr * 128 + fr) * 64 + fpos;
#pragma unroll
      for (int m = 4; m < 8; ++m) af[m] = *(const bf16x8*)(ab + m * 1024);
    }
    __builtin_amdgcn_sched_barrier(0);
#pragma unroll
    for (int m = 0; m < 4; ++m)
#pragma unroll
      for (int n = 0; n < 4; ++n) { if (VAR != 2 && VAR != 3) acc[m][n] = mfma16(bfc[n], af[m], acc[m][n]); else asm volatile("" :: "v"(bfc[n]), "v"(af[m])); }
    __builtin_amdgcn_sched_barrier(0);
    if (kt + 2 < NK) asm volatile("s_waitcnt vmcnt(6) lgkmcnt(0)" ::: "memory");
    else asm volatile("s_waitcnt vmcnt(0) lgkmcnt(0)" ::: "memory");
    __syncthreads();
#pragma unroll
    for (int m = 4; m < 8; ++m)
#pragma unroll
      for (int n = 0; n < 4; ++n) { if (VAR != 2 && VAR != 3) acc[m][n] = mfma16(bfc[n], af[m], acc[m][n]); else asm volatile("" :: "v"(bfc[n]), "v"(af[m])); }
    __builtin_amdgcn_sched_barrier(0);
    if (kt + 1 < NK) {
      const char* ab = As + sn * 24576 + (wr * 128 + fr) * 64 + fpos;
      const char* bb = Bs + sn * 24576 + (wc * 64 + fr) * 64 + fpos;
#pragma unroll
      for (int n = 0; n < 4; ++n) bfn[n] = *(const bf16x8*)(bb + n * 1024);
#pragma unroll
      for (int m = 0; m < 4; ++m) af[m] = *(const bf16x8*)(ab + m * 1024);
    }
    __builtin_amdgcn_sched_barrier(0);
    if (VAR != 1 && VAR != 3 && kt + 3 < NK) dma(kt + 3, sc);
    __builtin_amdgcn_sched_barrier(0);
#pragma unroll
    for (int n = 0; n < 4; ++n) bfc[n] = bfn[n];
    sc = sn;
    __builtin_amdgcn_s_waitcnt(0xC07F);
  }
  int fr_e = fr;
  asm volatile("" : "+v"(fr_e));
  if (MODE == 0) {
    const int hs = tn * 2 + wc;
    if (hs > 40) return;
    const bool isq = (hs >= 30 && hs < 36), isk = (hs == 36 || hs == 37);
    if (isq || isk) {
      const float* nw = (isq ? p.qnorm_w : p.knorm_w) + l * 64;
      const float* rc = (const float*)(p.ws + OFF_ROPE);
      float w_[4][4];
#pragma unroll
      for (int n = 0; n < 4; ++n)
#pragma unroll
        for (int j = 0; j < 4; ++j) w_[n][j] = nw[n * 16 + fq * 4 + j];
#pragma unroll
      for (int m = 0; m < 8; ++m) {
        float ss = 0.f;
#pragma unroll
        for (int n = 0; n < 4; ++n)
#pragma unroll
          for (int j = 0; j < 4; ++j) ss += acc[m][n][j] * acc[m][n][j];
        ss += shx(ss, 16); ss += shx(ss, 32);
        float inv = rsqrtf(ss * (1.f / 64.f) + 1e-6f);
#pragma unroll
        for (int n = 0; n < 4; ++n)
#pragma unroll
          for (int j = 0; j < 4; ++j) acc[m][n][j] *= inv * w_[n][j];
        if (lat) {
          int t = (row0 + wr * 128 + m * 16 + fr_e) & (NSEQ - 1);
          int gr = t >> 6, gc = t & 63;
#pragma unroll
          for (int j = 0; j < 4; ++j) {
            float cr = rc[gr * 16 + fq * 4 + j], sr = rc[1024 + gr * 16 + fq * 4 + j];
            float cc = rc[gc * 16 + fq * 4 + j], sn = rc[1024 + gc * 16 + fq * 4 + j];
            float x1 = acc[m][0][j], x2 = acc[m][1][j], x3 = acc[m][2][j], x4 = acc[m][3][j];
            acc[m][0][j] = x1 * cr - x2 * sr; acc[m][1][j] = x2 * cr + x1 * sr;
            acc[m][2][j] = x3 * cc - x4 * sn; acc[m][3][j] = x4 * cc + x3 * sn;
          }
        }
      }
    }
    float scl = 1.f;
    if (hs < 6 || isq) scl = QSCALE;
    else if (hs == 18 || hs == 19) scl = 0.17677669529663687f;
    const int nmax = (hs == 40) ? 2 : 4;
#pragma unroll
    for (int m = 0; m < 8; ++m) {
      bf16_t* pr = P + (size_t)(row0 + wr * 128 + m * 16 + fr_e) * PC + hs * 64 + fq * 4;
#pragma unroll
      for (int n = 0; n < 4; ++n) {
        if (n < nmax) {
          u32x2 u; u.x = pack2(acc[m][n][0] * scl, acc[m][n][1] * scl); u.y = pack2(acc[m][n][2] * scl, acc[m][n][3] * scl);
          *(u32x2*)(pr + n * 16) = u;
        }
      }
    }
  } else if (MODE == 2) {
    bf16_t* H = P;
#pragma unroll
    for (int m = 0; m < 8; ++m) {
      bf16_t* hr = H + ((size_t)(tn * 2 + wc) * NROWS + row0 + wr * 128 + m * 16 + fr_e) * 32 + fq * 4;
#pragma unroll
      for (int n = 0; n < 2; ++n) {
        float h0 = siluf(acc[m][n][0]) * acc[m][n + 2][0], h1 = siluf(acc[m][n][1]) * acc[m][n + 2][1];
        float h2 = siluf(acc[m][n][2]) * acc[m][n + 2][2], h3 = siluf(acc[m][n][3]) * acc[m][n + 2][3];
        u32x2 u; u.x = pack2(h0, h1); u.y = pack2(h2, h3);
        *(u32x2*)(hr + n * 16) = u;
      }
    }
  } else {
    const float* gate = MOD + (MODE == 1 ? 2048 : 5120) + tn * 128 + wc * 64 + fq * 4;
    const float* lng = nullptr; const float* lnb = nullptr; const float* xs; const float* st = nullptr;
    float* dst; float* stout;
    bool doln;
    if (MODE == 1) {
      doln = (l == 1);
      if (l == 0) xs = lat ? p.x + (size_t)row0 * 1024 : p.ctx + (size_t)(row0 - NLAT) * 1024;
      else { xs = p.out + (size_t)row0 * 1024; st = ST2 + (size_t)row0 * 16; lng = p.ln2_g; lnb = p.ln2_b; }
      dst = Y1 + (size_t)row0 * 1024;
      stout = (float*)(p.ws + OFF_ST1) + (size_t)row0 * 16;
    } else {
      doln = true;
      xs = Y1 + (size_t)row0 * 1024; st = ST1 + (size_t)row0 * 16; lng = p.ln1_g + l * 1024; lnb = p.ln1_b + l * 1024;
      dst = lat ? p.out + (size_t)row0 * 1024 : CTXY2 + (size_t)(row0 - NLAT) * 1024;
      stout = (float*)(p.ws + OFF_ST2) + (size_t)row0 * 16;
    }
    const int cb = tn * 128 + wc * 64 + fq * 4;
    float* rst = red + 1024;
    if (doln) { float m_, r_; row_stats(st + (size_t)tid * 16, m_, r_); rst[tid * 2] = m_; rst[tid * 2 + 1] = r_; }
    __syncthreads();
#pragma unroll
    for (int m = 0; m < 8; ++m) {
      const int rl = wr * 128 + m * 16 + fr_e;
      float rmu = 0.f, rrs = 1.f;
      if (doln) { rmu = rst[rl * 2]; rrs = rst[rl * 2 + 1]; }
      float s_ = 0.f, ss = 0.f;
      const float* xr = xs + (size_t)rl * 1024 + cb;
      float* dr = dst + (size_t)rl * 1024 + cb;
#pragma unroll
      for (int n = 0; n < 4; ++n) {
        const f32x4 gv = *(const f32x4*)(gate + n * 16);
        f32x4 xv = *(const f32x4*)(xr + n * 16);
        if (doln) {
          const f32x4 lg = *(const f32x4*)(lng + cb + n * 16), lb = *(const f32x4*)(lnb + cb + n * 16);
          xv.x = (xv.x - rmu) * rrs * lg.x + lb.x; xv.y = (xv.y - rmu) * rrs * lg.y + lb.y;
          xv.z = (xv.z - rmu) * rrs * lg.z + lb.z; xv.w = (xv.w - rmu) * rrs * lg.w + lb.w;
        }
        f32x4 o;
        o.x = ALPHA * xv.x + gv.x * acc[m][n][0]; o.y = ALPHA * xv.y + gv.y * acc[m][n][1];
        o.z = ALPHA * xv.z + gv.z * acc[m][n][2]; o.w = ALPHA * xv.w + gv.w * acc[m][n][3];
        *(f32x4*)(dr + n * 16) = o;
        s_ += o.x + o.y + o.z + o.w;
        ss += o.x * o.x + o.y * o.y + o.z * o.z + o.w * o.w;
      }
      s_ += shx(s_, 16); s_ += shx(s_, 32);
      ss += shx(ss, 16); ss += shx(ss, 32);
      if (fq == 0) { red[((wr * 2 + wc) * 128 + m * 16 + fr_e) * 2] = s_; red[((wr * 2 + wc) * 128 + m * 16 + fr_e) * 2 + 1] = ss; }
      if (m & 1) __builtin_amdgcn_sched_barrier(0);
    }
    __syncthreads();
    {
      int r = tid, w_ = r >> 7, rr = r & 127;
      float s = red[((w_ * 2 + 0) * 128 + rr) * 2] + red[((w_ * 2 + 1) * 128 + rr) * 2];
      float ss = red[((w_ * 2 + 0) * 128 + rr) * 2 + 1] + red[((w_ * 2 + 1) * 128 + rr) * 2 + 1];
      *(f32x2*)(stout + (size_t)r * 16 + tn * 2) = (f32x2){s, ss};
    }
  }
}

template <int MODE, int VAR = 0>
DI void phase_gemm(const Params& p, int l, char* smem) {
  const int NT = (MODE == 0) ? 21 : (MODE == 2 ? 44 : 8);
  const int MT = (l == 0 || MODE == 0) ? 144 : 128;
  const int vb = (blockIdx.x & 7) * (gridDim.x >> 3) + (blockIdx.x >> 3);
  for (int t = vb; t < MT * NT; t += gridDim.x) {
    const int g = t / (8 * NT), r = t - g * 8 * NT;
    gemm_tile<MODE, VAR>(p, l, g * 8 + (r & 7), r >> 3, smem);
  }
}

typedef __attribute__((address_space(3))) s16x4 lds_s16x4;
template <int NH>
DI void attn_item(const Params& p, int qrow0, int qcol, int kcol, int vcol, int lat_row0, int nb_lat, int ctx_row0, int nb_ctx,
                  bool na, int dr0, const float* rpb_h, char* smem, bool dry = false) {
  char* KV = smem;
  float* rpbs = (float*)(smem + 3 * 16384);
  const int tid = tidx(p), lane = tid & 63, w = tid >> 6, fr = lane & 15, fq = lane >> 4;
  bf16_t* P = (bf16_t*)(p.ws + OFF_P);
  __syncthreads();
  if (na) for (int i = tid; i < 465; i += 256) rpbs[i] = rpb_h[i] * LOG2E;
  bf16x8 qf[NH][2];
  f32x4 o[NH][4], lsum[NH];
  float mrun[NH];
  const bf16x8 ones = (bf16x8){0x3F80, 0x3F80, 0x3F80, 0x3F80, 0x3F80, 0x3F80, 0x3F80, 0x3F80};
#pragma unroll
  for (int hh = 0; hh < NH; ++hh) {
    const bf16_t* qp = P + (size_t)(qrow0 + w * 16 + fr) * PC + qcol + hh * 64 + fq * 8;
    qf[hh][0] = *(const bf16x8*)qp; qf[hh][1] = *(const bf16x8*)(qp + 32);
#pragma unroll
    for (int i = 0; i < 4; ++i) o[hh][i] = (f32x4){0.f, 0.f, 0.f, 0.f};
    mrun[hh] = -1e30f; lsum[hh] = (f32x4){0.f, 0.f, 0.f, 0.f};
  }
  const int nb = nb_lat + nb_ctx;
  const unsigned goff = (unsigned)(((w * 16 + (lane >> 3)) * PC + (((lane & 7) ^ (lane >> 3)) * 8)) * 2);
  char* dstk = KV + w * 2048 + lane * 16;
  auto dma = [&](int kb, int st) __attribute__((always_inline)) {
    const int rb = kb < nb_lat ? lat_row0 + kb * 64 : ctx_row0 + (kb - nb_lat) * 64;
    const char* ub = (const char*)(P + (size_t)rb * PC);
#pragma unroll
    for (int i = 0; i < 2; ++i) {
      __builtin_amdgcn_global_load_lds((const unsigned*)(ub + kcol * 2 + (goff + (unsigned)(i * 8 * PC * 2))), (unsigned*)(dstk + st * 16384 + i * 1024), 16, 0, 0);
      __builtin_amdgcn_global_load_lds((const unsigned*)(ub + vcol * 2 + (goff + (unsigned)(i * 8 * PC * 2))), (unsigned*)(dstk + st * 16384 + 8192 + i * 1024), 16, 0, 0);
    }
  };
  const int qj = w * 16 + fr;
  const int cs = min(max(qj - 8, 0), 48);
  const int koff = fr * 128;
  const int kx0 = ((fq) ^ (fr & 7)) * 16, kx1 = ((4 + fq) ^ (fr & 7)) * 16;
  const int vr7 = ((fq & 1) * 4 + (fr >> 2));
  const int voff = (fq * 4 + (fr >> 2)) * 128 + (fr & 1) * 8;
  dma(0, 0);
  if (nb > 1) dma(1, 1);
  if (nb > 1) asm volatile("s_waitcnt vmcnt(4)" ::: "memory"); else asm volatile("s_waitcnt vmcnt(0)" ::: "memory");
  __syncthreads();
  int sc = 0;
  for (int kb = 0; kb < nb; ++kb) {
    const char* Kb = KV + sc * 16384;
    const char* Vb = Kb + 8192;
    const int sn2 = (sc == 0) ? 2 : sc - 1;
    if (kb + 2 < nb) dma(kb + 2, sn2);
    const bool msk = na && kb < nb_lat;
    int mt_lo = 0, mt_hi = 3;
    if (msk) { mt_lo = (w >= 2) ? w - 1 : 0; mt_hi = (w <= 1) ? w + 1 : 3; }
    bf16x8 kf[4][2];
#pragma unroll
    for (int mt = 0; mt < 4; ++mt)
      if (mt >= mt_lo && mt <= mt_hi) {
        kf[mt][0] = *(const bf16x8*)(Kb + koff + mt * 2048 + kx0);
        kf[mt][1] = *(const bf16x8*)(Kb + koff + mt * 2048 + kx1);
      }
    bf16x8 pf[NH][2];
    f32x4 s[NH][4];
#pragma unroll
    for (int hh = 0; hh < NH; ++hh)
#pragma unroll
      for (int mt = 0; mt < 4; ++mt) {
        if (mt >= mt_lo && mt <= mt_hi) {
          s[hh][mt] = mfma16(kf[mt][0], qf[hh][0], (f32x4){0.f, 0.f, 0.f, 0.f});
          s[hh][mt] = mfma16(kf[mt][1], qf[hh][1], s[hh][mt]);
        } else s[hh][mt] = (f32x4){-1e30f, -1e30f, -1e30f, -1e30f};
      }
    if (msk) {
#pragma unroll
      for (int hh = 0; hh < NH; ++hh)
#pragma unroll
        for (int mt = 0; mt < 4; ++mt)
          if (mt >= mt_lo && mt <= mt_hi) {
#pragma unroll
            for (int j = 0; j < 4; ++j) {
              int kc = mt * 16 + fq * 4 + j;
              bool valid = (kc >= cs) && (kc < cs + 16);
              int bi = min(max(kc - qj, -15), 15);
              s[hh][mt][j] = valid ? s[hh][mt][j] + rpbs[(dr0 + kb) * 31 + bi + 15] : -1e30f;
            }
          }
    }
#pragma unroll
    for (int hh = 0; hh < NH; ++hh) {
      float mx = fmaxf(fmaxf(fmaxf(s[hh][0][0], s[hh][0][1]), fmaxf(s[hh][0][2], s[hh][0][3])), fmaxf(fmaxf(s[hh][1][0], s[hh][1][1]), fmaxf(s[hh][1][2], s[hh][1][3])));
      mx = fmaxf(mx, fmaxf(fmaxf(fmaxf(s[hh][2][0], s[hh][2][1]), fmaxf(s[hh][2][2], s[hh][2][3])), fmaxf(fmaxf(s[hh][3][0], s[hh][3][1]), fmaxf(s[hh][3][2], s[hh][3][3]))));
      mx = fmaxf(mx, shx(mx, 16)); mx = fmaxf(mx, shx(mx, 32));
      const float mnew = fmaxf(mrun[hh], mx);
      const float alpha = __builtin_amdgcn_exp2f(mrun[hh] - mnew);
      mrun[hh] = mnew;
      const f32x4 av = (f32x4){alpha, alpha, alpha, alpha}, mv = (f32x4){mnew, mnew, mnew, mnew};
      lsum[hh] = lsum[hh] * av;
#pragma unroll
      for (int i = 0; i < 4; ++i) o[hh][i] = o[hh][i] * av;
#pragma unroll
      for (int mt = 0; mt < 4; ++mt) {
        f32x4 d = s[hh][mt] - mv;
        d[0] = __builtin_amdgcn_exp2f(d[0]); d[1] = __builtin_amdgcn_exp2f(d[1]); d[2] = __builtin_amdgcn_exp2f(d[2]); d[3] = __builtin_amdgcn_exp2f(d[3]);
        s[hh][mt] = d;
      }
#pragma unroll
      for (int kp = 0; kp < 2; ++kp) {
        u32x4 pk;
        pk.x = pack2(s[hh][2 * kp][0], s[hh][2 * kp][1]); pk.y = pack2(s[hh][2 * kp][2], s[hh][2 * kp][3]);
        pk.z = pack2(s[hh][2 * kp + 1][0], s[hh][2 * kp + 1][1]); pk.w = pack2(s[hh][2 * kp + 1][2], s[hh][2 * kp + 1][3]);
        pf[hh][kp] = __builtin_bit_cast(bf16x8, pk);
      }
    }
#pragma unroll
    for (int kp = 0; kp < 2; ++kp) {
      if ((kp == 0 && mt_lo <= 1) || (kp == 1 && mt_hi >= 2)) {
#pragma unroll
        for (int hh = 0; hh < NH; ++hh) lsum[hh] = mfma16(ones, pf[hh][kp], lsum[hh]);
        s16x4 vl[4], vh[4];
        {
          const unsigned a0 = (unsigned)(size_t)(Vb + voff + kp * 4096 + (((0 + ((fr & 3) >> 1)) ^ vr7) * 16));
          const unsigned a1 = (unsigned)(size_t)(Vb + voff + kp * 4096 + (((2 + ((fr & 3) >> 1)) ^ vr7) * 16));
          const unsigned a2 = (unsigned)(size_t)(Vb + voff + kp * 4096 + (((4 + ((fr & 3) >> 1)) ^ vr7) * 16));
          const unsigned a3 = (unsigned)(size_t)(Vb + voff + kp * 4096 + (((6 + ((fr & 3) >> 1)) ^ vr7) * 16));
          asm volatile(
              "ds_read_b64_tr_b16 %0, %8\n\tds_read_b64_tr_b16 %1, %8 offset:2048\n\t"
              "ds_read_b64_tr_b16 %2, %9\n\tds_read_b64_tr_b16 %3, %9 offset:2048\n\t"
              "ds_read_b64_tr_b16 %4, %10\n\tds_read_b64_tr_b16 %5, %10 offset:2048\n\t"
              "ds_read_b64_tr_b16 %6, %11\n\tds_read_b64_tr_b16 %7, %11 offset:2048\n\t"
              "s_waitcnt lgkmcnt(0)"
              : "=&v"(vl[0]), "=&v"(vh[0]), "=&v"(vl[1]), "=&v"(vh[1]), "=&v"(vl[2]), "=&v"(vh[2]), "=&v"(vl[3]), "=&v"(vh[3])
              : "v"(a0), "v"(a1), "v"(a2), "v"(a3)
              : "memory");
        }
#pragma unroll
        for (int dt = 0; dt < 4; ++dt) {
          bf16x8 vf = __builtin_shufflevector(vl[dt], vh[dt], 0, 1, 2, 3, 4, 5, 6, 7);
#pragma unroll
          for (int hh = 0; hh < NH; ++hh) o[hh][dt] = mfma16(vf, pf[hh][kp], o[hh][dt]);
        }
      }
    }
    if (kb + 2 < nb) asm volatile("s_waitcnt vmcnt(4) lgkmcnt(0)" ::: "memory");
    else asm volatile("s_waitcnt vmcnt(0) lgkmcnt(0)" ::: "memory");
    __builtin_amdgcn_s_barrier();
    asm volatile("" ::: "memory");
    sc = (sc == 2) ? 0 : sc + 1;
  }
#pragma unroll
  for (int hh = 0; hh < NH; ++hh) {
    const float inv = 1.f / lsum[hh][0];
    bf16_t* op = dry ? (bf16_t*)(p.ws + OFF_Y1) + (size_t)((qrow0 + w * 16 + fr) & 16383) * PC + qcol + hh * 64 + fq * 4
                     : P + (size_t)(qrow0 + w * 16 + fr) * PC + qcol + hh * 64 + fq * 4;
#pragma unroll
    for (int dt = 0; dt < 4; ++dt) {
      u32x2 u; u.x = pack2(o[hh][dt][0] * inv, o[hh][dt][1] * inv); u.y = pack2(o[hh][dt][2] * inv, o[hh][dt][3] * inv);
      *(u32x2*)(op + dt * 16) = u;
    }
  }
}

DI float logsig(float z) { return fminf(z, 0.f) - __logf(1.f + __expf(-fabsf(z))); }
DI int chunk_row0(int b, int cidx) { return cidx < 4 ? NLAT + b * LC + cidx * 64 : b * NSEQ + (cidx - 4) * 64; }
DI int chain_pos(int cidx, int dir) { return dir == 0 ? cidx : (cidx < 4 ? 3 - cidx : 39 - cidx); }

DI void gla_gates(const Params& p, int l, int h, int dir, int row0, float* bs, float* lrs, float* was, float* segt) {
  const int tid = tidx(p);
  const bf16_t* P = (const bf16_t*)(p.ws + OFF_P);
  {
    int s = tid >> 2, r4 = (tid & 3) * 4;
    u32x2 u = *(const u32x2*)(P + (size_t)(row0 + s) * PC + C_GLR + dir * 16 + r4);
    lrs[s * 17 + r4] = bflo(u.x); lrs[s * 17 + r4 + 1] = bfhi(u.x); lrs[s * 17 + r4 + 2] = bflo(u.y); lrs[s * 17 + r4 + 3] = bfhi(u.y);
    for (int i = tid; i < 512; i += 256) was[i] = p.gla_wa2[(((size_t)l * 2 + dir) * 16 + (i >> 5)) * 128 + h * 32 + (i & 31)];
  }
  __syncthreads();
  const int d = tid & 31, sg = tid >> 5;
  const float ba = p.gla_ba[(l * 2 + dir) * 128 + h * 32 + d];
  float la[8];
#pragma unroll
  for (int i = 0; i < 8; ++i) {
    int s = sg * 8 + i;
    float z = ba;
#pragma unroll
    for (int r = 0; r < 16; ++r) z += lrs[s * 17 + r] * was[r * 32 + d];
    la[i] = logsig(z) * (1.f / 16.f);
  }
  if (dir == 0) {
#pragma unroll
    for (int i = 1; i < 8; ++i) la[i] += la[i - 1];
    segt[sg * 32 + d] = la[7];
  } else {
#pragma unroll
    for (int i = 6; i >= 0; --i) la[i] += la[i + 1];
    segt[sg * 32 + d] = la[0];
  }
  __syncthreads();
  float pre = 0.f;
#pragma unroll
  for (int g = 0; g < 8; ++g) {
    float v = segt[g * 32 + d];
    if (dir == 0 ? (g < sg) : (g > sg)) pre += v;
  }
#pragma unroll
  for (int i = 0; i < 8; ++i) bs[(sg * 8 + i) * 33 + d] = la[i] + pre;
  __syncthreads();
}

DI void gla_passA(const Params& p, int l, int item, char* smem) {
  float* bs = (float*)smem;
  bf16_t* Kw = (bf16_t*)(bs + 64 * 33);
  bf16_t* Vs = Kw + 64 * 40;
  float* lrs = (float*)(Vs + 64 * 72);
  float* was = lrs + 64 * 17;
  float* segt = was + 512;
  const int tid = tidx(p), lane = tid & 63, w = tid >> 6, fr = lane & 15, fq = lane >> 4;
  const int cidx = item % 36, bh = item / 36, h = bh & 3, b = bh >> 2;
  const int row0 = chunk_row0(b, cidx);
  const bf16_t* P = (const bf16_t*)(p.ws + OFF_P);
  __syncthreads();
  {
    int s = tid >> 2, v16 = (tid & 3) * 16;
    const bf16_t* vp = P + (size_t)(row0 + s) * PC + C_GLV + h * 64 + v16;
    *(u32x4*)(Vs + s * 72 + v16) = *(const u32x4*)vp;
    *(u32x4*)(Vs + s * 72 + v16 + 8) = *(const u32x4*)(vp + 8);
  }
  for (int dir = 0; dir < 2; ++dir) {
    gla_gates(p, l, h, dir, row0, bs, lrs, was, segt);
    const int pos = chain_pos(cidx, dir);
    const size_t chain = (size_t)((b * 4 + h) * 2 + dir) * 36;
    {
      int s = tid >> 2, d8 = (tid & 3) * 8;
      const int slast = dir == 0 ? 63 : 0;
      u32x4 uk = *(const u32x4*)(P + (size_t)(row0 + s) * PC + C_GLK + h * 32 + d8);
      float bv[8];
#pragma unroll
      for (int e = 0; e < 8; ++e) bv[e] = bs[s * 33 + d8 + e];
      float* BS = (float*)(p.ws + OFF_BS) + (chain + cidx) * 2048 + s * 32 + d8;
      *(f32x4*)BS = (f32x4){bv[0], bv[1], bv[2], bv[3]};
      *(f32x4*)(BS + 4) = (f32x4){bv[4], bv[5], bv[6], bv[7]};
      u32x4 ok;
#pragma unroll
      for (int e = 0; e < 4; ++e) {
        int d0 = d8 + 2 * e;
        ok[e] = pack2(bflo(uk[e]) * __expf(bs[slast * 33 + d0] - bv[2 * e]), bfhi(uk[e]) * __expf(bs[slast * 33 + d0 + 1] - bv[2 * e + 1]));
      }
      *(u32x4*)(Kw + s * 40 + d8) = ok;
      if (tid < 32) ((float*)(p.ws + OFF_BL))[(chain + pos) * 32 + tid] = bs[slast * 33 + tid];
    }
    __syncthreads();
    {
      f32x4 acc[2];
      acc[0] = (f32x4){0.f, 0.f, 0.f, 0.f}; acc[1] = acc[0];
#pragma unroll
      for (int ks = 0; ks < 2; ++ks) {
        const bf16_t* vp = Vs + (ks * 32 + fq * 8 + (fr >> 2)) * 72 + w * 16 + (fr & 3) * 4;
        s16x4 vlo = __builtin_amdgcn_ds_read_tr16_b64_v4i16((lds_s16x4*)vp);
        s16x4 vhi = __builtin_amdgcn_ds_read_tr16_b64_v4i16((lds_s16x4*)(vp + 4 * 72));
        const bf16x8 vf = __builtin_shufflevector(vlo, vhi, 0, 1, 2, 3, 4, 5, 6, 7);
#pragma unroll
        for (int mt = 0; mt < 2; ++mt) {
          const bf16_t* kp = Kw + (ks * 32 + fq * 8 + (fr >> 2)) * 40 + mt * 16 + (fr & 3) * 4;
          s16x4 klo = __builtin_amdgcn_ds_read_tr16_b64_v4i16((lds_s16x4*)kp);
          s16x4 khi = __builtin_amdgcn_ds_read_tr16_b64_v4i16((lds_s16x4*)(kp + 4 * 40));
          const bf16x8 kf = __builtin_shufflevector(klo, khi, 0, 1, 2, 3, 4, 5, 6, 7);
          acc[mt] = mfma16(kf, vf, acc[mt]);
        }
      }
      float* LS = (float*)(p.ws + OFF_LS) + (chain + pos) * 2048;
#pragma unroll
      for (int mt = 0; mt < 2; ++mt)
#pragma unroll
        for (int j = 0; j < 4; ++j) LS[(mt * 16 + fq * 4 + j) * 64 + w * 16 + fr] = acc[mt][j];
    }
    __syncthreads();
  }
}

DI void gla_scan(const Params& p, int item) {
  const int tid = tidx(p);
  const int chain = item >> 3, e = (item & 7) * 256 + tid, d = e >> 6;
  float* LS = (float*)(p.ws + OFF_LS) + (size_t)chain * 36 * 2048 + e;
  const float* BL = (const float*)(p.ws + OFF_BL) + (size_t)chain * 36 * 32 + d;
  float S = 0.f;
#pragma unroll 6
  for (int pos = 0; pos < 36; ++pos) {
    float x = LS[(size_t)pos * 2048], bl = BL[pos * 32];
    LS[(size_t)pos * 2048] = S;
    S = __expf(bl) * S + x;
  }
}

DI void gla_passB(const Params& p, int l, int b, int h, int cidx, char* smem, bool dry = false) {
  float* bs = (float*)smem;
  bf16_t* Qe = (bf16_t*)(bs + 64 * 33);
  bf16_t* Ke = Qe + 64 * 40;
  bf16_t* Vs = Ke + 64 * 40;
  bf16_t* S0 = Vs + 64 * 72;
  float* lrs = (float*)(S0 + 32 * 72);
  float* was = lrs + 64 * 17;
  float* segt = was + 512;
  const int tid = tidx(p), lane = tid & 63, w = tid >> 6, fr = lane & 15, fq = lane >> 4;
  const int row0 = chunk_row0(b, cidx);
  bf16_t* P = (bf16_t*)(p.ws + OFF_P);
  f32x4 o[4];
#pragma unroll
  for (int i = 0; i < 4; ++i) o[i] = (f32x4){0.f, 0.f, 0.f, 0.f};
  __syncthreads();
  {
    int s = tid >> 2, v16 = (tid & 3) * 16;
    const bf16_t* vp = P + (size_t)(row0 + s) * PC + C_GLV + h * 64 + v16;
    *(u32x4*)(Vs + s * 72 + v16) = *(const u32x4*)vp;
    *(u32x4*)(Vs + s * 72 + v16 + 8) = *(const u32x4*)(vp + 8);
  }
  for (int dir = 0; dir < 2; ++dir) {
    {
      int s = tid >> 2, d8 = (tid & 3) * 8;
      const float* BS = (const float*)(p.ws + OFF_BS) + ((size_t)((b * 4 + h) * 2 + dir) * 36 + cidx) * 2048 + s * 32 + d8;
      const f32x4 bA = *(const f32x4*)BS, bB = *(const f32x4*)(BS + 4);
      const float bv[8] = {bA.x, bA.y, bA.z, bA.w, bB.x, bB.y, bB.z, bB.w};
      u32x4 uq = *(const u32x4*)(P + (size_t)(row0 + s) * PC + C_GLQ + h * 32 + d8);
      u32x4 uk = *(const u32x4*)(P + (size_t)(row0 + s) * PC + C_GLK + h * 32 + d8);
      u32x4 oq, ok;
#pragma unroll
      for (int e = 0; e < 4; ++e) {
        int d0 = d8 + 2 * e;
        float b0 = bv[2 * e], b1 = bv[2 * e + 1];
        oq[e] = pack2(bflo(uq[e]) * __expf(b0), bfhi(uq[e]) * __expf(b1));
        ok[e] = pack2(bflo(uk[e]) * __expf(-b0), bfhi(uk[e]) * __expf(-b1));
      }
      *(u32x4*)(Qe + s * 40 + d8) = oq;
      *(u32x4*)(Ke + s * 40 + d8) = ok;
      const int pos = chain_pos(cidx, dir);
      const float* LS = (const float*)(p.ws + OFF_LS) + ((size_t)((b * 4 + h) * 2 + dir) * 36 + pos) * 2048;
      int d = tid >> 3, v8 = (tid & 7) * 8;
      f32x4 s0 = *(const f32x4*)(LS + d * 64 + v8), s1 = *(const f32x4*)(LS + d * 64 + v8 + 4);
      u32x4 os;
      os.x = pack2(s0.x, s0.y); os.y = pack2(s0.z, s0.w); os.z = pack2(s1.x, s1.y); os.w = pack2(s1.z, s1.w);
      *(u32x4*)(S0 + d * 72 + v8) = os;
    }
    __syncthreads();
    {
      const bf16x8 qf = *(const bf16x8*)(Qe + (w * 16 + fr) * 40 + fq * 8);
      f32x4 at[4];
#pragma unroll
      for (int mt = 0; mt < 4; ++mt) {
        const bool need = dir == 0 ? (mt <= w) : (mt >= w);
        if (need) {
          const bf16x8 kf = *(const bf16x8*)(Ke + (mt * 16 + fr) * 40 + fq * 8);
          at[mt] = mfma16(kf, qf, (f32x4){0.f, 0.f, 0.f, 0.f});
          if (mt == w) {
#pragma unroll
            for (int j = 0; j < 4; ++j) {
              const int sI = fq * 4 + j;
              const bool keep = dir == 0 ? (sI <= fr) : (sI >= fr);
              at[mt][j] = keep ? at[mt][j] : 0.f;
            }
          }
        } else at[mt] = (f32x4){0.f, 0.f, 0.f, 0.f};
      }
#pragma unroll
      for (int kp = 0; kp < 2; ++kp) {
        const bool needp = dir == 0 ? (2 * kp <= w) : (2 * kp + 1 >= w);
        if (needp) {
          u32x4 pk;
          pk.x = pack2(at[2 * kp][0], at[2 * kp][1]); pk.y = pack2(at[2 * kp][2], at[2 * kp][3]);
          pk.z = pack2(at[2 * kp + 1][0], at[2 * kp + 1][1]); pk.w = pack2(at[2 * kp + 1][2], at[2 * kp + 1][3]);
          const bf16x8 pf = __builtin_bit_cast(bf16x8, pk);
#pragma unroll
          for (int dt = 0; dt < 4; ++dt) {
            const bf16_t* vp = Vs + (kp * 32 + fq * 4 + (fr >> 2)) * 72 + dt * 16 + (fr & 3) * 4;
            s16x4 lo = __builtin_amdgcn_ds_read_tr16_b64_v4i16((lds_s16x4*)vp);
            s16x4 hi = __builtin_amdgcn_ds_read_tr16_b64_v4i16((lds_s16x4*)(vp + 16 * 72));
            bf16x8 vf = __builtin_shufflevector(lo, hi, 0, 1, 2, 3, 4, 5, 6, 7);
            o[dt] = mfma16(vf, pf, o[dt]);
          }
        }
      }
#pragma unroll
      for (int dt = 0; dt < 4; ++dt) {
        const bf16_t* sp = S0 + (fq * 8 + (fr >> 2)) * 72 + dt * 16 + (fr & 3) * 4;
        s16x4 lo = __builtin_amdgcn_ds_read_tr16_b64_v4i16((lds_s16x4*)sp);
        s16x4 hi = __builtin_amdgcn_ds_read_tr16_b64_v4i16((lds_s16x4*)(sp + 4 * 72));
        bf16x8 sf = __builtin_shufflevector(lo, hi, 0, 1, 2, 3, 4, 5, 6, 7);
        o[dt] = mfma16(sf, qf, o[dt]);
      }
    }
    __syncthreads();
  }
  float ss = 0.f;
#pragma unroll
  for (int dt = 0; dt < 4; ++dt) ss += o[dt][0] * o[dt][0] + o[dt][1] * o[dt][1] + o[dt][2] * o[dt][2] + o[dt][3] * o[dt][3];
  ss += shx(ss, 16); ss += shx(ss, 32);
  const float inv = rsqrtf(ss * (1.f / 64.f) + 1e-6f);
#pragma unroll
  for (int dt = 0; dt < 4; ++dt) {
    const f32x4 nw = *(const f32x4*)(p.gla_norm_w + l * 64 + dt * 16 + fq * 4);
    bf16_t* gp = P + (size_t)(row0 + w * 16 + fr) * PC + C_GLG + h * 64 + dt * 16 + fq * 4;
    u32x2 g = *(const u32x2*)gp;
    u32x2 u;
    u.x = pack2(o[dt][0] * inv * nw.x * siluf(bflo(g.x)), o[dt][1] * inv * nw.y * siluf(bfhi(g.x)));
    u.y = pack2(o[dt][2] * inv * nw.z * siluf(bflo(g.y)), o[dt][3] * inv * nw.w * siluf(bfhi(g.y)));
    if (dry) gp = (bf16_t*)(p.ws + OFF_Y1) + (size_t)((row0 + w * 16 + fr) & 16383) * PC + C_GLG + h * 64 + dt * 16 + fq * 4;
    *(u32x2*)gp = u;
  }
}

DI void phase_mixA(const Params& p, int l, char* smem, bool dry = false, int only = 3) {
  const int NGQA = NB * 2 * 32, NGLA = NB * 4 * 36;
  for (int it = blockIdx.x; it < NGQA + NGLA; it += gridDim.x) {
    if (it < NGQA) {
      if (!(only & 1)) continue;
      int b = it >> 6, rem = it & 63, g = rem >> 5, qt = rem & 31;
      attn_item<3>(p, b * NSEQ + qt * 64, C_GAQ + g * 192, C_GAK + g * 64, C_GAV + g * 64, b * NSEQ, 32, NLAT + b * LC, 4, false, 0, nullptr, smem, dry);
    } else if (only & 2) gla_passA(p, l, it - NGQA, smem);
  }
}
DI void phase_mixS(const Params& p, int l, char* smem, bool dry = false) {
  const int NSC = NB * 4 * 2 * 8, NNA = NB * 6 * 32, NCG = (l == 0) ? NB * 2 * 4 : 0, NCN = (l == 0) ? NB * 6 * 4 : 0;
  for (int it = blockIdx.x; it < NSC + NNA + NCG + NCN; it += gridDim.x) {
    if (it < NSC) {
      if (!dry) gla_scan(p, it);
    } else if (it < NSC + NNA) {
      int i = it - NSC, b = i / 192, rem = i % 192, h = rem >> 5, r = rem & 31;
      int rs = min(max(r - 4, 0), 24);
      attn_item<1>(p, b * NSEQ + r * 64, C_NAQ + h * 64, C_NAK + h * 64, C_NAV + h * 64, b * NSEQ + rs * 64, 8, NLAT + b * LC, 4, true, rs - r + 7,
                   p.na_rpb + ((size_t)l * 6 + h) * 465, smem, dry);
    } else if (it < NSC + NNA + NCG) {
      int i = it - NSC - NNA, b = i >> 3, g = (i >> 2) & 1, qt = i & 3;
      attn_item<3>(p, NLAT + b * LC + qt * 64, C_GAQ + g * 192, C_GAK + g * 64, C_GAV + g * 64, 0, 0, NLAT + b * LC, 4, false, 0, nullptr, smem, dry);
    } else {
      int i = it - NSC - NNA - NCG, b = i / 24, rem = i % 24, h = rem >> 2, qt = rem & 3;
      attn_item<1>(p, NLAT + b * LC + qt * 64, C_NAQ + h * 64, C_NAK + h * 64, C_NAV + h * 64, 0, 0, NLAT + b * LC, 4, false, 0, nullptr, smem, dry);
    }
  }
}
DI void phase_mixB(const Params& p, int l, char* smem, bool dry = false) {
  const int cpl = (l == 0) ? 36 : 32;
  const int NGLB = NB * 4 * cpl;
  for (int it = blockIdx.x; it < NGLB; it += gridDim.x) {
    int cc = it % cpl, bh = it / cpl;
    gla_passB(p, l, bh >> 2, bh & 3, cc + (36 - cpl), smem, dry);
  }
}

DI void phase_final(const Params& p) {
  const int lane = tidx(p) & 63, w = tidx(p) >> 6;
  const float* g = p.ln2_g + 1024; const float* bb = p.ln2_b + 1024;
  for (int r = blockIdx.x * 4 + w; r < NLAT; r += gridDim.x * 4) {
    float* row = p.out + (size_t)r * 1024;
    f32x4 v[4];
    float s = 0.f;
#pragma unroll
    for (int i = 0; i < 4; ++i) { v[i] = *(const f32x4*)(row + i * 256 + lane * 4); s += v[i].x + v[i].y + v[i].z + v[i].w; }
#pragma unroll
    for (int m = 1; m < 64; m <<= 1) s += shx(s, m);
    float mu = s * (1.f / 1024.f), ss = 0.f;
#pragma unroll
    for (int i = 0; i < 4; ++i) { float a = v[i].x - mu, b = v[i].y - mu, c = v[i].z - mu, d = v[i].w - mu; ss += a * a + b * b + c * c + d * d; }
#pragma unroll
    for (int m = 1; m < 64; m <<= 1) ss += shx(ss, m);
    float rs = rsqrtf(ss * (1.f / 1024.f) + 1e-5f);
#pragma unroll
    for (int i = 0; i < 4; ++i) {
      f32x4 gg = *(const f32x4*)(g + i * 256 + lane * 4), be = *(const f32x4*)(bb + i * 256 + lane * 4), o;
      o.x = (v[i].x - mu) * rs * gg.x + be.x; o.y = (v[i].y - mu) * rs * gg.y + be.y;
      o.z = (v[i].z - mu) * rs * gg.z + be.z; o.w = (v[i].w - mu) * rs * gg.w + be.w;
      *(f32x4*)(row + i * 256 + lane * 4) = o;
    }
  }
}

DI void phase_uconv(const Params& p, int kind, int l) {
  const int tid = tidx(p), lane = tid & 63, w = tid >> 6;
  const int nrows = (kind == 1 && l == 1) ? NLAT : NROWS;
  const float* MODb = (const float*)(p.ws + OFF_MOD);
  const float* TABb = (const float*)(p.ws + OFF_TAB) + (size_t)l * 4 * 17 * 1024;
  for (int r = blockIdx.x * 4 + w; r < nrows; r += gridDim.x * 4) {
    const bool lat = r < NLAT;
    const int b = lat ? r / NSEQ : 16;
    const float* src; const float* st = nullptr; bf16_t* dstb;
    if (kind == 0) {
      if (l == 0) src = lat ? p.x + (size_t)r * 1024 : p.ctx + (size_t)(r - NLAT) * 1024;
      else { src = lat ? p.out + (size_t)r * 1024 : (const float*)(p.ws + OFF_CTXY2) + (size_t)(r - NLAT) * 1024; st = (const float*)(p.ws + OFF_ST2) + (size_t)r * 16; }
      dstb = (bf16_t*)(p.ws + OFF_Y1);
    } else {
      src = (const float*)(p.ws + OFF_Y1) + (size_t)r * 1024; st = (const float*)(p.ws + OFF_ST1) + (size_t)r * 16;
      dstb = (bf16_t*)(p.ws + OFF_UF);
    }
    float mu = 0.f, rs = 1.f;
    if (st) row_stats(st, mu, rs);
    const bool raw = (kind == 0 && l == 0);
    const float* t1 = raw ? MODb + (size_t)b * 6144 + 1024 : TABb + (size_t)(kind * 2) * 17 * 1024 + b * 1024;
    const float* t2 = raw ? MODb + (size_t)b * 6144 : TABb + (size_t)(kind * 2 + 1) * 17 * 1024 + b * 1024;
#pragma unroll
    for (int i = 0; i < 4; ++i) {
      const int k = i * 256 + lane * 4;
      f32x4 v = *(const f32x4*)(src + k), a = *(const f32x4*)(t1 + k), c = *(const f32x4*)(t2 + k);
      if (raw) { a.x += 1.f; a.y += 1.f; a.z += 1.f; a.w += 1.f; }
      u32x2 u;
      u.x = pack2((v.x - mu) * rs * a.x + c.x, (v.y - mu) * rs * a.y + c.y);
      u.y = pack2((v.z - mu) * rs * a.z + c.z, (v.w - mu) * rs * a.w + c.w);
      *(u32x2*)(dstb + ((size_t)(k >> 5) * NROWS + r) * 32 + (k & 31)) = u;
    }
  }
}

#define XB_TMO      128
#define XB_XCNT(j)  (256  + 64 * (j))
#define XB_XSUB(j)  (1280 + 64 * (j))
#define XB_XGEN(j)  (2304 + 64 * (j))
#define XB_TOP      3328
#define XB_TOPGEN   3392
#define XCD_BAR_WORDS 3456
#define XB_SPIN_CAP (1u << 18)
#define LAS __attribute__((address_space(3)))

__device__ __forceinline__ unsigned xb_ld(unsigned* p)              { return __hip_atomic_load(p, __ATOMIC_RELAXED, __HIP_MEMORY_SCOPE_AGENT); }
__device__ __forceinline__ unsigned xb_add(unsigned* p, unsigned v) { return __hip_atomic_fetch_add(p, v, __ATOMIC_RELAXED, __HIP_MEMORY_SCOPE_AGENT); }
__device__ __forceinline__ unsigned xb_xcc_id() { return (unsigned)__builtin_amdgcn_s_getreg((3 << 11) | 20) & 0xFu; }
#define XB_SPIN(cond, bar) do { unsigned _sp = 0; while (cond) { __builtin_amdgcn_s_sleep(1); \
    if ((++_sp & 255u) == 0u) { if (xb_ld(&(bar)[XB_TMO])) break; if (_sp > XB_SPIN_CAP) { atomicAdd(&(bar)[XB_TMO], 1u); break; } } } } while (0)

struct XcdBarrier {
    unsigned* bar; unsigned x;
    volatile LAS unsigned* st;
};

__device__ __forceinline__ XcdBarrier xcd_barrier_post(unsigned* bar, volatile LAS unsigned* st) {
    XcdBarrier b; b.bar = bar; b.x = xb_xcc_id(); b.st = st;
    if (threadIdx.x == 0) (void)xb_add(&bar[XB_XCNT(b.x)], 1u);
    return b;
}
__device__ __forceinline__ void xcd_barrier_complete(unsigned* bar, unsigned x, unsigned& nloc, unsigned& nx) {
    const unsigned G = gridDim.x * gridDim.y * gridDim.z;
    unsigned sum, cnt, mine, sp = 0u;
    for (;;) {
        sum = 0u; cnt = 0u; mine = 0u;
#pragma unroll
        for (unsigned j = 0; j < 16; ++j) { const unsigned c = xb_ld(&bar[XB_XCNT(j)]); sum += c; cnt += (c > 0u) ? 1u : 0u; mine = (j == x) ? c : mine; }
        if (sum == G) break;
        __builtin_amdgcn_s_sleep(1);
        if ((++sp & 255u) == 0u) { if (xb_ld(&bar[XB_TMO])) break; if (sp > XB_SPIN_CAP) { atomicAdd(&bar[XB_TMO], 1u); break; } }
    }
    nloc = mine > 0u ? mine : 1u; nx = cnt > 0u ? cnt : 1u;
}

__device__ __forceinline__ void xcd_barrier(const XcdBarrier& b) {
    asm volatile("s_waitcnt vmcnt(0)" ::: "memory");
    __syncthreads();
    if (threadIdx.x == 0) {
        unsigned* bar = b.bar;
        __builtin_amdgcn_s_waitcnt(0);
        unsigned nloc = b.st[0], nx = b.st[1];
        if (nloc == 0u) { xcd_barrier_complete(bar, b.x, nloc, nx); b.st[0] = nloc; b.st[1] = nx; }
        const unsigned old = xb_add(&bar[XB_XSUB(b.x)], 1u);
        const unsigned gen = old / nloc;
        if (old + 1u == (gen + 1u) * nloc) {
            __builtin_amdgcn_fence(__ATOMIC_RELEASE, "agent");
            asm volatile("s_waitcnt vmcnt(0)" ::: "memory");
            const unsigned og = xb_add(&bar[XB_TOP], 1u);
            const unsigned tg = og / nx;
            if (og + 1u == (tg + 1u) * nx) xb_add(&bar[XB_TOPGEN], 1u);
            else XB_SPIN(xb_ld(&bar[XB_TOPGEN]) == tg, bar);
            __builtin_amdgcn_fence(__ATOMIC_ACQUIRE, "agent");
            xb_add(&bar[XB_XGEN(b.x)], 1u);
            asm volatile("s_waitcnt vmcnt(0)" ::: "memory");
        } else {
            XB_SPIN(xb_ld(&bar[XB_XGEN(b.x)]) == gen, bar);
            __builtin_amdgcn_fence(__ATOMIC_ACQUIRE, "agent");
            asm volatile("s_waitcnt vmcnt(0)" ::: "memory");
        }
    }
    __syncthreads();
}


__global__ void __launch_bounds__(256, 2) mega(Params p_in) {
  Params p = p_in;
  p.wave_id = __builtin_amdgcn_readfirstlane((int)(threadIdx.x >> 6));
  extern __shared__ __attribute__((aligned(16))) char smem[];
  __shared__ uint4 xb_words;
  cg::grid_group grid = cg::this_grid();
  if (p.ph_lo < 0) grid.sync();
  if (threadIdx.x == 0) xb_words = make_uint4(0u, 0u, 0u, 0u);
  __syncthreads();
  XcdBarrier xb = xcd_barrier_post((unsigned*)(p.ws + OFF_BAR), (volatile LAS unsigned*)&xb_words);
  if (DUP & 32) { for (int i = 0; i < 16; ++i) xcd_barrier(xb); }
  for (int ph = p.ph_lo; ph < p.ph_hi; ++ph) {
    if (ph > p.ph_lo) xcd_barrier(xb);
    if (ph == 0) { phase_prepA(p, smem); if (DUP & 8) phase_prepA(p, smem); }
    else if (ph == 1) { phase_prepB(p); phase_uconv(p, 0, 0); }
    else {
      const int l = (ph - 2) / 9, s = (ph - 2) % 9;
      if (s == 0) { if (DUP & 1) phase_gemm<0, GV>(p, l, smem); phase_gemm<0>(p, l, smem); }
      else if (s == 1) { if (DUP & 2) phase_mixA(p, l, smem, true); if (DUP & 64) phase_mixA(p, l, smem, true, 2); phase_mixA(p, l, smem); }
      else if (s == 2) { if (DUP & 4) phase_mixS(p, l, smem, true); phase_mixS(p, l, smem); }
      else if (s == 3) { if (DUP & 128) phase_mixB(p, l, smem, true); phase_mixB(p, l, smem); }
      else if (s == 4) { if (DUP & 1) phase_gemm<1, GV>(p, l, smem); phase_gemm<1>(p, l, smem); }
      else if (s == 5) { phase_uconv(p, 1, l); if (DUP & 16) phase_uconv(p, 1, l); }
      else if (s == 6) { if (DUP & 1) phase_gemm<2, GV>(p, l, smem); phase_gemm<2>(p, l, smem); }
      else if (s == 7) { if (DUP & 1) phase_gemm<3, GV>(p, l, smem); phase_gemm<3>(p, l, smem); }
      else if (l == 0) phase_uconv(p, 0, 1);
      else phase_final(p);
    }
  }
}

extern "C" void kernel_launch(void* const* d_in, const int* in_sizes, int n_in, void* d_out, int out_size, void* d_ws, size_t ws_size,
                              hipStream_t stream) {
  static int grid = 0;
  if (grid == 0) {
    if (n_in != 20 || out_size != NLAT * 1024 || ws_size < WS_END) {
      fprintf(stderr, "kernel_launch: unexpected shapes (n_in %d out %d ws %zu need %zu)\n", n_in, out_size, ws_size, (size_t)WS_END);
      grid = -1; return;
    }
    int dev = 0, cus = 0, per = 0;
    hipGetDevice(&dev);
    hipDeviceGetAttribute(&cus, hipDeviceAttributeMultiprocessorCount, dev);
    hipFuncSetAttribute((const void*)mega, hipFuncAttributeMaxDynamicSharedMemorySize, SMEM_BYTES);
    hipOccupancyMaxActiveBlocksPerMultiprocessor(&per, (const void*)mega, 256, SMEM_BYTES);
    if (per < 1) per = 1;
    if (per > 2) per = 2;
    grid = cus * per;
  }
  if (grid < 0) return;
  if (hipMemsetAsync((char*)d_ws + OFF_BAR, 0, BAR_BYTES, stream) != hipSuccess) { fprintf(stderr, "kernel_launch: memset failed\n"); return; }
  Params p{};
  const float** pp = (const float**)&p;
  for (int i = 0; i < 20; ++i) pp[i] = (const float*)d_in[i];
  p.out = (float*)d_out; p.ws = (char*)d_ws;
#if ONE_LAUNCH
  p.ph_lo = 0; p.ph_hi = NPHASE;
  void* args[] = {&p};
  hipError_t e = hipLaunchCooperativeKernel((const void*)mega, dim3(grid), dim3(256), args, SMEM_BYTES, stream);
  if (e != hipSuccess) fprintf(stderr, "cooperative launch failed: %s (grid %d)\n", hipGetErrorString(e), grid);
#else
  for (int ph = 0; ph < NPHASE; ++ph) {
    p.ph_lo = ph; p.ph_hi = ph + 1;
    hipLaunchKernelGGL(mega, dim3(grid), dim3(256), SMEM_BYTES, stream, p);
  }
#endif
}
```
